# Optimizing an MI355X kernel written in HIP

```python
import math
import jax, jax.numpy as jnp
from jax import lax
import numpy as np

D_MODEL = 1024
BATCH = 8
SEQ = 2048
DEPTH = 4

N_MIXERS = 2
N_REC_LAYERS = (DEPTH + 1) // 2
N_ATT_LAYERS = DEPTH // 2
EPS = 1e-6

D_RNN = D_MODEL
RG_BLOCKS = 4
RG_BW = D_RNN // RG_BLOCKS
CONV_W = 4
RG_C = 8.0

H_ATT = 16
D_QK = 64
D_V = 64
D_LAT = 128
H_IDX = 8
D_IDX = 64
TOPK_MAX = 256
Q_BLOCK = 128
ATT_SCALE = D_QK ** -0.5
IDX_W_SCALE = (H_IDX ** -0.5) * (D_IDX ** -0.5)
ATT_IN_SPLITS = [H_ATT * D_QK,
                 H_ATT * D_QK + D_LAT,
                 H_ATT * D_QK + D_LAT + H_IDX * D_IDX,
                 H_ATT * D_QK + D_LAT + H_IDX * D_IDX + D_IDX]
ATT_IN_DIM = ATT_IN_SPLITS[-1] + H_IDX

NUM_BUCKETS = 32
MAX_DISTANCE = 128
MAX_EXACT = NUM_BUCKETS // 2

D_FF = 4 * D_MODEL

kernel_name = "hybrid_rglru_dsa_sqrelu_trunk"


def rms_norm(x, g):
    xf = x.astype(jnp.float32)
    y = xf * lax.rsqrt(jnp.mean(xf * xf, axis=-1, keepdims=True) + EPS)
    return (y * g.astype(jnp.float32)).astype(x.dtype)


def t5_bucket(dist):
    n = jnp.maximum(dist, 0)
    nf = jnp.maximum(n, 1).astype(jnp.float32)
    large = MAX_EXACT + (jnp.log(nf / MAX_EXACT) / math.log(MAX_DISTANCE / MAX_EXACT)
                         * (NUM_BUCKETS - MAX_EXACT)).astype(jnp.int32)
    large = jnp.minimum(large, NUM_BUCKETS - 1)
    return jnp.where(n < MAX_EXACT, n, large)


def rglru_mixer(h, w_in, conv_w, conv_b, w_a, b_a, w_x, b_x, lam, w_out):
    B, S, _ = h.shape
    gate, xr = jnp.split(h @ w_in, 2, axis=-1)
    gate = jax.nn.gelu(gate)
    xpad = jnp.pad(xr, ((0, 0), (CONV_W - 1, 0), (0, 0)))
    xc = conv_b + xpad[:, 0:S] * conv_w[0]
    for k in range(1, CONV_W):
        xc = xc + xpad[:, k:k + S] * conv_w[k]
    xb = xc.reshape(B, S, RG_BLOCKS, RG_BW)
    r = jax.nn.sigmoid(jnp.einsum('bsnj,nji->bsni', xb, w_a).reshape(B, S, D_RNN) + b_a)
    i = jax.nn.sigmoid(jnp.einsum('bsnj,nji->bsni', xb, w_x).reshape(B, S, D_RNN) + b_x)
    log_a = (-RG_C * r.astype(jnp.float32)) * jax.nn.softplus(-lam.astype(jnp.float32))
    a = jnp.exp(log_a)
    u = jnp.sqrt(-jnp.expm1(2.0 * log_a)) * (i * xc).astype(jnp.float32)

    def combine(left, right):
        a_l, b_l = left
        a_r, b_r = right
        return a_l * a_r, a_r * b_l + b_r

    _, hs = lax.associative_scan(combine, (a, u), axis=1)
    y = hs.astype(h.dtype) * gate
    return y @ w_out


def dsa_mixer(h, w_in, kv_norm_g, w_uk, w_uv, w_o, rel_bias):
    B, S, _ = h.shape
    n_blk = S // Q_BLOCK
    topk = min(TOPK_MAX, S // 4)
    q, c, qi, ki, wi = jnp.split(h @ w_in, ATT_IN_SPLITS, axis=-1)
    q = q.reshape(B, S, H_ATT, D_QK)
    c = rms_norm(c, kv_norm_g)
    qi = qi.reshape(B, S, H_IDX, D_IDX)
    wi = wi * IDX_W_SCALE
    q_lat = jnp.einsum('bshd,hdc->bshc', q, w_uk) * ATT_SCALE
    key_pos = jnp.arange(S)

    def block(args):
        q_lat_b, qi_b, wi_b, pos_b = args
        dots = jax.nn.relu(jnp.einsum('bqhd,bsd->bqhs', qi_b, ki))
        score = jnp.einsum('bqh,bqhs->bqs', wi_b, dots).astype(jnp.float32)
        causal = key_pos[None, :] <= pos_b[:, None]
        score = jnp.where(causal[None], score, -jnp.inf)
        _, idx = lax.top_k(score, topk)
        c_sel = jax.vmap(lambda cb, ib: cb[ib])(c, idx)
        dist = pos_b[None, :, None] - idx
        bias = jnp.moveaxis(rel_bias[t5_bucket(dist)], -1, 2)
        logits = jnp.einsum('bqhc,bqkc->bqhk', q_lat_b, c_sel).astype(jnp.float32) \
            + bias.astype(jnp.float32)
        logits = jnp.where((dist >= 0)[:, :, None, :], logits, -jnp.inf)
        p = jax.nn.softmax(logits, axis=-1).astype(c.dtype)
        return jnp.einsum('bqhk,bqkc->bqhc', p, c_sel)

    def to_blocks(a):
        return a.reshape(B, n_blk, Q_BLOCK, *a.shape[2:]).swapaxes(0, 1)

    o_lat = lax.map(block, (to_blocks(q_lat), to_blocks(qi), to_blocks(wi),
                            key_pos.reshape(n_blk, Q_BLOCK)))
    o_lat = o_lat.swapaxes(0, 1).reshape(B, S, H_ATT, D_LAT)
    o = jnp.einsum('bshc,hcv->bshv', o_lat, w_uv).reshape(B, S, H_ATT * D_V)
    return o @ w_o


def sq_relu_mlp(h, w_up, w_down):
    return jnp.square(jax.nn.relu(h @ w_up)) @ w_down


def setup_inputs(seed: int = 0) -> dict:
    key = jax.random.key(seed)
    ks = jax.random.split(key, 24)
    nr, na, L = N_REC_LAYERS, N_ATT_LAYERS, DEPTH
    f32 = jnp.float32

    def nrm(k, shape, scale):
        return jax.random.normal(k, shape, f32) * scale

    u = jax.random.uniform(ks[10], (nr, D_RNN), f32, 0.9, 0.999)
    return {
        "x": jax.random.normal(ks[0], (BATCH, SEQ, D_MODEL), f32),
        "norm_mix_g": 1.0 + nrm(ks[1], (L, D_MODEL), 0.02),
        "norm_mlp_g": 1.0 + nrm(ks[2], (L, D_MODEL), 0.02),
        "final_norm_g": 1.0 + nrm(ks[3], (D_MODEL,), 0.02),
        "rec_w_in": nrm(ks[4], (nr, D_MODEL, 2 * D_RNN), D_MODEL ** -0.5),
        "rec_conv_w": nrm(ks[5], (nr, CONV_W, D_RNN), CONV_W ** -0.5),
        "rec_conv_b": nrm(ks[6], (nr, D_RNN), 0.01),
        "rec_w_a": nrm(ks[7], (nr, RG_BLOCKS, RG_BW, RG_BW), RG_BW ** -0.5),
        "rec_b_a": nrm(ks[8], (nr, D_RNN), 0.01),
        "rec_w_x": nrm(ks[9], (nr, RG_BLOCKS, RG_BW, RG_BW), RG_BW ** -0.5),
        "rec_b_x": nrm(ks[11], (nr, D_RNN), 0.01),
        "rec_lambda": jnp.log(u) - jnp.log1p(-u),
        "rec_w_out": nrm(ks[12], (nr, D_RNN, D_MODEL), D_RNN ** -0.5),
        "att_w_in": nrm(ks[13], (na, D_MODEL, ATT_IN_DIM), D_MODEL ** -0.5),
        "att_kv_norm_g": 1.0 + nrm(ks[14], (na, D_LAT), 0.02),
        "att_w_uk": nrm(ks[15], (na, H_ATT, D_QK, D_LAT), D_LAT ** -0.5),
        "att_w_uv": nrm(ks[16], (na, H_ATT, D_LAT, D_V), D_LAT ** -0.5),
        "att_w_o": nrm(ks[17], (na, H_ATT * D_V, D_MODEL), (H_ATT * D_V) ** -0.5),
        "rel_bias": nrm(ks[18], (NUM_BUCKETS, H_ATT), 0.2),
        "mlp_w_up": nrm(ks[19], (L, D_MODEL, D_FF), D_MODEL ** -0.5),
        "mlp_w_down": nrm(ks[20], (L, D_FF, D_MODEL), D_FF ** -0.5),
    }


def reference(x, norm_mix_g, norm_mlp_g, final_norm_g,
              rec_w_in, rec_conv_w, rec_conv_b, rec_w_a, rec_b_a, rec_w_x, rec_b_x,
              rec_lambda, rec_w_out,
              att_w_in, att_kv_norm_g, att_w_uk, att_w_uv, att_w_o, rel_bias,
              mlp_w_up, mlp_w_down):
    for layer in range(DEPTH):
        j = layer // N_MIXERS
        hn = rms_norm(x, norm_mix_g[layer])
        if layer % N_MIXERS == 0:
            mix = rglru_mixer(hn, rec_w_in[j], rec_conv_w[j], rec_conv_b[j],
                              rec_w_a[j], rec_b_a[j], rec_w_x[j], rec_b_x[j],
                              rec_lambda[j], rec_w_out[j])
        else:
            mix = dsa_mixer(hn, att_w_in[j], att_kv_norm_g[j], att_w_uk[j],
                            att_w_uv[j], att_w_o[j], rel_bias)
        x = x + mix
        x = x + sq_relu_mlp(rms_norm(x, norm_mlp_g[layer]), mlp_w_up[layer], mlp_w_down[layer])
    return rms_norm(x, final_norm_g)
```

```cpp
#include <hip/hip_runtime.h>
#include <cstdio>
#include <cstdint>

#define LAS __attribute__((address_space(3)))
#define GAS __attribute__((address_space(1)))
typedef unsigned short bf16_t;
typedef short bf16x8 __attribute__((ext_vector_type(8)));
typedef short s16x4 __attribute__((ext_vector_type(4)));
typedef float f32x4 __attribute__((ext_vector_type(4)));
typedef float f32x2 __attribute__((ext_vector_type(2)));
typedef float f32x16 __attribute__((ext_vector_type(16)));
typedef unsigned u32x4 __attribute__((ext_vector_type(4)));
typedef unsigned u32x2 __attribute__((ext_vector_type(2)));
typedef unsigned short u16x4 __attribute__((ext_vector_type(4)));

constexpr int BATCH = 8, SEQ = 2048, D = 1024, M = BATCH * SEQ, DEPTH = 4, FF = 4096;
constexpr int H_ATT = 16, D_LAT = 128, H_IDX = 8, D_IDX = 64, TOPK = 256;
constexpr int ATT_IN = 1736;
constexpr int NATT = 2816;
constexpr int QC_C = 2048, QC_QI = 2176, QC_KI = 2688, QC_WI = 2752;
constexpr float EPS = 1e-6f;
constexpr int NWAVES = 8, NTHREADS = 512;

constexpr size_t MiB = 1u << 20;
constexpr size_t WS_CTL = 0, CTL_ZERO_BYTES = 64 * 1024;
constexpr size_t WS_SSQ = 1 * MiB;
constexpr size_t WS_WMIX = 2 * MiB;
constexpr size_t WS_WUP = 12 * MiB, WS_WDOWN = 20 * MiB;
constexpr size_t WS_XB = 28 * MiB;
constexpr size_t WS_BIG = 60 * MiB;
constexpr size_t WS_H = WS_BIG;
constexpr size_t WS_GX = WS_BIG;
constexpr size_t WS_XC = WS_BIG + 64 * MiB;
constexpr size_t WS_RB = WS_BIG + 96 * MiB;
constexpr size_t WS_IB = WS_BIG + 128 * MiB;
constexpr size_t WS_QC = WS_BIG;
constexpr size_t WS_CN = WS_BIG + 88 * MiB;
constexpr size_t WS_IDX = WS_BIG + 92 * MiB;
constexpr size_t WS_WATT = WS_BIG + 160 * MiB;
constexpr size_t WS_SSQM = WS_WATT + 20 * MiB;
constexpr size_t WS_END = WS_SSQM + 1 * MiB;
constexpr size_t WM_REC_GATE = (size_t)2048 * 1024, WM_REC_OUT = WM_REC_GATE + (size_t)2048 * 1024;
constexpr size_t WM_ATT_COMB = (size_t)NATT * 1024;

constexpr int RING_BYTES = 131072;
constexpr int LDSCTL_OFF = RING_BYTES;
constexpr int LDS_BYTES = 163840;
constexpr int MISC_OFF = LDS_BYTES - 512;
constexpr int BSL_OFF = 132096;

#ifndef DBLMASK
#define DBLMASK 0u
#endif
#define DB(b) ((DBLMASK >> (b)) & 1u)
typedef __bf16 bf16x2_t __attribute__((ext_vector_type(2)));
__device__ __forceinline__ unsigned cvt_pk_bf16(float lo, float hi) { const f32x2 v = {lo, hi}; return __builtin_bit_cast(unsigned, __builtin_convertvector(v, bf16x2_t)); }
__device__ __forceinline__ float bf2f(unsigned h) { return __uint_as_float(h << 16); }
__device__ __forceinline__ float bflo(unsigned w) { return __uint_as_float(w << 16); }
__device__ __forceinline__ float bfhi(unsigned w) { return __uint_as_float(w & 0xffff0000u); }
__device__ __forceinline__ float wave_sum(float v) {
#pragma unroll
    for (int o = 1; o < 64; o <<= 1) v += __shfl_xor(v, o);
    return v;
}
#ifndef WT_STORES
#define WT_STORES 1
#endif
__device__ __forceinline__ void store16_wt(void* p, u32x4 v) {
#if WT_STORES
    asm volatile("global_store_dwordx4 %0, %1, off sc1\n\ts_nop 1" :: "v"(p), "v"(v) : "memory");
#else
    *(u32x4*)p = v;
#endif
}
#define LDS_WAIT() asm volatile("s_waitcnt lgkmcnt(0)" ::: "memory")
#define VM_WAIT() asm volatile("s_waitcnt vmcnt(0)" ::: "memory")

#define XB_TMO      128
#define XB_XCNT(j)  (256  + 64 * (j))
#define XB_XSUB(j)  (1280 + 64 * (j))
#define XB_XGEN(j)  (2304 + 64 * (j))
#define XB_TOP      3328
#define XB_TOPGEN   3392
#define XCD_BAR_WORDS 3456
#define XB_SPIN_CAP (1u << 22)
constexpr int CW_BAR = 4096;
static_assert((CW_BAR + XCD_BAR_WORDS) * 4 <= (int)CTL_ZERO_BYTES, "barrier words inside the memset region");

__device__ __forceinline__ unsigned xb_ld(unsigned* p)              { return __hip_atomic_load(p, __ATOMIC_RELAXED, __HIP_MEMORY_SCOPE_AGENT); }
__device__ __forceinline__ unsigned xb_add(unsigned* p, unsigned v) { return __hip_atomic_fetch_add(p, v, __ATOMIC_RELAXED, __HIP_MEMORY_SCOPE_AGENT); }
__device__ __forceinline__ unsigned xb_xcc_id() { return (unsigned)__builtin_amdgcn_s_getreg((3 << 11) | 20) & 0xFu; }
#define XB_SPIN(cond, bar) do { unsigned _sp = 0; while (cond) { __builtin_amdgcn_s_sleep(1); \
    if ((++_sp & 255u) == 0u) { if (xb_ld(&(bar)[XB_TMO])) break; if (_sp > XB_SPIN_CAP) { atomicAdd(&(bar)[XB_TMO], 1u); break; } } } } while (0)

struct XcdBarrier { unsigned* bar; unsigned x; volatile LAS unsigned* st; };

__device__ __forceinline__ XcdBarrier xcd_barrier_post(unsigned* bar, volatile LAS unsigned* st) {
    XcdBarrier b; b.bar = bar; b.x = xb_xcc_id(); b.st = st;
    if (threadIdx.x == 0) (void)xb_add(&bar[XB_XCNT(b.x)], 1u);
    return b;
}
__device__ __forceinline__ void xcd_barrier_complete(unsigned* bar, unsigned x, unsigned& nloc, unsigned& nx) {
    const unsigned G = gridDim.x * gridDim.y * gridDim.z;
    unsigned sum, cnt, mine, sp = 0u;
    for (;;) {
        sum = 0u; cnt = 0u; mine = 0u;
#pragma unroll
        for (unsigned j = 0; j < 16; ++j) { const unsigned c = xb_ld(&bar[XB_XCNT(j)]); sum += c; cnt += (c > 0u) ? 1u : 0u; mine = (j == x) ? c : mine; }
        if (sum == G) break;
        __builtin_amdgcn_s_sleep(1);
        if ((++sp & 255u) == 0u) { if (xb_ld(&bar[XB_TMO])) break; if (sp > XB_SPIN_CAP) { atomicAdd(&bar[XB_TMO], 1u); break; } }
    }
    nloc = mine > 0u ? mine : 1u; nx = cnt > 0u ? cnt : 1u;
}
__device__ __forceinline__ void xcd_barrier(const XcdBarrier& b) {
    asm volatile("s_waitcnt vmcnt(0)" ::: "memory");
    __syncthreads();
    if (threadIdx.x == 0) {
        unsigned* bar = b.bar;
        __builtin_amdgcn_s_waitcnt(0);
        unsigned nloc = b.st[0], nx = b.st[1];
        if (nloc == 0u) { xcd_barrier_complete(bar, b.x, nloc, nx); b.st[0] = nloc; b.st[1] = nx; }
        const unsigned old = xb_add(&bar[XB_XSUB(b.x)], 1u);
        const unsigned gen = old / nloc;
        if (old + 1u == (gen + 1u) * nloc) {
            __builtin_amdgcn_fence(__ATOMIC_RELEASE, "agent");
            asm volatile("s_waitcnt vmcnt(0)" ::: "memory");
            const unsigned og = xb_add(&bar[XB_TOP], 1u);
            const unsigned tg = og / nx;
            if (og + 1u == (tg + 1u) * nx) xb_add(&bar[XB_TOPGEN], 1u);
            else XB_SPIN(xb_ld(&bar[XB_TOPGEN]) == tg, bar);
            __builtin_amdgcn_fence(__ATOMIC_ACQUIRE, "agent");
            xb_add(&bar[XB_XGEN(b.x)], 1u);
            asm volatile("s_waitcnt vmcnt(0)" ::: "memory");
        } else {
            XB_SPIN(xb_ld(&bar[XB_XGEN(b.x)]) == gen, bar);
            __builtin_amdgcn_fence(__ATOMIC_ACQUIRE, "agent");
            asm volatile("s_waitcnt vmcnt(0)" ::: "memory");
        }
    }
    __syncthreads();
}

namespace pg8 {
constexpr int BM = 256, BK = 64, HALF = 128, HTB = HALF * BK * 2, NXCD = 8, WGM = 8;
__device__ __forceinline__ int lds_byte(int r, int c) { const int st = (r >> 4) * 2 + (c >> 5), rr = r & 15, cc = c & 31, ob = rr * 64 + cc * 2; return st * 1024 + (ob ^ (((ob >> 9) & 1) << 5)); }
__device__ __forceinline__ void stage_rc(int b, int& R, int& C) { const int st = b / 1024, sb = b % 1024, swz = sb ^ (((sb >> 9) & 1) << 5); R = (st >> 1) * 16 + swz / 64; C = (st & 1) * 32 + (swz % 64) / 2; }
__device__ __forceinline__ int perm32(int rho) { const int n = rho >> 4, i = rho & 15; return 8 * (i >> 2) + 4 * n + (i & 3); }

struct Unit { int pm, pn; };
struct Gemm { const bf16_t* A; const bf16_t* Bt; int lda, ldb, K, a_shift; };

struct StaticOrder {
    int nM, nN, nwg, G, c;
    __device__ void init(int Mr, int N, int G_, int c_) { nM = Mr / BM; nN = N / BM; nwg = nM * nN; G = G_; c = c_; }
    __device__ bool next(int i, Unit& u) const {
        const long L = (long)i * G + c; if (L >= nwg) return false;
        int wgid = (int)L; { const int q = nwg / NXCD, r = nwg % NXCD, xcd = wgid % NXCD, off = wgid / NXCD; wgid = (xcd < r ? xcd * (q + 1) : r * (q + 1) + (xcd - r) * q) + off; }
        const int nig = WGM * nN, gid = wgid / nig, fm = gid * WGM, gsz = (nM - fm) < WGM ? (nM - fm) : WGM;
        u.pm = fm + ((wgid % nig) % gsz); u.pn = (wgid % nig) / gsz; return true;
    }
};
struct GateOrder {
    int G, c;
    __device__ bool next(int i, Unit& u) const { const int p = c + (i >> 1) * G; if (p >= 256) return false; u.pm = p >> 2; u.pn = ((p & 3) << 1) | (i & 1); return true; }
};

template <class Epi, class Sched>
__device__ __forceinline__ void gemm_phase(LAS unsigned char* lds, int tid, const Gemm g, const Sched& S, const Epi& E) {
    const int wid = __builtin_amdgcn_readfirstlane(tid >> 6), lane = tid & 63, wr = wid >> 2, wc = wid & 3, fr = lane & 15, fq = lane >> 4;
    int Kq = g.K; asm volatile("" : "+s"(Kq)); const int nt = Kq / BK;
    unsigned voffA[2], voffB[2];
#pragma unroll
    for (int i = 0; i < 2; ++i) { int R, C; stage_rc(tid * 16 + i * 8192, R, C); const int Rb = Epi::PERM ? ((R & ~31) + perm32(R & 31)) : R;
        voffA[i] = (unsigned)(R * g.lda + C) * 2u; voffB[i] = (unsigned)(Rb * g.ldb + C) * 2u; }
    const size_t kstep = (size_t)(BK * 2);
    const size_t hA = (size_t)HALF * g.lda * 2, hB = (size_t)HALF * g.ldb * 2;
    const size_t tA = 2 * hA, tB = 2 * hB;
    const unsigned ldsw = (unsigned)wid * 1024u;
    const int aoff = lds_byte(wr * 64 + fr, fq * 8), boff = lds_byte(wc * 32 + fr, fq * 8);
#define PG8_SA(b, h) (((b) * 2 + (h)) * HTB)
#define PG8_SB(b, h) ((4 + (b) * 2 + (h)) * HTB)
#define PG8_STAGE(bufoff, gbase, voff) do { _Pragma("unroll") for (int _i = 0; _i < 2; ++_i) \
        __builtin_amdgcn_global_load_lds((const unsigned*)((const char*)(gbase) + (voff)[_i]), (LAS unsigned*)(lds + (bufoff) + ldsw + _i * 8192), 16, 0, 0); } while (0)
#define PG8_LDA(dst, b, h) do { _Pragma("unroll") for (int m = 0; m < 4; ++m) _Pragma("unroll") for (int k = 0; k < 2; ++k) dst[m][k] = *(const LAS bf16x8*)(lds + PG8_SA(b, h) + aoff + m * 2048 + k * 1024); } while (0)
#define PG8_LDB(dst, b, h) do { _Pragma("unroll") for (int n = 0; n < 2; ++n) _Pragma("unroll") for (int k = 0; k < 2; ++k) dst[n][k] = *(const LAS bf16x8*)(lds + PG8_SB(b, h) + boff + n * 2048 + k * 1024); } while (0)
#define PG8_MMA(ai, bj, At, Bt) do { __builtin_amdgcn_s_setprio(1); _Pragma("unroll") for (int m = 0; m < 4; ++m) _Pragma("unroll") for (int n = 0; n < 2; ++n) _Pragma("unroll") for (int k = 0; k < 2; ++k) \
        acc[ai][bj][m][n] = __builtin_amdgcn_mfma_f32_16x16x32_bf16(Bt[n][k], At[m][k], acc[ai][bj][m][n], 0, 0, 0); __builtin_amdgcn_s_setprio(0); } while (0)
#define PG8_WAIT_V(n) asm volatile("s_waitcnt vmcnt(" #n ")" ::: "memory")
#define PG8_WAIT_L(n) asm volatile("s_waitcnt lgkmcnt(" #n ")" ::: "memory")
#define PG8_BAR __builtin_amdgcn_s_barrier()
#define PG8_SCHED __builtin_amdgcn_sched_barrier(0)
#define PG8_ABASE(u) ((const char*)g.A + (size_t)(u).pm * tA + (g.a_shift >= 0 ? (size_t)(((u).pn & g.a_shift) * 512) : (size_t)0))
#define PG8_BBASE(u) ((const char*)g.Bt + (size_t)(u).pn * tB + (g.a_shift >= 0 ? (size_t)(((u).pn & g.a_shift) * 512) : (size_t)0))
    Unit cur, nxt; int ui = 0;
    if (!S.next(0, cur)) return;
    f32x4 acc[2][2][4][2];
#pragma unroll
    for (int a = 0; a < 2; ++a)
#pragma unroll
        for (int b = 0; b < 2; ++b)
#pragma unroll
            for (int m = 0; m < 4; ++m)
#pragma unroll
                for (int n = 0; n < 2; ++n) acc[a][b][m][n] = (f32x4){0.f, 0.f, 0.f, 0.f};
    bf16x8 At[4][2], B0[2][2], B1[2][2];
    const char* cA = PG8_ABASE(cur); const char* cB = PG8_BBASE(cur);
    PG8_STAGE(PG8_SB(0, 0), cB, voffB); PG8_STAGE(PG8_SB(0, 1), cB + hB, voffB); PG8_STAGE(PG8_SA(0, 0), cA, voffA); PG8_STAGE(PG8_SA(0, 1), cA + hA, voffA);
    if (wr == 1) PG8_BAR;
    PG8_WAIT_V(2); PG8_BAR;
    PG8_STAGE(PG8_SB(1, 0), cB + kstep, voffB); PG8_STAGE(PG8_SA(1, 0), cA + kstep, voffA); PG8_STAGE(PG8_SB(1, 1), cB + hB + kstep, voffB);
    PG8_WAIT_V(6); PG8_BAR;
    for (;;) {
        const bool has_next = S.next(ui + 1, nxt);
        const char* nA = has_next ? PG8_ABASE(nxt) : cA; const char* nB = has_next ? PG8_BBASE(nxt) : cB;
        for (int t = 0; t < nt; t += 2) {
            const bool last = (t == nt - 2);
            const char* a1 = cA + (size_t)(t + 1) * kstep;
            const char* a2 = last ? nA : cA + (size_t)(t + 2) * kstep; const char* b2 = last ? nB : cB + (size_t)(t + 2) * kstep;
            const char* a3 = a2 + kstep; const char* b3 = b2 + kstep;
            PG8_LDB(B0, 0, 0); PG8_LDB(B1, 0, 1); PG8_SCHED; PG8_LDA(At, 0, 0); PG8_STAGE(PG8_SA(1, 1), a1 + hA, voffA);
            PG8_WAIT_V(8); PG8_WAIT_L(0); PG8_BAR; PG8_MMA(0, 0, At, B0); PG8_MMA(0, 1, At, B1); PG8_BAR; PG8_SCHED;
            PG8_LDA(At, 0, 1); PG8_STAGE(PG8_SB(0, 0), b2, voffB); PG8_STAGE(PG8_SB(0, 1), b2 + hB, voffB); PG8_STAGE(PG8_SA(0, 0), a2, voffA);
            PG8_WAIT_V(8); PG8_WAIT_L(0); PG8_BAR; PG8_MMA(1, 0, At, B0); PG8_MMA(1, 1, At, B1); PG8_BAR; PG8_SCHED;
            PG8_LDB(B0, 1, 0); PG8_LDB(B1, 1, 1); PG8_SCHED; PG8_LDA(At, 1, 0); PG8_STAGE(PG8_SA(0, 1), a2 + hA, voffA);
            PG8_WAIT_V(8); PG8_WAIT_L(0); PG8_BAR; PG8_MMA(0, 0, At, B0); PG8_MMA(0, 1, At, B1); PG8_BAR; PG8_SCHED;
            PG8_LDA(At, 1, 1); PG8_STAGE(PG8_SB(1, 0), b3, voffB); PG8_STAGE(PG8_SB(1, 1), b3 + hB, voffB); PG8_STAGE(PG8_SA(1, 0), a3, voffA);
            PG8_WAIT_V(8); PG8_WAIT_L(0); PG8_BAR; PG8_MMA(1, 0, At, B0); PG8_MMA(1, 1, At, B1); PG8_BAR; PG8_SCHED;
        }
        if (wr == 0) PG8_BAR;
        E(acc, cur, wr, wc, fr, fq);
        if (!has_next) break;
#pragma unroll
        for (int a = 0; a < 2; ++a)
#pragma unroll
            for (int b = 0; b < 2; ++b)
#pragma unroll
                for (int m = 0; m < 4; ++m)
#pragma unroll
                    for (int n = 0; n < 2; ++n) acc[a][b][m][n] = (f32x4){0.f, 0.f, 0.f, 0.f};
        cur = nxt; cA = nA; cB = nB; ++ui;
        if (wr == 1) PG8_BAR;
    }
    PG8_WAIT_V(0);
    PG8_BAR;
#undef PG8_SA
#undef PG8_SB
#undef PG8_STAGE
#undef PG8_LDA
#undef PG8_LDB
#undef PG8_MMA
#undef PG8_WAIT_V
#undef PG8_WAIT_L
#undef PG8_BAR
#undef PG8_SCHED
#undef PG8_ABASE
#undef PG8_BBASE
}

__device__ __forceinline__ float row_rs(const float* ssq, int row) {
    const f32x4* p = (const f32x4*)(ssq + (size_t)row * 16); const f32x4 a = p[0], b = p[1], c = p[2], d = p[3];
    const float s = ((a.x + a.y) + (a.z + a.w)) + ((b.x + b.y) + (b.z + b.w)) + ((c.x + c.y) + (c.z + c.w)) + ((d.x + d.y) + (d.z + d.w));
    return rsqrtf(s * (1.0f / 1024.0f) + EPS);
}
__device__ __forceinline__ float gelu_tanh(float v) {
    const float u = 1.5957691216f * (v + 0.044715f * v * v * v);
    return v * __builtin_amdgcn_rcpf(1.0f + __builtin_amdgcn_exp2f(-1.44269504089f * u));
}
__device__ __forceinline__ float sigmoidf_(float z) { return __builtin_amdgcn_rcpf(1.0f + __builtin_amdgcn_exp2f(-1.44269504089f * z)); }

template <int MODE> struct EpiScale {
    static constexpr bool PERM = true;
    bf16_t* O; int ldc; const float* ssq;
    __device__ __forceinline__ void operator()(const f32x4 (&acc)[2][2][4][2], const Unit& u, int wr, int wc, int fr, int fq) const {
        const int row0 = u.pm * BM + wr * 64 + fr, col0 = u.pn * BM + wc * 32 + 8 * fq;
        const bool act = (MODE == 1) && (u.pn < 4);
        float rsv[2][4];
        if (MODE == 2) {
#pragma unroll
          for (int ai = 0; ai < 2; ++ai)
#pragma unroll
              for (int m = 0; m < 4; ++m) rsv[ai][m] = 1.0f; }
        else { f32x4 part[2][4];
#pragma unroll
          for (int ai = 0; ai < 2; ++ai)
#pragma unroll
              for (int m = 0; m < 4; ++m) part[ai][m] = *(const f32x4*)(ssq + (size_t)(row0 + ai * HALF + m * 16) * 16 + 4 * fq);
#pragma unroll
          for (int ai = 0; ai < 2; ++ai)
#pragma unroll
              for (int m = 0; m < 4; ++m) { float t = (part[ai][m].x + part[ai][m].y) + (part[ai][m].z + part[ai][m].w); t += __shfl_xor(t, 16); t += __shfl_xor(t, 32); rsv[ai][m] = rsqrtf(t * (1.0f / 1024.0f) + EPS); } }
#pragma unroll
        for (int ai = 0; ai < 2; ++ai)
#pragma unroll
            for (int m = 0; m < 4; ++m) { const int row = row0 + ai * HALF + m * 16; const float rs = rsv[ai][m]; bf16_t* rowp = O + (size_t)row * ldc + col0;
#pragma unroll
                for (int bj = 0; bj < 2; ++bj) { f32x4 v0 = acc[ai][bj][m][0], v1 = acc[ai][bj][m][1];
                    if (MODE != 2) { v0 = v0 * rs; v1 = v1 * rs; }
                    if (MODE == 1) { if (act) {
#pragma unroll
                        for (int e = 0; e < 4; ++e) { v0[e] = gelu_tanh(v0[e]); v1[e] = gelu_tanh(v1[e]); } } }
                    if (MODE == 2) {
#pragma unroll
                        for (int e = 0; e < 4; ++e) { const float a = fmaxf(v0[e], 0.f), b = fmaxf(v1[e], 0.f); v0[e] = a * a; v1[e] = b * b; } }
                    u32x4 w; w.x = cvt_pk_bf16(v0[0], v0[1]); w.y = cvt_pk_bf16(v0[2], v0[3]); w.z = cvt_pk_bf16(v1[0], v1[1]); w.w = cvt_pk_bf16(v1[2], v1[3]);
                    store16_wt(rowp + bj * HALF, w); } }
    }
};
struct EpiGate {
    static constexpr bool PERM = true;
    bf16_t* R; bf16_t* I; const float* ba; const float* bx;
    __device__ __forceinline__ void operator()(const f32x4 (&acc)[2][2][4][2], const Unit& u, int wr, int wc, int fr, int fq) const {
        const int which = u.pn >> 2, blk = u.pn & 3;
        bf16_t* O = which ? I : R; const float* bias = which ? bx : ba;
        const int row0 = u.pm * BM + wr * 64 + fr, col0 = blk * BM + wc * 32 + 8 * fq;
#pragma unroll
        for (int bj = 0; bj < 2; ++bj) {
            const f32x4 bv0 = *(const f32x4*)(bias + col0 + bj * HALF), bv1 = *(const f32x4*)(bias + col0 + bj * HALF + 4);
#pragma unroll
            for (int ai = 0; ai < 2; ++ai)
#pragma unroll
                for (int m = 0; m < 4; ++m) { bf16_t* rowp = O + (size_t)(row0 + ai * HALF + m * 16) * D + col0;
                    f32x4 v0 = acc[ai][bj][m][0] + bv0, v1 = acc[ai][bj][m][1] + bv1;
#pragma unroll
                    for (int e = 0; e < 4; ++e) { v0[e] = sigmoidf_(v0[e]); v1[e] = sigmoidf_(v1[e]); }
                    u32x4 w; w.x = cvt_pk_bf16(v0[0], v0[1]); w.y = cvt_pk_bf16(v0[2], v0[3]); w.z = cvt_pk_bf16(v1[0], v1[1]); w.w = cvt_pk_bf16(v1[2], v1[3]);
                    store16_wt(rowp + bj * HALF, w); }
        }
    }
};
template <bool SCALE> struct EpiRes {
    static constexpr bool PERM = true;
    bf16_t* xb; float* ssq; const float* ssq_in;
    __device__ __forceinline__ void operator()(const f32x4 (&acc)[2][2][4][2], const Unit& u, int wr, int wc, int fr, int fq) const {
        const int col0 = u.pn * BM + wc * 32 + 8 * fq;
#pragma unroll
        for (int ai = 0; ai < 2; ++ai) {
            f32x4 part_[4];
            if (SCALE) {
#pragma unroll
                for (int m = 0; m < 4; ++m) part_[m] = *(const f32x4*)(ssq_in + (size_t)(u.pm * BM + ai * HALF + wr * 64 + m * 16 + fr) * 16 + 4 * fq); }
            u32x4 o[4][2];
#pragma unroll
            for (int m = 0; m < 4; ++m) { const size_t off = (size_t)(u.pm * BM + ai * HALF + wr * 64 + m * 16 + fr) * D + col0;
#pragma unroll
                for (int bj = 0; bj < 2; ++bj) o[m][bj] = *(const u32x4*)(xb + off + bj * HALF); }
#pragma unroll
            for (int m = 0; m < 4; ++m) { const int row = u.pm * BM + ai * HALF + wr * 64 + m * 16 + fr; const size_t off = (size_t)row * D + col0; float part = 0.f;
                float rs2 = 1.0f;
                if (SCALE) { float t = (part_[m].x + part_[m].y) + (part_[m].z + part_[m].w); t += __shfl_xor(t, 16); t += __shfl_xor(t, 32); rs2 = __builtin_amdgcn_rcpf(t * (1.0f / 1024.0f) + EPS); }
#pragma unroll
                for (int bj = 0; bj < 2; ++bj) { const u32x4 xo = o[m][bj]; f32x4 a0 = acc[ai][bj][m][0], a1 = acc[ai][bj][m][1];
                    if (SCALE) { a0 = a0 * rs2; a1 = a1 * rs2; }
                    const float v0 = bflo(xo.x) + a0[0], v1 = bfhi(xo.x) + a0[1], v2 = bflo(xo.y) + a0[2], v3 = bfhi(xo.y) + a0[3];
                    const float v4 = bflo(xo.z) + a1[0], v5 = bfhi(xo.z) + a1[1], v6 = bflo(xo.w) + a1[2], v7 = bfhi(xo.w) + a1[3];
                    u32x4 w; w.x = cvt_pk_bf16(v0, v1); w.y = cvt_pk_bf16(v2, v3); w.z = cvt_pk_bf16(v4, v5); w.w = cvt_pk_bf16(v6, v7); store16_wt(xb + off + bj * HALF, w);
                    part += ((v0 * v0 + v1 * v1) + (v2 * v2 + v3 * v3)) + ((v4 * v4 + v5 * v5) + (v6 * v6 + v7 * v7)); }
                part += __shfl_xor(part, 16); part += __shfl_xor(part, 32);
                if (fq == 0) ssq[(size_t)row * 16 + u.pn * 4 + wc] = part; }
            asm volatile("" ::: "memory");
        }
    }
};
}

struct Args { const float* in[21]; float* out; unsigned char* ws; int ph_lo, ph_hi; };
static_assert(sizeof(Args) == 21 * 8 + 8 + 8 + 8, "Args has no padding");

struct Frame {
    LAS unsigned char* lds;
    int tid, lane, wave, G, vcu, bid;
};
__device__ __forceinline__ Frame launder(const Frame& F0) {
    Frame F = F0; int t = F0.tid, w = F0.wave, g = F0.G, v = F0.vcu, b = F0.bid;
    asm volatile("" : "+v"(t)); asm volatile("" : "+s"(w)); asm volatile("" : "+s"(g)); asm volatile("" : "+s"(v)); asm volatile("" : "+s"(b));
    F.tid = t; F.lane = t & 63; F.wave = w; F.G = g; F.vcu = v; F.bid = b; return F;
}

__device__ __forceinline__ void cvt_item(const float* W, int ldw, const float* gamma, float scale, bf16_t* Bt, int ldb, int nblk, int nvalid, LAS float* scr, int item, int lane) {
    const int kb = item / nblk, nb = item % nblk, k0 = 64 * kb, n0 = 32 * nb;
    const int nn = lane & 31; const bool ok = (n0 + nn) < nvalid;
    if (n0 + 32 <= nvalid && ((((size_t)W) | ((size_t)ldw * 4u)) & 15u) == 0) {
        const int c4 = (lane & 7) * 4, r8 = lane >> 3; f32x4 v[8];
#pragma unroll
        for (int i = 0; i < 8; ++i) v[i] = __builtin_nontemporal_load((const f32x4*)(W + (size_t)(k0 + 8 * i + r8) * ldw + n0 + c4));
#pragma unroll
        for (int i = 0; i < 8; ++i) { const int kk = 8 * i + r8; const float gs = (gamma ? gamma[k0 + kk] : 1.0f) * scale; LAS float* d = scr + kk * 33 + c4;
            d[0] = v[i].x * gs; d[1] = v[i].y * gs; d[2] = v[i].z * gs; d[3] = v[i].w * gs; }
    } else
#pragma unroll 8
    for (int i = 0; i < 32; ++i) { const int kk = 2 * i + (lane >> 5); float v = ok ? __builtin_nontemporal_load(W + (size_t)(k0 + kk) * ldw + n0 + nn) : 0.f;     v *= (gamma ? gamma[k0 + kk] : 1.0f) * scale; scr[kk * 33 + nn] = v; }
    LDS_WAIT(); asm volatile("" ::: "memory");
    const int c = lane & 7;
#pragma unroll
    for (int j = 0; j < 4; ++j) { const int n = (lane >> 3) + 8 * j; const LAS float* s = scr + (8 * c) * 33 + n;
        u32x4 o; o.x = cvt_pk_bf16(s[0 * 33], s[1 * 33]); o.y = cvt_pk_bf16(s[2 * 33], s[3 * 33]); o.z = cvt_pk_bf16(s[4 * 33], s[5 * 33]); o.w = cvt_pk_bf16(s[6 * 33], s[7 * 33]);
        store16_wt(Bt + (size_t)(n0 + n) * ldb + k0 + 8 * c, o); }
    LDS_WAIT(); asm volatile("" ::: "memory");
}
__device__ __forceinline__ bf16x8 pack8(const f32x4 a, const f32x4 b) { const u32x4 w = {cvt_pk_bf16(a.x, a.y), cvt_pk_bf16(a.z, a.w), cvt_pk_bf16(b.x, b.y), cvt_pk_bf16(b.z, b.w)}; return __builtin_bit_cast(bf16x8, w); }
__device__ __forceinline__ void qlat_item(const float* Win, const float* wuk, const float* gamma, float scale, bf16_t* Bt, int item, int chalf, int lane) {
    const int h = item >> 4, k0 = (item & 15) << 6, cb = 64 * chalf, fr = lane & 15, fq = lane >> 4;
    bf16x8 X[4][2], Y[4][2];
    { f32x4 xa[4][2], xb[4][2]; float gs[4];
#pragma unroll
      for (int kt = 0; kt < 4; ++kt) { const int k = k0 + 16 * kt + fr; gs[kt] = gamma[k] * scale; const f32x4* p = (const f32x4*)(Win + (size_t)k * ATT_IN + h * 64 + 8 * fq);
#pragma unroll
          for (int s_ = 0; s_ < 2; ++s_) { xa[kt][s_] = p[8 * s_]; xb[kt][s_] = p[8 * s_ + 1]; } }
#pragma unroll
      for (int kt = 0; kt < 4; ++kt)
#pragma unroll
          for (int s_ = 0; s_ < 2; ++s_) X[kt][s_] = pack8(xa[kt][s_] * gs[kt], xb[kt][s_] * gs[kt]); }
#pragma unroll
    for (int ct = 0; ct < 4; ++ct)
#pragma unroll
        for (int s_ = 0; s_ < 2; ++s_) { const float* p = wuk + (size_t)h * 64 * 128 + (size_t)(32 * s_ + 8 * fq) * 128 + cb + 16 * ct + fr;
            const f32x4 ya = {p[0], p[128], p[256], p[384]}, yb = {p[512], p[640], p[768], p[896]}; Y[ct][s_] = pack8(ya, yb); }
#pragma unroll
    for (int ct = 0; ct < 4; ++ct)
#pragma unroll
        for (int kt = 0; kt < 4; ++kt) { f32x4 acc = {0.f, 0.f, 0.f, 0.f};
#pragma unroll
            for (int s_ = 0; s_ < 2; ++s_) acc = __builtin_amdgcn_mfma_f32_16x16x32_bf16(X[kt][s_], Y[ct][s_], acc, 0, 0, 0);
            u32x2 o; o.x = cvt_pk_bf16(acc[0], acc[1]); o.y = cvt_pk_bf16(acc[2], acc[3]);
            *(u32x2*)(Bt + (size_t)(h * 128 + cb + 16 * ct + fr) * D + k0 + 16 * kt + 4 * fq) = o; }
}
__device__ __forceinline__ void comb_item(const float* wuv, const float* wo, bf16_t* Bt, int item, int chalf, int lane) {
    const int h = item >> 4, n0 = (item & 15) << 6, cb = 64 * chalf, fr = lane & 15, fq = lane >> 4;
    bf16x8 X[4][2], Y[4][2];
#pragma unroll
    for (int ct = 0; ct < 4; ++ct) { const f32x4* p = (const f32x4*)(wuv + (size_t)h * 128 * 64 + (size_t)(cb + 16 * ct + fr) * 64 + 8 * fq);
#pragma unroll
        for (int s_ = 0; s_ < 2; ++s_) X[ct][s_] = pack8(p[8 * s_], p[8 * s_ + 1]); }
#pragma unroll
    for (int nt = 0; nt < 4; ++nt)
#pragma unroll
        for (int s_ = 0; s_ < 2; ++s_) { const float* p = wo + (size_t)(h * 64 + 32 * s_ + 8 * fq) * D + n0 + 16 * nt + fr;
            const f32x4 ya = {p[0], p[D], p[2 * D], p[3 * D]}, yb = {p[4 * D], p[5 * D], p[6 * D], p[7 * D]}; Y[nt][s_] = pack8(ya, yb); }
#pragma unroll
    for (int nt = 0; nt < 4; ++nt)
#pragma unroll
        for (int ct = 0; ct < 4; ++ct) { f32x4 acc = {0.f, 0.f, 0.f, 0.f};
#pragma unroll
            for (int s_ = 0; s_ < 2; ++s_) acc = __builtin_amdgcn_mfma_f32_16x16x32_bf16(X[ct][s_], Y[nt][s_], acc, 0, 0, 0);
            u32x2 o; o.x = cvt_pk_bf16(acc[0], acc[1]); o.y = cvt_pk_bf16(acc[2], acc[3]);
            *(u32x2*)(Bt + (size_t)(n0 + 16 * nt + fr) * 2048 + h * 128 + cb + 16 * ct + 4 * fq) = o; }
}

struct Ptrs {
    const float* in[21]; float* out; unsigned char* ws;
};
__device__ __forceinline__ unsigned long long argq(int k) {
    asm volatile("" : "+s"(k));
    return ((const __attribute__((address_space(4))) unsigned long long*)__builtin_amdgcn_kernarg_segment_ptr())[k];
}
__device__ __forceinline__ Ptrs load_ptrs() {
    Ptrs P;
#pragma unroll
    for (int i = 0; i < 21; ++i) P.in[i] = (const float*)(GAS const float*)argq(i);
    P.out = (float*)(GAS float*)argq(21); P.ws = (unsigned char*)(GAS unsigned char*)argq(22);
    return P;
}

__device__ __forceinline__ void cvt_rec_mix(const Frame& F, const Ptrs& P, int j, int L) {
    LAS float* scr = (LAS float*)(F.lds + F.wave * 16384);
    bf16_t* WM = (bf16_t*)(P.ws + WS_WMIX);
    const int gw = F.vcu * NWAVES + F.wave, NGW = F.G * NWAVES;
    constexpr int I_IN = 16 * 64, I_G = 4 * 8, I_OUT = 16 * 32, I_Z = 8 * 3 * 8;
    constexpr int NITEMS = I_IN + 8 * I_G + I_OUT + I_Z;
    for (int it = gw; it < NITEMS; it += NGW) {
        int r = it;
        if (r < I_IN) { cvt_item(P.in[4] + (size_t)j * D * 2048, 2048, P.in[1] + L * D, 1.f, WM, D, 64, 2048, scr, r, F.lane); continue; } r -= I_IN;
        if (r < 8 * I_G) { const int blk = r / (2 * I_G), which = (r / I_G) & 1, ri = r % I_G;
            cvt_item(P.in[which ? 9 : 7] + (size_t)(j * 4 + blk) * 65536, 256, nullptr, 1.f, WM + WM_REC_GATE + (size_t)(which * 1024 + blk * 256) * D + blk * 256, D, 8, 256, scr, ri, F.lane); continue; } r -= 8 * I_G;
        if (r < I_OUT) { cvt_item(P.in[12] + (size_t)j * D * D, D, nullptr, 1.f, WM + WM_REC_OUT, D, 32, D, scr, r, F.lane); continue; } r -= I_OUT;
        {
            const int rb = r / 24, cbi = (r / 8) % 3, piece = r & 7, blk = rb & 3, cb = cbi + (cbi >= blk ? 1 : 0);
            bf16_t* z = WM + WM_REC_GATE + (size_t)(rb * 256 + piece * 32) * D + cb * 256;
#pragma unroll
            for (int q = 0; q < 16; ++q) { const int e = q * 64 + F.lane, rr = e >> 5, cc = (e & 31) * 8; *(u32x4*)(z + (size_t)rr * D + cc) = (u32x4){0u, 0u, 0u, 0u}; }
        }
    }
}
__device__ __forceinline__ void cvt_att_mix(const Frame& F, const Ptrs& P, int j, int L, int rot = 0) {
    LAS float* scr = (LAS float*)(F.lds + F.wave * 16384);
    bf16_t* WM = (bf16_t*)(P.ws + WS_WATT + (size_t)j * 10 * MiB);
    const int NGW = F.G * NWAVES, gw = (F.vcu * NWAVES + F.wave + NGW - rot) % NGW;
    const float* Win = P.in[13] + (size_t)j * D * ATT_IN; const float* gam = P.in[1] + L * D;
    constexpr int I_H = 512, I_C = 16 * 22, I_W = 16 * 2;
    constexpr int NITEMS = 2 * I_H + I_C + I_W;
    for (int it = gw; it < NITEMS; it += NGW) {
        int r = it;
        if (r < I_H) { qlat_item(Win, P.in[15] + (size_t)j * 16 * 64 * 128, gam, 0.125f, WM, r >> 1, r & 1, F.lane); continue; } r -= I_H;
        if (r < I_H) { comb_item(P.in[16] + (size_t)j * 16 * 128 * 64, P.in[17] + (size_t)j * D * D, WM + WM_ATT_COMB, r >> 1, r & 1, F.lane); continue; } r -= I_H;
        if (r < I_C) { cvt_item(Win + 1024, ATT_IN, gam, 1.f, WM + (size_t)2048 * D, D, 22, 704, scr, r, F.lane); continue; } r -= I_C;
        cvt_item(Win + 1728, ATT_IN, gam, 0.044194173824159216f, WM + (size_t)2752 * D, D, 2, 8, scr, r, F.lane);
    }
}
__device__ __forceinline__ void cvt_up(const Frame& F, const Ptrs& P, int L) {
    LAS float* scr = (LAS float*)(F.lds + F.wave * 16384);
    const int gw = F.vcu * NWAVES + F.wave, NGW = F.G * NWAVES;
    for (int it = gw; it < 16 * 128; it += NGW) cvt_item(P.in[19] + (size_t)L * D * FF, FF, P.in[2] + L * D, 1.f, (bf16_t*)(P.ws + WS_WUP), D, 128, FF, scr, it, F.lane);
}
__device__ __forceinline__ void cvt_down(const Frame& F, const Ptrs& P, int L) {
    LAS float* scr = (LAS float*)(F.lds + F.wave * 16384);
    const int gw = F.vcu * NWAVES + F.wave, NGW = F.G * NWAVES;
    for (int it = gw; it < 64 * 32; it += NGW) cvt_item(P.in[20] + (size_t)L * FF * D, D, nullptr, 1.f, (bf16_t*)(P.ws + WS_WDOWN), FF, 32, D, scr, it, F.lane);
}

__device__ __forceinline__ void p0_rows(const Frame& F, const Ptrs& P) {
    const int gw = F.vcu * NWAVES + F.wave, NGW = F.G * NWAVES;
    bf16_t* XB = (bf16_t*)(P.ws + WS_XB); float* SSQ = (float*)(P.ws + WS_SSQ);
    for (int m = gw; m < M; m += NGW) {
        const f32x4* xr = (const f32x4*)(P.in[0] + (size_t)m * D) + F.lane; float s = 0.f; f32x4 v[4];
#pragma unroll
        for (int jj = 0; jj < 4; ++jj) { v[jj] = __builtin_nontemporal_load(xr + 64 * jj); s += (v[jj].x * v[jj].x + v[jj].y * v[jj].y) + (v[jj].z * v[jj].z + v[jj].w * v[jj].w); }
        s = wave_sum(s);
        u32x2* o = (u32x2*)(XB + (size_t)m * D) + F.lane;
#pragma unroll
        for (int jj = 0; jj < 4; ++jj) { u32x2 w; w.x = cvt_pk_bf16(v[jj].x, v[jj].y); w.y = cvt_pk_bf16(v[jj].z, v[jj].w); o[64 * jj] = w; }
        if (F.lane < 16) SSQ[(size_t)m * 16 + F.lane] = (F.lane == 0) ? s : 0.f;
    }
}
__device__ __forceinline__ void final_norm(const Frame& F, const Ptrs& P, bool dry = false) {
    const int gw = F.vcu * NWAVES + F.wave, NGW = F.G * NWAVES;
    const float* SSQ = (const float*)(P.ws + WS_SSQ); const f32x4* g = (const f32x4*)P.in[3] + F.lane; const bf16_t* XB = (const bf16_t*)(P.ws + WS_XB);
    for (int m = gw; m < M; m += NGW) {
        f32x4* xr = (f32x4*)(P.out + (size_t)m * D) + F.lane; const u32x2* xi = (const u32x2*)(XB + (size_t)m * D) + F.lane; const float rs = pg8::row_rs(SSQ, m);
#pragma unroll
        for (int jj = 0; jj < 4; ++jj) { const u32x2 xv = xi[64 * jj]; const f32x4 v = {bflo(xv.x), bfhi(xv.x), bflo(xv.y), bfhi(xv.y)}; const f32x4 gg = g[64 * jj]; const f32x4 w = v * rs * gg; __builtin_nontemporal_store(dry ? v : w, xr + 64 * jj); }
    }
}
__device__ __forceinline__ void conv_tile(const Frame& F, const Ptrs& P, int j, int pm, int blk) {
    const bf16_t* GX = (const bf16_t*)(P.ws + WS_GX); bf16_t* XC = (bf16_t*)(P.ws + WS_XC);
    const int cp = F.tid & 127, rq = F.tid >> 7, ch = blk * 256 + 2 * cp, r0 = pm * 256 + rq * 64;
    const float* cw = P.in[5] + (size_t)j * 4 * D + ch; const float* cb = P.in[6] + (size_t)j * D + ch;
    const f32x2 w0 = *(const f32x2*)(cw), w1 = *(const f32x2*)(cw + D), w2 = *(const f32x2*)(cw + 2 * D), w3 = *(const f32x2*)(cw + 3 * D), bb = *(const f32x2*)cb;
    const unsigned* xr = (const unsigned*)(GX + (size_t)r0 * 2048 + 1024 + ch);
    unsigned x0 = 0u, x1 = 0u, x2 = 0u;
    if ((r0 & (SEQ - 1)) != 0) { x0 = xr[-3 * 1024]; x1 = xr[-2 * 1024]; x2 = xr[-1 * 1024]; }
    unsigned* xo = (unsigned*)(XC + (size_t)r0 * D + ch);
    for (int tb = 0; tb < 64; tb += 16) {
        unsigned xin[16];
#pragma unroll
        for (int q = 0; q < 16; ++q) xin[q] = xr[(size_t)(tb + q) * 1024];
#pragma unroll
        for (int q = 0; q < 16; ++q) {
            const unsigned x3 = xin[q];
            const float a = bb.x + w0.x * bflo(x0) + w1.x * bflo(x1) + w2.x * bflo(x2) + w3.x * bflo(x3);
            const float b = bb.y + w0.y * bfhi(x0) + w1.y * bfhi(x1) + w2.y * bfhi(x2) + w3.y * bfhi(x3);
            xo[(size_t)(tb + q) * 512] = cvt_pk_bf16(a, b);
            x0 = x1; x1 = x2; x2 = x3;
        }
    }
}

__device__ __forceinline__ void scan_phase(const Frame& F, const Ptrs& P, int j, bool dry = false) {
    LAS float* sA = (LAS float*)F.lds; LAS float* sH = sA + 32 * 32;
    bf16_t* GX = (bf16_t*)(P.ws + WS_GX); const bf16_t* XC = (const bf16_t*)(P.ws + WS_XC);
    const bf16_t* RB = (const bf16_t*)(P.ws + WS_RB); const bf16_t* IB = (const bf16_t*)(P.ws + WS_IB);
    const int c2 = F.tid & 15, chunk = F.tid >> 4;
    for (int u = F.vcu; u < BATCH * 32; u += F.G) {
        const int b = u >> 5, cg = u & 31, ch = cg * 32 + 2 * c2; const size_t row0 = (size_t)b * SEQ + chunk * 64;
        const f32x2 lam = *(const f32x2*)(P.in[11] + (size_t)j * D + ch);
        const float sp0 = -8.0f * log1pf(expf(-lam.x)), sp1 = -8.0f * log1pf(expf(-lam.y));
        const unsigned* rp = (const unsigned*)(RB + row0 * D + ch); const unsigned* ip = (const unsigned*)(IB + row0 * D + ch); const unsigned* xp = (const unsigned*)(XC + row0 * D + ch);
        float A0 = 1.f, A1 = 1.f, h0 = 0.f, h1 = 0.f;
        for (int tb = 0; tb < 64; tb += 8) {
            unsigned rr[8], ii[8], xx[8];
#pragma unroll
            for (int q = 0; q < 8; ++q) { rr[q] = rp[(size_t)(tb + q) * 512]; ii[q] = ip[(size_t)(tb + q) * 512]; xx[q] = xp[(size_t)(tb + q) * 512]; }
#pragma unroll
            for (int q = 0; q < 8; ++q) { const unsigned r = rr[q], i = ii[q], x = xx[q];
                const float a0 = __expf(sp0 * bflo(r)), a1 = __expf(sp1 * bfhi(r));
                const float u0 = sqrtf(fmaxf(fmaf(-a0, a0, 1.0f), 0.f)) * (bflo(i) * bflo(x)), u1 = sqrtf(fmaxf(fmaf(-a1, a1, 1.0f), 0.f)) * (bfhi(i) * bfhi(x));
                A0 *= a0; A1 *= a1; h0 = fmaf(a0, h0, u0); h1 = fmaf(a1, h1, u1); }
        }
        sA[chunk * 32 + 2 * c2] = A0; sA[chunk * 32 + 2 * c2 + 1] = A1; sH[chunk * 32 + 2 * c2] = h0; sH[chunk * 32 + 2 * c2 + 1] = h1;
        __syncthreads();
        h0 = 0.f; h1 = 0.f;
        for (int k = 0; k < chunk; ++k) { h0 = fmaf(sA[k * 32 + 2 * c2], h0, sH[k * 32 + 2 * c2]); h1 = fmaf(sA[k * 32 + 2 * c2 + 1], h1, sH[k * 32 + 2 * c2 + 1]); }
        unsigned* gp = (unsigned*)(GX + row0 * 2048 + ch);
        for (int tb = 0; tb < 64; tb += 8) {
            unsigned rr[8], ii[8], xx[8], gg[8];
#pragma unroll
            for (int q = 0; q < 8; ++q) { rr[q] = rp[(size_t)(tb + q) * 512]; ii[q] = ip[(size_t)(tb + q) * 512]; xx[q] = xp[(size_t)(tb + q) * 512]; gg[q] = gp[(size_t)(tb + q) * 1024]; }
#pragma unroll
            for (int q = 0; q < 8; ++q) { const unsigned r = rr[q], i = ii[q], x = xx[q], gt = gg[q];
                const float a0 = __expf(sp0 * bflo(r)), a1 = __expf(sp1 * bfhi(r));
                const float u0 = sqrtf(fmaxf(fmaf(-a0, a0, 1.0f), 0.f)) * (bflo(i) * bflo(x)), u1 = sqrtf(fmaxf(fmaf(-a1, a1, 1.0f), 0.f)) * (bfhi(i) * bfhi(x));
                h0 = fmaf(a0, h0, u0); h1 = fmaf(a1, h1, u1);
                gp[(size_t)(tb + q) * 1024] = dry ? gt : cvt_pk_bf16(h0 * bflo(gt), h1 * bfhi(gt)); }
        }
        __syncthreads();
    }
}

__device__ __forceinline__ unsigned f2key(float f) { const unsigned u = __float_as_uint(f + 0.0f); return u ^ ((unsigned)((int)u >> 31) | 0x80000000u); }
__device__ __forceinline__ int wave_sum_dpp(int x) {
    x += __builtin_amdgcn_update_dpp(0, x, 0x111, 0xF, 0xF, false);
    x += __builtin_amdgcn_update_dpp(0, x, 0x112, 0xF, 0xF, false);
    x += __builtin_amdgcn_update_dpp(0, x, 0x114, 0xF, 0xF, false);
    x += __builtin_amdgcn_update_dpp(0, x, 0x118, 0xF, 0xF, false);
    x += __builtin_amdgcn_update_dpp(0, x, 0x142, 0xA, 0xF, false);
    x += __builtin_amdgcn_update_dpp(0, x, 0x143, 0xC, 0xF, false);
    return __builtin_amdgcn_readlane(x, 63);
}
__device__ __forceinline__ float wave_sum_f32_dpp(float v) {
#define WSF_STEP(ctrl, rmask) v += __int_as_float(__builtin_amdgcn_update_dpp(0, __float_as_int(v), ctrl, rmask, 0xF, false))
    WSF_STEP(0x111, 0xF); WSF_STEP(0x112, 0xF); WSF_STEP(0x114, 0xF); WSF_STEP(0x118, 0xF); WSF_STEP(0x142, 0xA); WSF_STEP(0x143, 0xC);
#undef WSF_STEP
    return __int_as_float(__builtin_amdgcn_readlane(__float_as_int(v), 63));
}
__device__ __forceinline__ int wave_scan_dpp(int x) {
    x += __builtin_amdgcn_update_dpp(0, x, 0x111, 0xF, 0xF, false);
    x += __builtin_amdgcn_update_dpp(0, x, 0x112, 0xF, 0xF, false);
    x += __builtin_amdgcn_update_dpp(0, x, 0x114, 0xF, 0xF, false);
    x += __builtin_amdgcn_update_dpp(0, x, 0x118, 0xF, 0xF, false);
    x += __builtin_amdgcn_update_dpp(0, x, 0x142, 0xA, 0xF, false);
    x += __builtin_amdgcn_update_dpp(0, x, 0x143, 0xC, 0xF, false);
    return x;
}
template <int NR>
__device__ __forceinline__ void idx_select(const LAS float* scq, int pos, int lane, const LAS unsigned char* bkL, unsigned short* out) {
    unsigned keys[NR];
#pragma unroll
    for (int jj = 0; jj < NR; ++jj) { const int idx = lane + 64 * jj; const float v = scq[idx]; keys[jj] = (idx <= pos) ? f2key(v) : 0u; }
    unsigned T = 0u; bool exact = false; int cl_last = 0;
    for (int bit = 31; bit >= 0; --bit) {
        const unsigned cand = T | (1u << bit);
        unsigned c0 = 0, c1 = 0, c2 = 0, c3 = 0;
#pragma unroll
        for (int jj = 0; jj < NR; jj += 4) { unsigned long long m0, m1, m2, m3;
            asm volatile("v_cmp_ge_u32_e64 %4, %8, %12\n\tv_cmp_ge_u32_e64 %5, %9, %12\n\tv_cmp_ge_u32_e64 %6, %10, %12\n\tv_cmp_ge_u32_e64 %7, %11, %12\n\t"
                         "v_addc_co_u32_e64 %0, %4, 0, %0, %4\n\tv_addc_co_u32_e64 %1, %5, 0, %1, %5\n\tv_addc_co_u32_e64 %2, %6, 0, %2, %6\n\tv_addc_co_u32_e64 %3, %7, 0, %3, %7"
                         : "+v"(c0), "+v"(c1), "+v"(c2), "+v"(c3), "=&s"(m0), "=&s"(m1), "=&s"(m2), "=&s"(m3)
                         : "v"(keys[jj]), "v"(keys[jj + 1]), "v"(keys[jj + 2]), "v"(keys[jj + 3]), "s"(cand)); }
        cl_last = (int)((c0 + c1) + (c2 + c3));
        const int cnt = wave_sum_dpp(cl_last);
        if (cnt >= TOPK) T = cand;
        if (cnt == TOPK) { exact = true; break; }
    }
    if (exact) {
        int k = wave_scan_dpp(cl_last) - cl_last;
#pragma unroll
        for (int jj = 0; jj < NR; ++jj) {
            const bool sel = keys[jj] >= T;
            if (sel) { const int idx = lane + 64 * jj; const int dist = pos - idx; const unsigned bk = dist >= 128 ? 31u : (unsigned)bkL[dist]; out[k] = (unsigned short)(idx | (bk << 11)); }
            k += sel ? 1 : 0;
        }
        return;
    }
    int cgt = 0;
#pragma unroll
    for (int jj = 0; jj < NR; ++jj) cgt += __builtin_popcountll(__builtin_amdgcn_ballot_w64(keys[jj] > T));
    const int need = TOPK - cgt; int obase = 0, ebase = 0;
#pragma unroll
    for (int jj = 0; jj < NR; ++jj) {
        const bool gt = keys[jj] > T, eq = keys[jj] == T;
        const unsigned long long em = __builtin_amdgcn_ballot_w64(eq);
        const int erank = ebase + (int)__builtin_amdgcn_mbcnt_hi((unsigned)(em >> 32), __builtin_amdgcn_mbcnt_lo((unsigned)em, 0u));
        const bool sel = gt || (eq && erank < need);
        const unsigned long long sm = __builtin_amdgcn_ballot_w64(sel);
        const int opos = obase + (int)__builtin_amdgcn_mbcnt_hi((unsigned)(sm >> 32), __builtin_amdgcn_mbcnt_lo((unsigned)sm, 0u));
        if (sel) { const int idx = lane + 64 * jj; const int dist = pos - idx; const unsigned bk = dist >= 128 ? 31u : (unsigned)bkL[dist]; out[opos] = (unsigned short)(idx | (bk << 11)); }
        obase += __builtin_popcountll(sm); ebase += __builtin_popcountll(em);
    }
}
__device__ __forceinline__ void index_phase(const Frame& F, const Ptrs& P, int j) {
    LAS float* scb = (LAS float*)F.lds;
    LAS float* wiB = (LAS float*)(F.lds + 131072);
    LAS unsigned char* bkL = (LAS unsigned char*)(F.lds + 131072 + 4096);
    const bf16_t* QC = (const bf16_t*)(P.ws + WS_QC); bf16_t* CN = (bf16_t*)(P.ws + WS_CN); unsigned short* IDX = (unsigned short*)(P.ws + WS_IDX);
    const int lane = F.lane, w = F.wave, half = lane >> 5;
    if (F.tid < 128) { const int n = F.tid; int bk = n; if (n >= 16) { bk = 16 + (int)(logf((float)n / 16.0f) / 2.0794415416798357f * 16.0f); bk = bk > 31 ? 31 : bk; } bkL[n] = (unsigned char)bk; }
    __syncthreads();
    const int nunits = M / 8;
    const int ar = lane & 31, ahalf_r = (ar >> 2) & 1, areg_r = (ar & 3) + 4 * (ar >> 3), aq = 2 * ahalf_r + (areg_r >> 3), ah = areg_r & 7;
#define IDX_UNIT(i_) (((i_) * F.G < nunits) ? ((i_) * F.G + (((i_) & 1) ? (F.G - 1 - F.vcu) : F.vcu)) : -1)
#define IDX_OK(u_) ((u_) >= 0 && (u_) < nunits)
#define IDX_FETCH(u_, A_, cw_, wi_) do { const int T0_ = (u_) * 8; \
        cw_ = *(const unsigned*)(QC + ((size_t)T0_ + w) * NATT + QC_C + 2 * lane); \
        wi_ = QC[(size_t)(T0_ + (lane >> 3)) * NATT + QC_WI + (lane & 7)]; \
        _Pragma("unroll") for (int g = 0; g < 2; ++g) { const bf16_t* p_ = QC + (size_t)(T0_ + 4 * g + aq) * NATT + QC_QI + ah * 64 + 8 * half; \
            _Pragma("unroll") for (int s = 0; s < 4; ++s) A_[g][s] = *(const bf16x8*)(p_ + 16 * s); } } while (0)
#define IDX_SCORE(u_, par_, unext_) do { const int T0 = (u_) * 8, b = T0 >> 11, p0 = T0 & (SEQ - 1); \
        LAS float* sc = scb + (par_) * 16384; LAS float* wiL = wiB + ((par_) * 8 + w) * 64; \
        bf16x8 Af[2][4]; \
        _Pragma("unroll") for (int g = 0; g < 2; ++g) _Pragma("unroll") for (int s = 0; s < 4; ++s) Af[g][s] = An[g][s]; \
        const unsigned cw = cwn; wiL[lane] = bf2f(win); \
        if (IDX_OK(unext_)) IDX_FETCH(unext_, An, cwn, win); \
        { const size_t tok = (size_t)T0 + w; const float c0 = bflo(cw), c1 = bfhi(cw); \
          const float ss = wave_sum_f32_dpp(c0 * c0 + c1 * c1); const float rs = rsqrtf(ss * (1.0f / 128.0f) + EPS); const f32x2 gg = gg_lat; \
          *(unsigned*)(CN + tok * 128 + 2 * lane) = cvt_pk_bf16(c0 * rs * gg.x, c1 * rs * gg.y); } \
        LDS_WAIT(); asm volatile("" ::: "memory"); \
        const int nkt = (p0 + 8 + 31) >> 5; \
        for (int kt0 = w; kt0 < nkt; kt0 += 16) { \
            bf16x8 Bf[2][4]; \
            _Pragma("unroll") for (int bi = 0; bi < 2; ++bi) { const int kt = kt0 + 8 * bi; if (kt < nkt) { const bf16_t* kp = QC + ((size_t)b * SEQ + 32 * kt + (lane & 31)) * NATT + QC_KI + 8 * half; \
                _Pragma("unroll") for (int s4 = 0; s4 < 4; ++s4) Bf[bi][s4] = *(const bf16x8*)(kp + 16 * s4); } } \
            _Pragma("unroll") for (int bi = 0; bi < 2; ++bi) { const int kt = kt0 + 8 * bi; if (kt < nkt) { const int key = 32 * kt + (lane & 31); \
                _Pragma("unroll") for (int g = 0; g < 2; ++g) { \
                    f32x16 acc; \
                    _Pragma("unroll") for (int e = 0; e < 16; ++e) acc[e] = 0.f; \
                    _Pragma("unroll") for (int s4 = 0; s4 < 4; ++s4) acc = __builtin_amdgcn_mfma_f32_32x32x16_bf16(Af[g][s4], Bf[bi][s4], acc, 0, 0, 0); \
                    _Pragma("unroll") for (int e = 0; e < 2; ++e) { float sv = 0.f; const f32x4 wlo = *(const LAS f32x4*)(wiL + (4 * g + 2 * half + e) * 8), whi = *(const LAS f32x4*)(wiL + (4 * g + 2 * half + e) * 8 + 4); \
                        _Pragma("unroll") for (int h = 0; h < 4; ++h) { sv = fmaf(wlo[h], fmaxf(acc[8 * e + h], 0.f), sv); sv = fmaf(whi[h], fmaxf(acc[8 * e + 4 + h], 0.f), sv); } \
                        const int qi = 4 * g + 2 * half + e; \
                        sc[qi * 2048 + key] = (key <= p0 + qi) ? sv : -INFINITY; } \
                } } } \
        } } while (0)
    const f32x2 gg_lat = *(const f32x2*)(P.in[14] + (size_t)j * 128 + 2 * lane);
    bf16x8 An[2][4]; unsigned cwn = 0u; unsigned short win = 0;
    { const int u0 = IDX_UNIT(0); if (IDX_OK(u0)) { IDX_FETCH(u0, An, cwn, win); const int u1 = IDX_UNIT(1); IDX_SCORE(u0, 0, u1); } }
    __syncthreads();
    for (int i = 0;; ++i) {
        const int u = IDX_UNIT(i); if (u < 0) break;
        if (IDX_OK(u)) {
            const int T0 = u * 8, p0 = T0 & (SEQ - 1); const LAS float* sc = scb + (i & 1) * 16384;
            const int pos = p0 + w, n = pos + 1; unsigned short* out = IDX + (size_t)(T0 + w) * 256;
            if (n <= TOPK) {
#pragma unroll
                for (int jj = 0; jj < 4; ++jj) { const int s = lane + 64 * jj; const int dist = pos - s; const unsigned bk = (dist >= 0) ? (dist >= 128 ? 31u : (unsigned)bkL[dist]) : 0u;
                    out[s] = (s < n) ? (unsigned short)(s | (bk << 11)) : (unsigned short)0; }
            } else {
                const LAS float* scq = sc + w * 2048;
                if (n <= 512) idx_select<8>(scq, pos, lane, bkL, out); else if (n <= 1024) idx_select<16>(scq, pos, lane, bkL, out);
                else if (n <= 1536) idx_select<24>(scq, pos, lane, bkL, out); else idx_select<32>(scq, pos, lane, bkL, out);
            }
        }
        { const int un = IDX_UNIT(i + 1); if (IDX_OK(un)) { const int un2 = IDX_UNIT(i + 2); IDX_SCORE(un, (i + 1) & 1, un2); } }
        __syncthreads();
    }
#undef IDX_UNIT
#undef IDX_OK
#undef IDX_FETCH
#undef IDX_SCORE
}

__device__ __forceinline__ s16x4 tr_read(const LAS unsigned char* p) {
    typedef short v4i16_t __attribute__((ext_vector_type(4)));
    return __builtin_bit_cast(s16x4, __builtin_amdgcn_ds_read_tr16_b64_v4i16((LAS v4i16_t*)p));
}
struct AttState { float mrun, lrun; f32x4 O[8]; };
__device__ __forceinline__ float xmax16(float v) { const auto r = __builtin_amdgcn_permlane16_swap(__float_as_uint(v), __float_as_uint(v), false, false); return fmaxf(__uint_as_float(r[0]), __uint_as_float(r[1])); }
__device__ __forceinline__ float xmax32(float v) { const auto r = __builtin_amdgcn_permlane32_swap(__float_as_uint(v), __float_as_uint(v), false, false); return fmaxf(__uint_as_float(r[0]), __uint_as_float(r[1])); }
__device__ __forceinline__ float xsum16(float v) { const auto r = __builtin_amdgcn_permlane16_swap(__float_as_uint(v), __float_as_uint(v), false, false); return __uint_as_float(r[0]) + __uint_as_float(r[1]); }
__device__ __forceinline__ float xsum32(float v) { const auto r = __builtin_amdgcn_permlane32_swap(__float_as_uint(v), __float_as_uint(v), false, false); return __uint_as_float(r[0]) + __uint_as_float(r[1]); }
__device__ __forceinline__ void att_stage(const bf16x8 (&cf)[16], LAS unsigned char* V, int lane) {
    constexpr int VROW = 288;
#pragma unroll
    for (int i = 0; i < 16; ++i) *(LAS bf16x8*)(V + (16 * (lane >> 4) + i) * VROW + (lane & 15) * 16) = cf[i];
    asm volatile("" ::: "memory");
}
__device__ __forceinline__ void att_qk(const bf16x8 (&qf)[4], f32x4 (&S)[4], const LAS unsigned char* V, int lane, int g) {
    constexpr int VROW = 288;
    const LAS unsigned char* ab = V + (lane & 15) * VROW + 16 * g;
#pragma unroll
    for (int t = 0; t < 4; ++t) { S[t] = (f32x4){0.f, 0.f, 0.f, 0.f};
#pragma unroll
        for (int ks = 0; ks < 4; ++ks) { const bf16x8 af = *(const LAS bf16x8*)(ab + 16 * t * VROW + 64 * ks); S[t] = __builtin_amdgcn_mfma_f32_16x16x32_bf16(af, qf[ks], S[t], 0, 0, 0); } }
}
template <bool MASKED>
__device__ __forceinline__ void att_sm_pv(const f32x4 (&S)[4], int s, int cnt, AttState& st, const LAS unsigned short* listL, const LAS float* biasL, const LAS unsigned char* trbase, int head, int g) {
    constexpr int VROW = 288; constexpr float L2E = 1.44269504089f;
    float val[4][4]; float cmax = -INFINITY;
#pragma unroll
    for (int t = 0; t < 4; ++t) { const u16x4 pk4 = *(const LAS u16x4*)(listL + 64 * s + 16 * t + 4 * g);
#pragma unroll
        for (int r = 0; r < 4; ++r) { const float bias = *(const LAS float*)((const LAS unsigned char*)biasL + ((pk4[r] >> 5) & 0x7C0u) + head * 4);
            float v = S[t][r] + bias; if (MASKED) v = (64 * s + 16 * t + 4 * g + r < cnt) ? v : -INFINITY; val[t][r] = v; cmax = fmaxf(cmax, v); } }
    cmax = xmax32(xmax16(cmax));
    const float mnew = fmaxf(st.mrun, cmax), mneg = -mnew * L2E;
    const float alpha = __builtin_amdgcn_exp2f(fmaf(st.mrun, L2E, mneg));
    float p[4][4]; float psum = 0.f;
#pragma unroll
    for (int t = 0; t < 4; ++t)
#pragma unroll
        for (int r = 0; r < 4; ++r) { p[t][r] = __builtin_amdgcn_exp2f(fmaf(val[t][r], L2E, mneg)); psum += p[t][r]; }
    psum = xsum32(xsum16(psum));
    const bool moved = __builtin_amdgcn_ballot_w64(mnew > st.mrun) != 0ull;
    st.lrun = st.lrun * alpha + psum; st.mrun = mnew;
    if (moved) {
#pragma unroll
        for (int dt = 0; dt < 8; ++dt) st.O[dt] = st.O[dt] * alpha; }
    union { bf16x8 v; unsigned u[4]; } pf[2];
#pragma unroll
    for (int hh = 0; hh < 2; ++hh) { pf[hh].u[0] = cvt_pk_bf16(p[2 * hh][0], p[2 * hh][1]); pf[hh].u[1] = cvt_pk_bf16(p[2 * hh][2], p[2 * hh][3]); pf[hh].u[2] = cvt_pk_bf16(p[2 * hh + 1][0], p[2 * hh + 1][1]); pf[hh].u[3] = cvt_pk_bf16(p[2 * hh + 1][2], p[2 * hh + 1][3]); }
#pragma unroll
    for (int dt = 0; dt < 8; ++dt)
#pragma unroll
        for (int hh = 0; hh < 2; ++hh) {
            union { bf16x8 v; s16x4 h[2]; } vf;
            vf.h[0] = tr_read(trbase + hh * 32 * VROW + dt * 32); vf.h[1] = tr_read(trbase + (hh * 32 + 16) * VROW + dt * 32);
            st.O[dt] = __builtin_amdgcn_mfma_f32_16x16x32_bf16(vf.v, pf[hh].v, st.O[dt], 0, 0, 0);
        }
    asm volatile("" ::: "memory");
}
__device__ __forceinline__ void attn_phase(const Frame& F, const Ptrs& P, bool dry = false) {
    constexpr int VROW = 288, VBYTES = 64 * VROW;
    LAS unsigned char* V = F.lds + F.wave * VBYTES;
    LAS unsigned short* listL = (LAS unsigned short*)(F.lds + 8 * VBYTES + F.wave * 512);
    LAS float* biasL = (LAS float*)(F.lds + 8 * VBYTES + 8 * 512);
    static_assert(8 * VBYTES + 8 * 512 + 2048 <= MISC_OFF, "attention LDS map");
    bf16_t* QC = (bf16_t*)(P.ws + WS_QC); const bf16_t* CN = (const bf16_t*)(P.ws + WS_CN); const unsigned short* IDX = (const unsigned short*)(P.ws + WS_IDX);
    const int lane = F.lane, head = lane & 15, g = lane >> 4;
    if (F.tid < 512) biasL[F.tid] = P.in[18][F.tid];
    __syncthreads();
    const int gw = F.vcu * NWAVES + F.wave, NGW = F.G * NWAVES;
    const int trq = (lane & 15) >> 2, trp = lane & 3;
    const LAS unsigned char* trbase = V + (4 * g + trq) * VROW + 8 * trp;
#define ATT_LOAD(buf, ss) do { const u32x4 l0_ = *(const LAS u32x4*)(listL + 64 * (ss) + 16 * (lane >> 4)), l1_ = *(const LAS u32x4*)(listL + 64 * (ss) + 16 * (lane >> 4) + 8); \
        _Pragma("unroll") for (int i = 0; i < 16; ++i) { const unsigned w_ = (i < 8) ? l0_[(i & 7) >> 1] : l1_[(i & 7) >> 1]; const unsigned pk = (i & 1) ? (w_ >> 16) : (w_ & 0xffffu); \
            buf[i] = *(const bf16x8*)(cnb + (((pk & 2047u) << 8) + (unsigned)(lane & 15) * 16u)); } } while (0)
#define ATT_TOKEN(k_) ((k_) * NGW + ((gw + 256 * (k_)) % NGW))
    unsigned long long lstn = 0ull; bf16x8 qfn[4];
    if (ATT_TOKEN(0) < M) { const int t0_ = ATT_TOKEN(0); lstn = *(const unsigned long long*)(IDX + (size_t)t0_ * 256 + 4 * lane); const bf16_t* qp = QC + (size_t)t0_ * NATT + head * 128 + 8 * g;
#pragma unroll
        for (int ks = 0; ks < 4; ++ks) qfn[ks] = *(const bf16x8*)(qp + 32 * ks); }
    for (int kr = 0; kr * NGW < M; ++kr) {
        const int token = ATT_TOKEN(kr); if (token >= M) break;
        const int b = token >> 11, pos = token & (SEQ - 1), cnt = pos + 1 < TOPK ? pos + 1 : TOPK, nstep = (cnt + 63) >> 6;
        asm volatile("" ::: "memory");
        *(LAS unsigned long long*)(listL + 4 * lane) = lstn;
        asm volatile("" ::: "memory");
        bf16x8 qf[4];
#pragma unroll
        for (int ks = 0; ks < 4; ++ks) qf[ks] = qfn[ks];
        const char* cnb = (const char*)(CN + (size_t)__builtin_amdgcn_readfirstlane(b) * SEQ * 128);
        bf16x8 cf[16];
        ATT_LOAD(cf, 0);
        { const int nt_ = ((kr + 1) * NGW < M) ? ATT_TOKEN(kr + 1) : M; if (nt_ < M) { lstn = *(const unsigned long long*)(IDX + (size_t)nt_ * 256 + 4 * lane); const bf16_t* qp = QC + (size_t)nt_ * NATT + head * 128 + 8 * g;
#pragma unroll
            for (int ks = 0; ks < 4; ++ks) qfn[ks] = *(const bf16x8*)(qp + 32 * ks); } }
        AttState st; st.mrun = -INFINITY; st.lrun = 0.f;
#pragma unroll
        for (int dt = 0; dt < 8; ++dt) st.O[dt] = (f32x4){0.f, 0.f, 0.f, 0.f};
        for (int s = 0; s < nstep; ++s) {
            f32x4 S[4];
            att_stage(cf, V, lane);
            if (s + 1 < nstep) ATT_LOAD(cf, s + 1);
            att_qk(qf, S, V, lane, g);
            if (64 * (s + 1) > cnt) att_sm_pv<true>(S, s, cnt, st, listL, biasL, trbase, head, g); else att_sm_pv<false>(S, s, cnt, st, listL, biasL, trbase, head, g);
        }
        const float inv = 1.0f / st.lrun;
        bf16_t* op = QC + (size_t)token * NATT + head * 128 + 4 * g;
        if (dry) { asm volatile("" :: "v"(st.O[0]), "v"(st.O[7]), "v"(inv)); bf16_t* qp = QC + (size_t)token * NATT + head * 128 + 8 * g;
#pragma unroll
            for (int ks = 0; ks < 4; ++ks) *(bf16x8*)(qp + 32 * ks) = qf[ks]; continue; }
#pragma unroll
        for (int dt = 0; dt < 8; ++dt) { u32x2 wv; wv.x = cvt_pk_bf16(st.O[dt][0] * inv, st.O[dt][1] * inv); wv.y = cvt_pk_bf16(st.O[dt][2] * inv, st.O[dt][3] * inv); *(u32x2*)(op + 16 * dt) = wv; }
    }
#undef ATT_LOAD
#undef ATT_TOKEN
}


#ifndef NAIVE_IDX
#define NAIVE_IDX 0
#endif
#ifndef NAIVE_ATT
#define NAIVE_ATT 0
#endif
__device__ __forceinline__ void naive_index_phase(const Frame& F, const Ptrs& P, int j) {
    LAS float* sc = (LAS float*)F.lds;
    LAS float* qiL = sc + 2048;
    LAS float* wL = qiL + 512;
    LAS int* cntL = (LAS int*)(wL + 8);
    LAS unsigned char* bkL = (LAS unsigned char*)(cntL + 520);
    const bf16_t* QC = (const bf16_t*)(P.ws + WS_QC); bf16_t* CN = (bf16_t*)(P.ws + WS_CN); unsigned short* IDX = (unsigned short*)(P.ws + WS_IDX);
    const int tid = F.tid;
    if (tid < 128) { const int n = tid; int bk = n; if (n >= 16) { bk = 16 + (int)(logf((float)n / 16.0f) / 2.0794415416798357f * 16.0f); bk = bk > 31 ? 31 : bk; } bkL[n] = (unsigned char)bk; }
    __syncthreads();
    for (int tok = F.vcu; tok < M; tok += F.G) {
        const int b = tok >> 11, pos = tok & (SEQ - 1), n = pos + 1;
        if (tid < 64) {
            const unsigned cw = *(const unsigned*)(QC + (size_t)tok * NATT + QC_C + 2 * tid); const float c0 = bflo(cw), c1 = bfhi(cw);
            const float ss = wave_sum(c0 * c0 + c1 * c1); const float rs = rsqrtf(ss * (1.0f / 128.0f) + EPS); const float* g = P.in[14] + (size_t)j * 128 + 2 * tid;
            *(unsigned*)(CN + (size_t)tok * 128 + 2 * tid) = cvt_pk_bf16(c0 * rs * g[0], c1 * rs * g[1]);
        }
        qiL[tid] = bf2f(QC[(size_t)tok * NATT + QC_QI + tid]);
        if (tid < 8) wL[tid] = bf2f(QC[(size_t)tok * NATT + QC_WI + tid]);
        __syncthreads();
        for (int key = tid; key < SEQ; key += NTHREADS) {
            float s = -INFINITY;
            if (key <= pos) { const bf16_t* kp = QC + ((size_t)b * SEQ + key) * NATT + QC_KI; s = 0.f;
                for (int h = 0; h < 8; ++h) { float d = 0.f; for (int e = 0; e < 64; ++e) d = fmaf(qiL[h * 64 + e], bf2f(kp[e]), d); s = fmaf(wL[h], fmaxf(d, 0.f), s); }
                s = s + 0.0f; }
            sc[key] = s;
        }
        __syncthreads();
        unsigned short* out = IDX + (size_t)tok * 256;
        if (n <= TOPK) { if (tid < 256) { const int dist = pos - tid; const unsigned bk = (dist >= 0) ? (dist >= 128 ? 31u : (unsigned)bkL[dist]) : 0u; out[tid] = (tid < n) ? (unsigned short)(tid | (bk << 11)) : (unsigned short)0; } }
        else {
            bool sel[4]; int mycnt = 0;
            for (int e = 0; e < 4; ++e) { const int i = tid * 4 + e; sel[e] = false;
                if (i <= pos) { const float si = sc[i]; int rank = 0; for (int jx = 0; jx <= pos; ++jx) { const float sj = sc[jx]; rank += (sj > si || (sj == si && jx < i)) ? 1 : 0; } sel[e] = rank < TOPK; }
                mycnt += sel[e] ? 1 : 0; }
            cntL[tid] = mycnt;
            __syncthreads();
            int basep = 0; for (int t2 = 0; t2 < tid; ++t2) basep += cntL[t2];
            for (int e = 0; e < 4; ++e) if (sel[e]) { const int i = tid * 4 + e; const int dist = pos - i; const unsigned bk = dist >= 128 ? 31u : (unsigned)bkL[dist]; out[basep++] = (unsigned short)(i | (bk << 11)); }
        }
        __syncthreads();
    }
}
__device__ __forceinline__ void naive_attn_phase(const Frame& F, const Ptrs& P) {
    bf16_t* QC = (bf16_t*)(P.ws + WS_QC); const bf16_t* CN = (const bf16_t*)(P.ws + WS_CN); const unsigned short* IDX = (const unsigned short*)(P.ws + WS_IDX);
    LAS float* pL = (LAS float*)(F.lds + F.wave * 4096);
    LAS int* kL = (LAS int*)(pL + 256);
    LAS float* oL = (LAS float*)(kL + 256);
    const int lane = F.lane, gw = F.vcu * NWAVES + F.wave, NGW = F.G * NWAVES;
    for (int token = gw; token < M; token += NGW) {
        const int b = token >> 11, pos = token & (SEQ - 1), cnt = pos + 1 < TOPK ? pos + 1 : TOPK;
        float qv[16][2];
#pragma unroll
        for (int h = 0; h < 16; ++h) { qv[h][0] = bf2f(QC[(size_t)token * NATT + h * 128 + lane]); qv[h][1] = bf2f(QC[(size_t)token * NATT + h * 128 + 64 + lane]); }
        for (int s = lane; s < 256; s += 64) kL[s] = IDX[(size_t)token * 256 + s];
        LDS_WAIT(); asm volatile("" ::: "memory");
#pragma unroll
        for (int h = 0; h < 16; ++h) {
            float mx = -INFINITY;
            for (int s = 0; s < cnt; ++s) { const int pk = kL[s]; const bf16_t* cp = CN + ((size_t)b * SEQ + (pk & 2047)) * 128;
                float d = qv[h][0] * bf2f(cp[lane]) + qv[h][1] * bf2f(cp[64 + lane]); d = wave_sum(d);
                d += P.in[18][(pk >> 11) * 16 + h]; if (lane == 0) pL[s] = d; mx = fmaxf(mx, d); }
            LDS_WAIT(); asm volatile("" ::: "memory");
            float sum = 0.f; for (int s = 0; s < cnt; ++s) sum += __expf(pL[s] - mx);
            float o0 = 0.f, o1 = 0.f;
            for (int s = 0; s < cnt; ++s) { const int pk = kL[s]; const bf16_t* cp = CN + ((size_t)b * SEQ + (pk & 2047)) * 128; const float p = __expf(pL[s] - mx) / sum;
                o0 = fmaf(p, bf2f(cp[lane]), o0); o1 = fmaf(p, bf2f(cp[64 + lane]), o1); }
            QC[(size_t)token * NATT + h * 128 + lane] = (bf16_t)(cvt_pk_bf16(o0, 0.f) & 0xffffu); QC[(size_t)token * NATT + h * 128 + 64 + lane] = (bf16_t)(cvt_pk_bf16(o1, 0.f) & 0xffffu);
            asm volatile("" ::: "memory");
        }
    }
}


#ifndef MK_DEBUG_CHECKS
#define MK_DEBUG_CHECKS 0
#endif
#if MK_DEBUG_CHECKS
constexpr size_t WS_DIAG = 224 * MiB, WS_SAVE = 225 * MiB, WS_SAVEG = 226 * MiB, WS_TMPO = 227 * MiB;
constexpr int NS = 256;
__device__ __forceinline__ int srow(int s) { return ((s & 63) << 8) | ((s * 37 + 11) & 255); }
__device__ __forceinline__ float diag_err(float mine, float ref) { float e = fabsf(mine - ref) / (fabsf(ref) + 0.25f); if (!(e == e)) e = 1e9f; return e; }
__device__ __forceinline__ void diag_max(unsigned char* ws, int id, float e) {
    for (int o = 1; o < 64; o <<= 1) e = fmaxf(e, __shfl_xor(e, o));
    if ((threadIdx.x & 63) == 0) atomicMax((unsigned*)(ws + WS_DIAG) + id, __float_as_uint(e));
}
__device__ __forceinline__ void diag_put(unsigned char* ws, int id, float mine, float ref) { diag_max(ws, id, diag_err(mine, ref)); }
__device__ __forceinline__ float d_rs(const unsigned char* ws, int row) { const float* p = (const float*)(ws + WS_SSQ) + (size_t)row * 16; float s = 0.f; for (int i = 0; i < 16; ++i) s += p[i]; return rsqrtf(s / 1024.f + EPS); }
__device__ __forceinline__ float d_bf(const unsigned char* ws, size_t off, size_t idx) { return bf2f(((const bf16_t*)(ws + off))[idx]); }
__global__ void chk_zero(unsigned char* ws) { if (threadIdx.x < 64) ((unsigned*)(ws + WS_DIAG))[threadIdx.x] = 0u; }
__global__ void chk_save_rows(unsigned char* ws, const float* src) { const int s = blockIdx.x; float* d = (float*)(ws + WS_SAVE) + s * 1024; for (int c = threadIdx.x; c < 1024; c += blockDim.x) d[c] = src[(size_t)srow(s) * D + c]; }
__global__ void chk_proj(unsigned char* ws, int id, size_t off_a, int lda, const float* W, int ldw, const float* gam, int K, int N, size_t off_o, int ldo, int mode) {
    const int s = blockIdx.y, row = srow(s), col = blockIdx.x * blockDim.x + threadIdx.x;
    float acc = 0.f; for (int k = 0; k < K; ++k) acc = fmaf(d_bf(ws, off_a, (size_t)row * lda + k) * (gam ? gam[k] : 1.f), W[(size_t)k * ldw + col], acc);
    acc *= d_rs(ws, row);
    if (mode == 1 && col < 1024) acc = 0.5f * acc * (1.f + tanhf(0.7978845608f * (acc + 0.044715f * acc * acc * acc)));
    if (mode == 2) { acc = fmaxf(acc, 0.f); acc *= acc; }
    diag_put(ws, id, d_bf(ws, off_o, (size_t)row * ldo + col), acc);
}
__global__ void chk_res(unsigned char* ws, int id, size_t off_a, int lda, const float* W, int K, const float* outp, const float* xold_full) {
    const int s = blockIdx.y, row = srow(s), col = blockIdx.x * blockDim.x + threadIdx.x;
    float acc = 0.f; for (int k = 0; k < K; ++k) acc = fmaf(d_bf(ws, off_a, (size_t)row * lda + k), W[(size_t)k * D + col], acc);
    const float xo = xold_full ? xold_full[(size_t)row * D + col] : ((const float*)(ws + WS_SAVE))[s * 1024 + col];
    diag_put(ws, id, outp[(size_t)row * D + col], xo + acc);
    diag_put(ws, id, d_bf(ws, WS_XB, (size_t)row * D + col), xo + acc);
}
__global__ void chk_ssq(unsigned char* ws, int id, const float* outp) {
    const int s = blockIdx.x * blockDim.x + threadIdx.x; const int row = srow(s); float q = 0.f; for (int c = 0; c < D; ++c) { const float v = outp[(size_t)row * D + c]; q += v * v; }
    const float* p = (const float*)(ws + WS_SSQ) + (size_t)row * 16; float t = 0.f; for (int i = 0; i < 16; ++i) t += p[i]; diag_put(ws, id, t, q);
}
__global__ void chk_conv(unsigned char* ws, int id, const float* cw, const float* cb) {
    const int s = blockIdx.y, row = srow(s) & ~3 | (s & 3) * 0, ch = blockIdx.x * blockDim.x + threadIdx.x;
    const int rr = (s < 16) ? ((s >> 1) * SEQ + (s & 1) * 256 * 3 + (s & 3)) : srow(s); const int pos = rr & (SEQ - 1);
    float acc = cb[ch]; for (int k = 0; k < 4; ++k) { const int p = pos - 3 + k; if (p >= 0) acc += cw[k * D + ch] * d_bf(ws, WS_GX, (size_t)(rr - 3 + k) * 2048 + 1024 + ch); }
    diag_put(ws, id, d_bf(ws, WS_XC, (size_t)rr * D + ch), acc);
}
__global__ void chk_gates(unsigned char* ws, int id, const float* wa, const float* ba, const float* wx, const float* bx) {
    const int s = blockIdx.y, row = srow(s), ch = blockIdx.x * blockDim.x + threadIdx.x, blk = ch >> 8, i = ch & 255;
    float a = ba[ch], x = bx[ch]; for (int jx = 0; jx < 256; ++jx) { const float v = d_bf(ws, WS_XC, (size_t)row * D + blk * 256 + jx); a = fmaf(v, wa[(size_t)blk * 65536 + jx * 256 + i], a); x = fmaf(v, wx[(size_t)blk * 65536 + jx * 256 + i], x); }
    diag_put(ws, id, d_bf(ws, WS_RB, (size_t)row * D + ch), 1.f / (1.f + expf(-a))); diag_put(ws, id, d_bf(ws, WS_IB, (size_t)row * D + ch), 1.f / (1.f + expf(-x)));
}
__global__ void chk_save_gate(unsigned char* ws) {
    const int p = blockIdx.x, b = p & 7, ch = (p * 61 + 5) & 1023; bf16_t* d = (bf16_t*)(ws + WS_SAVEG) + p * 2048;
    for (int t = threadIdx.x; t < SEQ; t += blockDim.x) d[t] = ((const bf16_t*)(ws + WS_GX))[((size_t)b * SEQ + t) * 2048 + ch];
}
__global__ void chk_scan(unsigned char* ws, int id, const float* lam) {
    const int p = blockIdx.x * blockDim.x + threadIdx.x; const int b = p & 7, ch = (p * 61 + 5) & 1023;
    const float sp = -8.f * log1pf(expf(-lam[ch])); float h = 0.f, em = 0.f;
    for (int t = 0; t < SEQ; ++t) { const size_t r = (size_t)b * SEQ + t; const float rr = d_bf(ws, WS_RB, r * D + ch), ii = d_bf(ws, WS_IB, r * D + ch), xc = d_bf(ws, WS_XC, r * D + ch);
        const float la = sp * rr, a = expf(la), u = sqrtf(-expm1f(2.f * la)) * (ii * xc); h = a * h + u;
        const float g = bf2f(((const bf16_t*)(ws + WS_SAVEG))[p * 2048 + t]); em = fmaxf(em, diag_err(d_bf(ws, WS_GX, r * 2048 + ch), h * g)); }
    diag_max(ws, id, em);
}
__global__ void chk_att_in(unsigned char* ws, int id, const float* Win, const float* wuk, const float* gam) {
    const int s = blockIdx.y, row = srow(s), col = blockIdx.x * blockDim.x + threadIdx.x;
    const float rs = d_rs(ws, row); float ref = 0.f;
    if (col < 2048) { const int h = col >> 7, c = col & 127;
        for (int d = 0; d < 64; ++d) { float q = 0.f; for (int k = 0; k < D; ++k) q = fmaf(d_bf(ws, WS_XB, (size_t)row * D + k) * gam[k], Win[(size_t)k * ATT_IN + h * 64 + d], q); ref = fmaf(q, wuk[((size_t)h * 64 + d) * 128 + c], ref); }
        ref *= rs * 0.125f; }
    else if (col < 2760) { const int wc = 1024 + (col - 2048); for (int k = 0; k < D; ++k) ref = fmaf(d_bf(ws, WS_XB, (size_t)row * D + k) * gam[k], Win[(size_t)k * ATT_IN + wc], ref); ref *= rs * (col >= 2752 ? 0.044194173824159216f : 1.f); }
    diag_put(ws, id, d_bf(ws, WS_QC, (size_t)row * NATT + col), ref);
}
__global__ void chk_cn(unsigned char* ws, int id, const float* g) {
    const int s = blockIdx.x, row = srow(s), c = threadIdx.x; float ss = 0.f; for (int e = 0; e < 128; ++e) { const float v = d_bf(ws, WS_QC, (size_t)row * NATT + QC_C + e); ss += v * v; }
    diag_put(ws, id, d_bf(ws, WS_CN, (size_t)row * 128 + c), d_bf(ws, WS_QC, (size_t)row * NATT + QC_C + c) * rsqrtf(ss / 128.f + EPS) * g[c]);
}
__global__ void chk_att_o(unsigned char* ws, const float* wuv) {
    const int s = blockIdx.y, row = srow(s), n = blockIdx.x * blockDim.x + threadIdx.x, h = n >> 6, v = n & 63; float a = 0.f;
    for (int c = 0; c < 128; ++c) a = fmaf(d_bf(ws, WS_QC, (size_t)row * NATT + h * 128 + c), wuv[((size_t)h * 128 + c) * 64 + v], a);
    ((float*)(ws + WS_TMPO))[s * 1024 + n] = a;
}
__global__ void chk_att_out(unsigned char* ws, int id, const float* wo, const float* outp) {
    const int s = blockIdx.y, row = srow(s), col = blockIdx.x * blockDim.x + threadIdx.x; float a = 0.f;
    for (int k = 0; k < 1024; ++k) a = fmaf(((const float*)(ws + WS_TMPO))[s * 1024 + k], wo[(size_t)k * D + col], a);
    diag_put(ws, id, outp[(size_t)row * D + col], ((const float*)(ws + WS_SAVE))[s * 1024 + col] + a);
}
__global__ void chk_report(unsigned char* ws, float* outp) {
    if (threadIdx.x == 0) { const unsigned* dg = (const unsigned*)(ws + WS_DIAG); for (int id = 1; id < 40; ++id) { const float e = __uint_as_float(dg[id]); if (e > 0.1f) { outp[0] = 100.f * id + 10.f; break; } } }
}
#endif


#ifndef MK_DETCHECK
#define MK_DETCHECK 0
#endif
#if MK_DETCHECK
constexpr size_t WS_CKS = 230 * MiB;
__global__ void cks_zero(unsigned* d) { d[threadIdx.x] = 0u; }
__global__ void lds_poison(unsigned pat) { extern __shared__ unsigned lp[]; for (int i = threadIdx.x; i < LDS_BYTES / 4; i += blockDim.x) lp[i] = pat; __syncthreads(); if (lp[threadIdx.x] != pat) asm volatile("s_nop 0"); }
__global__ void cks_kernel(const unsigned* p, size_t nwords, unsigned* dst) {
    unsigned a = 0u; for (size_t i = (size_t)blockIdx.x * blockDim.x + threadIdx.x; i < nwords; i += (size_t)gridDim.x * blockDim.x) a += p[i] * 2654435761u + (unsigned)i;
    for (int o = 1; o < 64; o <<= 1) a += __shfl_xor(a, o);
    if ((threadIdx.x & 63) == 0) atomicAdd(dst, a);
}
__global__ void cks_report(const unsigned* d, float* outp) { if (threadIdx.x == 0) for (int ph = 0; ph < 64; ++ph) if (d[ph] != d[64 + ph]) { outp[0] = 100.f * (ph + 1) + 10.f; break; } }
#endif

constexpr int N_PHASES = 28;
#ifndef MK_PER_PHASE
#define MK_PER_PHASE 0
#endif

__global__ void __launch_bounds__(NTHREADS, 2) trunk_fwd(Args args) {
    extern __shared__ __attribute__((aligned(16))) unsigned char lds_raw[];
    Frame F0;
    F0.lds = (LAS unsigned char*)lds_raw;
    F0.tid = threadIdx.x; F0.lane = F0.tid & 63; F0.wave = __builtin_amdgcn_readfirstlane(F0.tid >> 6);
    F0.G = gridDim.x; F0.bid = blockIdx.x; { const int bx = blockIdx.x; F0.vcu = (F0.G % 8 == 0) ? (bx % 8) * (F0.G / 8) + bx / 8 : bx; }
    volatile LAS unsigned* MISC = (volatile LAS unsigned*)(F0.lds + MISC_OFF);
    for (int u = F0.tid; u < (LDS_BYTES - LDSCTL_OFF) / 4; u += NTHREADS) ((LAS unsigned*)(F0.lds + LDSCTL_OFF))[u] = 0u;
    __syncthreads();
    unsigned* barw = (unsigned*)(args.ws + WS_CTL) + CW_BAR;
    XcdBarrier bar; bar.bar = barw; bar.x = 0; bar.st = nullptr;
    if (!MK_PER_PHASE) bar = xcd_barrier_post(barw, MISC + 8);
    const int lo = args.ph_lo, hi = args.ph_hi;
#ifndef PHMASK
#define PHMASK 0xFFFFu
#endif
#define PM(b) ((PHMASK >> (b)) & 1u)

#define IN(k) (lo <= (k) && (k) < hi)
#define SEAM(k) do { if (IN(k) && IN((k) + 1)) xcd_barrier(bar); } while (0)

#define PHASE_PTRS const Frame F = launder(F0); const Ptrs P = load_ptrs(); bf16_t* XB = (bf16_t*)(P.ws + WS_XB); float* SSQ = (float*)(P.ws + WS_SSQ); float* SSQM = (float*)(P.ws + WS_SSQM); \
    bf16_t* WM = (bf16_t*)(P.ws + WS_WMIX); bf16_t* WA = (bf16_t*)(P.ws + WS_WATT); bf16_t* WUP = (bf16_t*)(P.ws + WS_WUP); bf16_t* WDN = (bf16_t*)(P.ws + WS_WDOWN); \
    (void)XB; (void)SSQ; (void)SSQM; (void)WM; (void)WA; (void)WUP; (void)WDN

    if (PM(0) && IN(0)) { PHASE_PTRS; if (DB(0)) { cvt_att_mix(F, P, 0, 1); cvt_rec_mix(F, P, 0, 0); cvt_up(F, P, 0); cvt_down(F, P, 0); p0_rows(F, P); __syncthreads(); } cvt_att_mix(F, P, 0, 1, 0); cvt_att_mix(F, P, 1, 3, 1024); cvt_rec_mix(F, P, 0, 0); cvt_up(F, P, 0); cvt_down(F, P, 0); p0_rows(F, P); }
    SEAM(0);

    for (int L = 0; L < DEPTH; ++L) {
        const int pb = 1 + 7 * ((L + 1) >> 1) + 6 * (L >> 1), j = L >> 1, mo = (L & 1) ? 0 : 1;
        if ((L & 1) == 0) {
            if (PM(1) && IN(pb)) { PHASE_PTRS;
                { const Frame& F1 = F; (void)F1;
                pg8::Gemm g{XB, WM, D, D, D, -1}; pg8::StaticOrder S; S.init(M, 2048, F.G, F.bid);
                pg8::EpiScale<1> E{(bf16_t*)(P.ws + WS_GX), 2048, SSQ};
                if (DB(1)) pg8::gemm_phase(F.lds, F.tid, g, S, E);
                pg8::gemm_phase(F.lds, F.tid, g, S, E); } }
            SEAM(pb);
            if (PM(2) && IN(pb + 1)) { PHASE_PTRS;
                for (int rep = 0; rep < (DB(2) ? 2 : 1); ++rep) for (int p = F.vcu; p < 256; p += F.G) conv_tile(F, P, j, p >> 2, p & 3);
                if (L > 0) cvt_down(F, P, L); }
            SEAM(pb + 1);
            if (PM(2) && IN(pb + 2)) { PHASE_PTRS;
                pg8::Gemm g{(const bf16_t*)(P.ws + WS_XC), WM + WM_REC_GATE, D, D, 256, 3}; pg8::StaticOrder S; S.init(M, 2048, F.G, F.bid);
                pg8::EpiGate E{(bf16_t*)(P.ws + WS_RB), (bf16_t*)(P.ws + WS_IB), P.in[8] + (size_t)j * D, P.in[10] + (size_t)j * D};
                pg8::gemm_phase(F.lds, F.tid, g, S, E); }
            SEAM(pb + 2);
            if (PM(3) && IN(pb + 3)) { PHASE_PTRS; if (DB(3)) { scan_phase(F, P, j, true); __syncthreads(); } if (L > 0) { cvt_up(F, P, L); __syncthreads(); } scan_phase(F, P, j); }
            SEAM(pb + 3);
            if (PM(4) && IN(pb + 4)) { PHASE_PTRS;
                pg8::Gemm g{(const bf16_t*)(P.ws + WS_GX), WM + WM_REC_OUT, 2048, D, D, -1}; pg8::StaticOrder S; S.init(M, D, F.G, F.bid);
                pg8::EpiRes<false> E{XB, SSQM, nullptr};
                pg8::gemm_phase(F.lds, F.tid, g, S, E); }
            SEAM(pb + 4);
        } else {
            if (PM(5) && IN(pb)) { PHASE_PTRS;
                { const Frame& F1 = F; (void)F1;
                pg8::Gemm g{XB, WA + (size_t)j * 5 * MiB, D, D, D, -1}; pg8::StaticOrder S; S.init(M, NATT, F.G, F.bid);
                pg8::EpiScale<0> E{(bf16_t*)(P.ws + WS_QC), NATT, SSQ};
                pg8::gemm_phase(F.lds, F.tid, g, S, E); } }
            SEAM(pb);
            if (PM(6) && IN(pb + 1)) { PHASE_PTRS; cvt_down(F, P, L); if (L + 1 < DEPTH) cvt_rec_mix(F, P, (L + 1) >> 1, L + 1); __syncthreads(); if (DB(6)) { index_phase(F, P, j); __syncthreads(); } if (NAIVE_IDX) naive_index_phase(F, P, j); else index_phase(F, P, j); }
            SEAM(pb + 1);
            if (PM(7) && IN(pb + 2)) { PHASE_PTRS; cvt_up(F, P, L); __syncthreads(); if (DB(7)) { attn_phase(F, P, true); __syncthreads(); } if (NAIVE_ATT) naive_attn_phase(F, P); else attn_phase(F, P); }
            SEAM(pb + 2);
            if (PM(8) && IN(pb + 3)) { PHASE_PTRS;
                pg8::Gemm g{(const bf16_t*)(P.ws + WS_QC), WA + (size_t)j * 5 * MiB + WM_ATT_COMB, NATT, 2048, 2048, -1}; pg8::StaticOrder S; S.init(M, D, F.G, F.bid);
                pg8::EpiRes<false> E{XB, SSQM, nullptr};
                pg8::gemm_phase(F.lds, F.tid, g, S, E); }
            SEAM(pb + 3);
        }
        if (PM(9) && IN(pb + 4 + mo)) { PHASE_PTRS;
            { const Frame& F1 = F; (void)F1;
            pg8::Gemm g{XB, WUP, D, D, D, -1}; pg8::StaticOrder S; S.init(M, FF, F.G, F.bid);
            pg8::EpiScale<2> E{(bf16_t*)(P.ws + WS_H), FF, nullptr};
            if (DB(9)) pg8::gemm_phase(F.lds, F.tid, g, S, E);
            pg8::gemm_phase(F.lds, F.tid, g, S, E); } }
        SEAM(pb + 4 + mo);
        if (PM(10) && IN(pb + 5 + mo)) { PHASE_PTRS;
            { const Frame& F1 = F; (void)F1;
            pg8::Gemm g{(const bf16_t*)(P.ws + WS_H), WDN, FF, FF, FF, -1}; pg8::StaticOrder S; S.init(M, D, F.G, F.bid);
            pg8::EpiRes<true> E{XB, SSQ, SSQM};
            pg8::gemm_phase(F.lds, F.tid, g, S, E); } }
        SEAM(pb + 5 + mo);
    }
    if (PM(11) && IN(27)) { PHASE_PTRS; if (DB(11)) final_norm(F, P, true); final_norm(F, P); }
#undef IN
#undef SEAM
}

extern "C" void kernel_launch(void* const* d_in, const int* in_sizes, int n_in, void* d_out, int out_size, void* d_ws, size_t ws_size, hipStream_t stream) {
    static int grid = 0;
    if (grid == 0) {
        if (n_in != 21 || in_sizes[0] != M * D || out_size != M * D || ws_size < WS_END) { fprintf(stderr, "kernel_launch: unexpected shapes (n_in %d, in0 %d, out %d, ws %zu)\n", n_in, n_in > 0 ? in_sizes[0] : -1, out_size, ws_size); grid = -1; return; }
        int dev = 0, cus = 0, per_cu = 0;
        if (hipGetDevice(&dev) != hipSuccess || hipDeviceGetAttribute(&cus, hipDeviceAttributeMultiprocessorCount, dev) != hipSuccess) { grid = -1; return; }
        if (hipFuncSetAttribute((const void*)trunk_fwd, hipFuncAttributeMaxDynamicSharedMemorySize, LDS_BYTES) != hipSuccess) { fprintf(stderr, "kernel_launch: hipFuncSetAttribute failed\n"); grid = -1; return; }
        if (hipOccupancyMaxActiveBlocksPerMultiprocessor(&per_cu, (const void*)trunk_fwd, NTHREADS, LDS_BYTES) != hipSuccess || per_cu < 1) fprintf(stderr, "kernel_launch: occupancy query reports %d\n", per_cu);
        (void)hipGetLastError();
        grid = cus;
    }
    if (grid < 0) return;
    (void)hipMemsetAsync((char*)d_ws + WS_CTL, 0, CTL_ZERO_BYTES, stream);
    Args a{};
    for (int i = 0; i < 21; ++i) a.in[i] = (const float*)d_in[i];
    a.out = (float*)d_out; a.ws = (unsigned char*)d_ws;
#if MK_PER_PHASE
#if MK_DETCHECK
    unsigned char* wsb = (unsigned char*)d_ws; unsigned* ck = (unsigned*)(wsb + WS_CKS);
    cks_zero<<<1, 128, 0, stream>>>(ck);
    (void)hipFuncSetAttribute((const void*)lds_poison, hipFuncAttributeMaxDynamicSharedMemorySize, LDS_BYTES);
    for (int pass = 0; pass < 2; ++pass)
    for (int ph = 0; ph < N_PHASES; ++ph) {
        if (ph == 0) { (void)hipMemsetAsync(wsb + 65536, pass ? 0x55 : 0xAA, 224 * MiB - 65536, stream); (void)hipMemsetAsync(d_out, pass ? 0x55 : 0xAA, (size_t)M * D * 4, stream);
            hipLaunchKernelGGL(lds_poison, dim3(grid), dim3(NTHREADS), LDS_BYTES, stream, pass ? 0x55555555u : 0xAAAAAAAAu); }
        a.ph_lo = ph; a.ph_hi = ph + 1; hipLaunchKernelGGL(trunk_fwd, dim3(grid), dim3(NTHREADS), LDS_BYTES, stream, a);
        int L = -1, k = -1; { const int pbs[5] = {1, 8, 14, 21, 27}; for (int l = 0; l < 4; ++l) if (ph >= pbs[l] && ph < pbs[l + 1]) { L = l; k = ph - pbs[l]; } }
        const bool rec = (L & 1) == 0; unsigned* dst = ck + pass * 64 + ph;
        auto CK = [&](size_t off, size_t bytes) { cks_kernel<<<1024, 256, 0, stream>>>((const unsigned*)(wsb + off), bytes / 4, dst); };
        auto CKO = [&]() { cks_kernel<<<1024, 256, 0, stream>>>((const unsigned*)d_out, (size_t)M * D, dst); CK(WS_XB, 32 * MiB); CK(WS_SSQ, 1 * MiB); };
        if (ph == 0) { CK(WS_WMIX, 10 * MiB); CK(WS_WUP, 8 * MiB); CK(WS_WDOWN, 8 * MiB); CK(WS_XB, 32 * MiB); CK(WS_SSQ, 1 * MiB); }
        else if (ph == 27) { cks_kernel<<<1024, 256, 0, stream>>>((const unsigned*)d_out, (size_t)M * D, dst); }
        else if (rec) {
            if (k == 0) { CK(WS_GX, 64 * MiB); CK(WS_WDOWN, 8 * MiB); }
            if (k == 1) CK(WS_XC, 32 * MiB);
            if (k == 2) { CK(WS_RB, 32 * MiB); CK(WS_IB, 32 * MiB); }
            if (k == 3) CK(WS_GX, 64 * MiB);
            if (k == 4) CKO();
            if (k == 5) { CK(WS_H, 128 * MiB); CK(WS_WMIX, 10 * MiB); }
            if (k == 6) { CKO(); CK(WS_WUP, 8 * MiB); }
        } else {
            if (k == 0) { CK(WS_QC, 88 * MiB); CK(WS_WDOWN, 8 * MiB); }
            if (k == 1) { CK(WS_CN, 4 * MiB); CK(WS_IDX, 8 * MiB); }
            if (k == 2) CK(WS_QC, 88 * MiB);
            if (k == 3) CKO();
            if (k == 4) { CK(WS_H, 128 * MiB); CK(WS_WMIX, 10 * MiB); }
            if (k == 5) { CKO(); CK(WS_WUP, 8 * MiB); }
        }
    }
    cks_report<<<1, 64, 0, stream>>>(ck, (float*)d_out);
#else
#if MK_DEBUG_CHECKS
    unsigned char* ws = (unsigned char*)d_ws; const float** in = (const float**)a.in; float* outp = (float*)d_out;
    chk_zero<<<1, 64, 0, stream>>>(ws);
#endif
    for (int ph = 0; ph < N_PHASES; ++ph) {
#if MK_DEBUG_CHECKS
        int L = -1, k = -1; { const int pbs[5] = {1, 8, 14, 21, 27}; for (int l = 0; l < 4; ++l) if (ph >= pbs[l] && ph < pbs[l + 1]) { L = l; k = ph - pbs[l]; } }
        const int j = L >> 1, id0 = 10 * L; const bool rec = (L & 1) == 0;
        if (L >= 0) {
            if ((rec && k == 4 && L > 0) || (!rec && k == 3) || (rec && k == 6) || (!rec && k == 5)) chk_save_rows<<<NS, 256, 0, stream>>>(ws, outp);
            if (rec && k == 3) chk_save_gate<<<128, 256, 0, stream>>>(ws);
        }
#endif
        a.ph_lo = ph; a.ph_hi = ph + 1; hipLaunchKernelGGL(trunk_fwd, dim3(grid), dim3(NTHREADS), LDS_BYTES, stream, a);
#if MK_DEBUG_CHECKS
        if (L >= 0) {
          if (rec) {
            if (k == 0) chk_proj<<<dim3(8, NS), 256, 0, stream>>>(ws, id0 + 1, WS_XB, D, in[4] + (size_t)j * D * 2048, 2048, in[1] + L * D, D, 2048, WS_GX, 2048, 1);
            if (k == 1) chk_conv<<<dim3(4, NS), 256, 0, stream>>>(ws, id0 + 2, in[5] + (size_t)j * 4 * D, in[6] + (size_t)j * D);
            if (k == 2) chk_gates<<<dim3(4, NS), 256, 0, stream>>>(ws, id0 + 3, in[7] + (size_t)j * 4 * 65536, in[8] + (size_t)j * D, in[9] + (size_t)j * 4 * 65536, in[10] + (size_t)j * D);
            if (k == 3) chk_scan<<<2, 64, 0, stream>>>(ws, id0 + 4, in[11] + (size_t)j * D);
            if (k == 4) { chk_res<<<dim3(4, NS), 256, 0, stream>>>(ws, id0 + 5, WS_GX, 2048, in[12] + (size_t)j * D * D, D, outp, L == 0 ? in[0] : nullptr); chk_ssq<<<NS / 64, 64, 0, stream>>>(ws, id0 + 5, outp); }
            if (k == 5) chk_proj<<<dim3(16, NS), 256, 0, stream>>>(ws, id0 + 6, WS_XB, D, in[19] + (size_t)L * D * FF, FF, in[2] + L * D, D, FF, WS_H, FF, 2);
            if (k == 6) { chk_res<<<dim3(4, NS), 256, 0, stream>>>(ws, id0 + 7, WS_H, FF, in[20] + (size_t)L * FF * D, FF, outp, nullptr); chk_ssq<<<NS / 64, 64, 0, stream>>>(ws, id0 + 7, outp); }
          } else {
            if (k == 0) chk_att_in<<<dim3(11, NS), 256, 0, stream>>>(ws, id0 + 1, in[13] + (size_t)j * D * ATT_IN, in[15] + (size_t)j * 16 * 64 * 128, in[1] + L * D);
            if (k == 1) chk_cn<<<NS, 128, 0, stream>>>(ws, id0 + 2, in[14] + (size_t)j * 128);
            if (k == 3) { chk_att_o<<<dim3(4, NS), 256, 0, stream>>>(ws, in[16] + (size_t)j * 16 * 128 * 64); chk_att_out<<<dim3(4, NS), 256, 0, stream>>>(ws, id0 + 5, in[17] + (size_t)j * D * D, outp); chk_ssq<<<NS / 64, 64, 0, stream>>>(ws, id0 + 5, outp); }
            if (k == 4) chk_proj<<<dim3(16, NS), 256, 0, stream>>>(ws, id0 + 6, WS_XB, D, in[19] + (size_t)L * D * FF, FF, in[2] + L * D, D, FF, WS_H, FF, 2);
            if (k == 5) { chk_res<<<dim3(4, NS), 256, 0, stream>>>(ws, id0 + 7, WS_H, FF, in[20] + (size_t)L * FF * D, FF, outp, nullptr); chk_ssq<<<NS / 64, 64, 0, stream>>>(ws, id0 + 7, outp); }
          }
        }
#endif
    }
#if MK_DEBUG_CHECKS
    chk_report<<<1, 64, 0, stream>>>(ws, outp);
#endif
#endif
#else
    a.ph_lo = 0; a.ph_hi = N_PHASES;
    hipLaunchKernelGGL(trunk_fwd, dim3(grid), dim3(NTHREADS), LDS_BYTES, stream, a);
#endif
}
```

```cpp
#include <hip/hip_runtime.h>
#include <cstdio>
#include <cstdint>

#define LAS __attribute__((address_space(3)))
#define GAS __attribute__((address_space(1)))
typedef unsigned short bf16_t;
typedef short bf16x8 __attribute__((ext_vector_type(8)));
typedef short s16x4 __attribute__((ext_vector_type(4)));
typedef float f32x4 __attribute__((ext_vector_type(4)));
typedef float f32x2 __attribute__((ext_vector_type(2)));
typedef float f32x16 __attribute__((ext_vector_type(16)));
typedef unsigned u32x4 __attribute__((ext_vector_type(4)));
typedef unsigned u32x2 __attribute__((ext_vector_type(2)));
typedef unsigned short u16x4 __attribute__((ext_vector_type(4)));

constexpr int BATCH = 8, SEQ = 2048, D = 1024, M = BATCH * SEQ, DEPTH = 4, FF = 4096;
constexpr int H_ATT = 16, D_LAT = 128, H_IDX = 8, D_IDX = 64, TOPK = 256;
constexpr int ATT_IN = 1736;
constexpr int NATT = 2816;
constexpr int QC_C = 2048, QC_QI = 2176, QC_KI = 2688, QC_WI = 2752;
constexpr float EPS = 1e-6f;
constexpr int NWAVES = 8, NTHREADS = 512;

constexpr size_t MiB = 1u << 20;
constexpr size_t WS_CTL = 0, CTL_ZERO_BYTES = 64 * 1024;
constexpr size_t WS_SSQ = 1 * MiB;
constexpr size_t WS_WMIX = 2 * MiB;
constexpr size_t WS_WUP = 12 * MiB, WS_WDOWN = 20 * MiB;
constexpr size_t WS_XB = 28 * MiB;
constexpr size_t WS_BIG = 60 * MiB;
constexpr size_t WS_H = WS_BIG;
constexpr size_t WS_GX = WS_BIG;
constexpr size_t WS_XC = WS_BIG + 64 * MiB;
constexpr size_t WS_RB = WS_BIG + 96 * MiB;
constexpr size_t WS_IB = WS_BIG + 128 * MiB;
constexpr size_t WS_QC = WS_BIG;
constexpr size_t WS_CN = WS_BIG + 88 * MiB;
constexpr size_t WS_IDX = WS_BIG + 92 * MiB;
constexpr size_t WS_WATT = WS_BIG + 160 * MiB;
constexpr size_t WS_SSQM = WS_WATT + 20 * MiB;
constexpr size_t WS_END = WS_SSQM + 1 * MiB;
constexpr size_t WM_REC_GATE = (size_t)2048 * 1024, WM_REC_OUT = WM_REC_GATE + (size_t)2048 * 1024;
constexpr size_t WM_ATT_COMB = (size_t)NATT * 1024;

constexpr int RING_BYTES = 131072;
constexpr int LDSCTL_OFF = RING_BYTES;
constexpr int LDS_BYTES = 163840;
constexpr int MISC_OFF = LDS_BYTES - 512;
constexpr int BSL_OFF = 132096;

#ifndef DBLMASK
#define DBLMASK 0u
#endif
#define DB(b) ((DBLMASK >> (b)) & 1u)
typedef __bf16 bf16x2_t __attribute__((ext_vector_type(2)));
__device__ __forceinline__ unsigned cvt_pk_bf16(float lo, float hi) { const f32x2 v = {lo, hi}; return __builtin_bit_cast(unsigned, __builtin_convertvector(v, bf16x2_t)); }
__device__ __forceinline__ float bf2f(unsigned h) { return __uint_as_float(h << 16); }
__device__ __forceinline__ float bflo(unsigned w) { return __uint_as_float(w << 16); }
__device__ __forceinline__ float bfhi(unsigned w) { return __uint_as_float(w & 0xffff0000u); }
__device__ __forceinline__ float wave_sum(float v) {
#pragma unroll
    for (int o = 1; o < 64; o <<= 1) v += __shfl_xor(v, o);
    return v;
}
#ifndef WT_STORES
#define WT_STORES 1
#endif
__device__ __forceinline__ void store16_wt(void* p, u32x4 v) {
#if WT_STORES
    asm volatile("global_store_dwordx4 %0, %1, off sc1\n\ts_nop 1" :: "v"(p), "v"(v) : "memory");
#else
    *(u32x4*)p = v;
#endif
}
#define LDS_WAIT() asm volatile("s_waitcnt lgkmcnt(0)" ::: "memory")
#define VM_WAIT() asm volatile("s_waitcnt vmcnt(0)" ::: "memory")

#define XB_TMO      128
#define XB_XCNT(j)  (256  + 64 * (j))
#define XB_XSUB(j)  (1280 + 64 * (j))
#define XB_XGEN(j)  (2304 + 64 * (j))
#define XB_TOP      3328
#define XB_TOPGEN   3392
#define XCD_BAR_WORDS 3456
#define XB_SPIN_CAP (1u << 22)
constexpr int CW_BAR = 4096;
static_assert((CW_BAR + XCD_BAR_WORDS) * 4 <= (int)CTL_ZERO_BYTES, "barrier words inside the memset region");

__device__ __forceinline__ unsigned xb_ld(unsigned* p)              { return __hip_atomic_load(p, __ATOMIC_RELAXED, __HIP_MEMORY_SCOPE_AGENT); }
__device__ __forceinline__ unsigned xb_add(unsigned* p, unsigned v) { return __hip_atomic_fetch_add(p, v, __ATOMIC_RELAXED, __HIP_MEMORY_SCOPE_AGENT); }
__device__ __forceinline__ unsigned xb_xcc_id() { return (unsigned)__builtin_amdgcn_s_getreg((3 << 11) | 20) & 0xFu; }
#define XB_SPIN(cond, bar) do { unsigned _sp = 0; while (cond) { __builtin_amdgcn_s_sleep(1); \
    if ((++_sp & 255u) == 0u) { if (xb_ld(&(bar)[XB_TMO])) break; if (_sp > XB_SPIN_CAP) { atomicAdd(&(bar)[XB_TMO], 1u); break; } } } } while (0)

struct XcdBarrier { unsigned* bar; unsigned x; volatile LAS unsigned* st; };

__device__ __forceinline__ XcdBarrier xcd_barrier_post(unsigned* bar, volatile LAS unsigned* st) {
    XcdBarrier b; b.bar = bar; b.x = xb_xcc_id(); b.st = st;
    if (threadIdx.x == 0) (void)xb_add(&bar[XB_XCNT(b.x)], 1u);
    return b;
}
__device__ __forceinline__ void xcd_barrier_complete(unsigned* bar, unsigned x, unsigned& nloc, unsigned& nx) {
    const unsigned G = gridDim.x * gridDim.y * gridDim.z;
    unsigned sum, cnt, mine, sp = 0u;
    for (;;) {
        sum = 0u; cnt = 0u; mine = 0u;
#pragma unroll
        for (unsigned j = 0; j < 16; ++j) { const unsigned c = xb_ld(&bar[XB_XCNT(j)]); sum += c; cnt += (c > 0u) ? 1u : 0u; mine = (j == x) ? c : mine; }
        if (sum == G) break;
        __builtin_amdgcn_s_sleep(1);
        if ((++sp & 255u) == 0u) { if (xb_ld(&bar[XB_TMO])) break; if (sp > XB_SPIN_CAP) { atomicAdd(&bar[XB_TMO], 1u); break; } }
    }
    nloc = mine > 0u ? mine : 1u; nx = cnt > 0u ? cnt : 1u;
}
__device__ __forceinline__ void xcd_barrier(const XcdBarrier& b) {
    asm volatile("s_waitcnt vmcnt(0)" ::: "memory");
    __syncthreads();
    if (threadIdx.x == 0) {
        unsigned* bar = b.bar;
        __builtin_amdgcn_s_waitcnt(0);
        unsigned nloc = b.st[0], nx = b.st[1];
        if (nloc == 0u) { xcd_barrier_complete(bar, b.x, nloc, nx); b.st[0] = nloc; b.st[1] = nx; }
        const unsigned old = xb_add(&bar[XB_XSUB(b.x)], 1u);
        const unsigned gen = old / nloc;
        if (old + 1u == (gen + 1u) * nloc) {
            __builtin_amdgcn_fence(__ATOMIC_RELEASE, "agent");
            asm volatile("s_waitcnt vmcnt(0)" ::: "memory");
            const unsigned og = xb_add(&bar[XB_TOP], 1u);
            const unsigned tg = og / nx;
            if (og + 1u == (tg + 1u) * nx) xb_add(&bar[XB_TOPGEN], 1u);
            else XB_SPIN(xb_ld(&bar[XB_TOPGEN]) == tg, bar);
            __builtin_amdgcn_fence(__ATOMIC_ACQUIRE, "agent");
            xb_add(&bar[XB_XGEN(b.x)], 1u);
            asm volatile("s_waitcnt vmcnt(0)" ::: "memory");
        } else {
            XB_SPIN(xb_ld(&bar[XB_XGEN(b.x)]) == gen, bar);
            __builtin_amdgcn_fence(__ATOMIC_ACQUIRE, "agent");
            asm volatile("s_waitcnt vmcnt(0)" ::: "memory");
        }
    }
    __syncthreads();
}

namespace pg8 {
constexpr int BM = 256, BK = 64, HALF = 128, HTB = HALF * BK * 2, NXCD = 8, WGM = 8;
__device__ __forceinline__ int lds_byte(int r, int c) { const int st = (r >> 4) * 2 + (c >> 5), rr = r & 15, cc = c & 31, ob = rr * 64 + cc * 2; return st * 1024 + (ob ^ (((ob >> 9) & 1) << 5)); }
__device__ __forceinline__ void stage_rc(int b, int& R, int& C) { const int st = b / 1024, sb = b % 1024, swz = sb ^ (((sb >> 9) & 1) << 5); R = (st >> 1) * 16 + swz / 64; C = (st & 1) * 32 + (swz % 64) / 2; }
__device__ __forceinline__ int perm32(int rho) { const int n = rho >> 4, i = rho & 15; return 8 * (i >> 2) + 4 * n + (i & 3); }

struct Unit { int pm, pn; };
struct Gemm { const bf16_t* A; const bf16_t* Bt; int lda, ldb, K, a_shift; };

struct StaticOrder {
    int nM, nN, nwg, G, c;
    __device__ void init(int Mr, int N, int G_, int c_) { nM = Mr / BM; nN = N / BM; nwg = nM * nN; G = G_; c = c_; }
    __device__ bool next(int i, Unit& u) const {
        const long L = (long)i * G + c; if (L >= nwg) return false;
        int wgid = (int)L; { const int q = nwg / NXCD, r = nwg % NXCD, xcd = wgid % NXCD, off = wgid / NXCD; wgid = (xcd < r ? xcd * (q + 1) : r * (q + 1) + (xcd - r) * q) + off; }
        const int nig = WGM * nN, gid = wgid / nig, fm = gid * WGM, gsz = (nM - fm) < WGM ? (nM - fm) : WGM;
        u.pm = fm + ((wgid % nig) % gsz); u.pn = (wgid % nig) / gsz; return true;
    }
};
struct GateOrder {
    int G, c;
    __device__ bool next(int i, Unit& u) const { const int p = c + (i >> 1) * G; if (p >= 256) return false; u.pm = p >> 2; u.pn = 4 * (i & 1) + (p & 3); return true; }
};

template <class Epi, class Sched>
__device__ __forceinline__ void gemm_phase(LAS unsigned char* lds, int tid, const Gemm g, const Sched& S, const Epi& E) {
    const int wid = __builtin_amdgcn_readfirstlane(tid >> 6), lane = tid & 63, wr = wid >> 2, wc = wid & 3, fr = lane & 15, fq = lane >> 4;
    int Kq = g.K; asm volatile("" : "+s"(Kq)); const int nt = Kq / BK;
    unsigned voffA[2], voffB[2];
#pragma unroll
    for (int i = 0; i < 2; ++i) { int R, C; stage_rc(tid * 16 + i * 8192, R, C); const int Rb = Epi::PERM ? ((R & ~31) + perm32(R & 31)) : R;
        voffA[i] = (unsigned)(R * g.lda + C) * 2u; voffB[i] = (unsigned)(Rb * g.ldb + C) * 2u; }
    const size_t kstep = (size_t)(BK * 2);
    const size_t hA = (size_t)HALF * g.lda * 2, hB = (size_t)HALF * g.ldb * 2;
    const size_t tA = 2 * hA, tB = 2 * hB;
    const unsigned ldsw = (unsigned)wid * 1024u;
    const int aoff = lds_byte(wr * 64 + fr, fq * 8), boff = lds_byte(wc * 32 + fr, fq * 8);
#define PG8_SA(b, h) (((b) * 2 + (h)) * HTB)
#define PG8_SB(b, h) ((4 + (b) * 2 + (h)) * HTB)
#define PG8_STAGE(bufoff, gbase, voff) do { _Pragma("unroll") for (int _i = 0; _i < 2; ++_i) \
        __builtin_amdgcn_global_load_lds((const unsigned*)((const char*)(gbase) + (voff)[_i]), (LAS unsigned*)(lds + (bufoff) + ldsw + _i * 8192), 16, 0, 0); } while (0)
#define PG8_LDA(dst, b, h) do { _Pragma("unroll") for (int m = 0; m < 4; ++m) _Pragma("unroll") for (int k = 0; k < 2; ++k) dst[m][k] = *(const LAS bf16x8*)(lds + PG8_SA(b, h) + aoff + m * 2048 + k * 1024); } while (0)
#define PG8_LDB(dst, b, h) do { _Pragma("unroll") for (int n = 0; n < 2; ++n) _Pragma("unroll") for (int k = 0; k < 2; ++k) dst[n][k] = *(const LAS bf16x8*)(lds + PG8_SB(b, h) + boff + n * 2048 + k * 1024); } while (0)
#define PG8_MMA(ai, bj, At, Bt) do { __builtin_amdgcn_s_setprio(1); _Pragma("unroll") for (int m = 0; m < 4; ++m) _Pragma("unroll") for (int n = 0; n < 2; ++n) _Pragma("unroll") for (int k = 0; k < 2; ++k) \
        acc[ai][bj][m][n] = __builtin_amdgcn_mfma_f32_16x16x32_bf16(Bt[n][k], At[m][k], acc[ai][bj][m][n], 0, 0, 0); __builtin_amdgcn_s_setprio(0); } while (0)
#define PG8_WAIT_V(n) asm volatile("s_waitcnt vmcnt(" #n ")" ::: "memory")
#define PG8_WAIT_L(n) asm volatile("s_waitcnt lgkmcnt(" #n ")" ::: "memory")
#define PG8_BAR __builtin_amdgcn_s_barrier()
#define PG8_SCHED __builtin_amdgcn_sched_barrier(0)
#define PG8_ABASE(u) ((const char*)g.A + (size_t)(u).pm * tA + (g.a_shift >= 0 ? (size_t)(((u).pn & g.a_shift) * 512) : (size_t)0))
#define PG8_BBASE(u) ((const char*)g.Bt + (size_t)(u).pn * tB + (g.a_shift >= 0 ? (size_t)(((u).pn & g.a_shift) * 512) : (size_t)0))
    Unit cur, nxt; int ui = 0;
    if (!S.next(0, cur)) return;
    f32x4 acc[2][2][4][2];
#pragma unroll
    for (int a = 0; a < 2; ++a)
#pragma unroll
        for (int b = 0; b < 2; ++b)
#pragma unroll
            for (int m = 0; m < 4; ++m)
#pragma unroll
                for (int n = 0; n < 2; ++n) acc[a][b][m][n] = (f32x4){0.f, 0.f, 0.f, 0.f};
    bf16x8 At[4][2], B0[2][2], B1[2][2];
    float rsv[2][4];
#pragma unroll
    for (int a = 0; a < 2; ++a)
#pragma unroll
        for (int m = 0; m < 4; ++m) rsv[a][m] = 1.0f;
    const char* cA = PG8_ABASE(cur); const char* cB = PG8_BBASE(cur);
    if (Epi::HAS_PRE) { f32x4 part[2][4]; E.pre_load(cur, wr, fr, fq, part);
        PG8_STAGE(PG8_SB(0, 0), cB, voffB); PG8_STAGE(PG8_SB(0, 1), cB + hB, voffB); PG8_STAGE(PG8_SA(0, 0), cA, voffA); PG8_STAGE(PG8_SA(0, 1), cA + hA, voffA);
        if (wr == 1) PG8_BAR;
        PG8_WAIT_V(2); PG8_BAR;
        E.pre_reduce(part, rsv);
    } else {
    PG8_STAGE(PG8_SB(0, 0), cB, voffB); PG8_STAGE(PG8_SB(0, 1), cB + hB, voffB); PG8_STAGE(PG8_SA(0, 0), cA, voffA); PG8_STAGE(PG8_SA(0, 1), cA + hA, voffA);
    if (wr == 1) PG8_BAR;
    PG8_WAIT_V(2); PG8_BAR; }
    PG8_STAGE(PG8_SB(1, 0), cB + kstep, voffB); PG8_STAGE(PG8_SA(1, 0), cA + kstep, voffA); PG8_STAGE(PG8_SB(1, 1), cB + hB + kstep, voffB);
    PG8_WAIT_V(6); PG8_BAR;
    for (;;) {
        const bool has_next = S.next(ui + 1, nxt);
        const char* nA = has_next ? PG8_ABASE(nxt) : cA; const char* nB = has_next ? PG8_BBASE(nxt) : cB;
        for (int t = 0; t < nt; t += 2) {
            const bool last = (t == nt - 2);
            const char* a1 = cA + (size_t)(t + 1) * kstep;
            const char* a2 = last ? nA : cA + (size_t)(t + 2) * kstep; const char* b2 = last ? nB : cB + (size_t)(t + 2) * kstep;
            const char* a3 = a2 + kstep; const char* b3 = b2 + kstep;
            PG8_LDB(B0, 0, 0); PG8_LDB(B1, 0, 1); PG8_SCHED; PG8_LDA(At, 0, 0); PG8_STAGE(PG8_SA(1, 1), a1 + hA, voffA);
            PG8_WAIT_V(8); PG8_WAIT_L(0); PG8_BAR; PG8_MMA(0, 0, At, B0); PG8_MMA(0, 1, At, B1); PG8_BAR; PG8_SCHED;
            PG8_LDA(At, 0, 1); PG8_STAGE(PG8_SB(0, 0), b2, voffB); PG8_STAGE(PG8_SB(0, 1), b2 + hB, voffB); PG8_STAGE(PG8_SA(0, 0), a2, voffA);
            PG8_WAIT_V(8); PG8_WAIT_L(0); PG8_BAR; PG8_MMA(1, 0, At, B0); PG8_MMA(1, 1, At, B1); PG8_BAR; PG8_SCHED;
            PG8_LDB(B0, 1, 0); PG8_LDB(B1, 1, 1); PG8_SCHED; PG8_LDA(At, 1, 0); PG8_STAGE(PG8_SA(0, 1), a2 + hA, voffA);
            PG8_WAIT_V(8); PG8_WAIT_L(0); PG8_BAR; PG8_MMA(0, 0, At, B0); PG8_MMA(0, 1, At, B1); PG8_BAR; PG8_SCHED;
            PG8_LDA(At, 1, 1); PG8_STAGE(PG8_SB(1, 0), b3, voffB); PG8_STAGE(PG8_SB(1, 1), b3 + hB, voffB); PG8_STAGE(PG8_SA(1, 0), a3, voffA);
            PG8_WAIT_V(8); PG8_WAIT_L(0); PG8_BAR; PG8_MMA(1, 0, At, B0); PG8_MMA(1, 1, At, B1); PG8_BAR; PG8_SCHED;
        }
        if (wr == 0) PG8_BAR;
        E(acc, cur, wr, wc, fr, fq, rsv);
        if (!has_next) break;
#pragma unroll
        for (int a = 0; a < 2; ++a)
#pragma unroll
            for (int b = 0; b < 2; ++b)
#pragma unroll
                for (int m = 0; m < 4; ++m)
#pragma unroll
                    for (int n = 0; n < 2; ++n) acc[a][b][m][n] = (f32x4){0.f, 0.f, 0.f, 0.f};
        cur = nxt; cA = nA; cB = nB; ++ui;
        if (Epi::HAS_PRE) { f32x4 part[2][4]; E.pre_load(cur, wr, fr, fq, part); E.pre_reduce(part, rsv); }
        if (wr == 1) PG8_BAR;
    }
    PG8_WAIT_V(0);
    PG8_BAR;
#undef PG8_SA
#undef PG8_SB
#undef PG8_STAGE
#undef PG8_LDA
#undef PG8_LDB
#undef PG8_MMA
#undef PG8_WAIT_V
#undef PG8_WAIT_L
#undef PG8_BAR
#undef PG8_SCHED
#undef PG8_ABASE
#undef PG8_BBASE
}

__device__ __forceinline__ float row_rs(const float* ssq, int row) {
    const f32x4* p = (const f32x4*)(ssq + (size_t)row * 16); const f32x4 a = p[0], b = p[1], c = p[2], d = p[3];
    const float s = ((a.x + a.y) + (a.z + a.w)) + ((b.x + b.y) + (b.z + b.w)) + ((c.x + c.y) + (c.z + c.w)) + ((d.x + d.y) + (d.z + d.w));
    return rsqrtf(s * (1.0f / 1024.0f) + EPS);
}
__device__ __forceinline__ float gelu_tanh(float v) {
    const float u = 1.5957691216f * (v + 0.044715f * v * v * v);
    return v * __builtin_amdgcn_rcpf(1.0f + __builtin_amdgcn_exp2f(-1.44269504089f * u));
}
__device__ __forceinline__ float sigmoidf_(float z) { return __builtin_amdgcn_rcpf(1.0f + __builtin_amdgcn_exp2f(-1.44269504089f * z)); }

template <int MODE> struct EpiScale {
    static constexpr bool PERM = true;
    static constexpr bool HAS_PRE = (MODE != 2);
    bf16_t* O; int ldc; const float* ssq;
    __device__ __forceinline__ void pre_load(const Unit& u, int wr, int fr, int fq, f32x4 (&part)[2][4]) const {
        const int row0 = u.pm * BM + wr * 64 + fr;
#pragma unroll
        for (int ai = 0; ai < 2; ++ai)
#pragma unroll
            for (int m = 0; m < 4; ++m) part[ai][m] = *(const f32x4*)(ssq + (size_t)(row0 + ai * HALF + m * 16) * 16 + 4 * fq);
    }
    __device__ __forceinline__ void pre_reduce(const f32x4 (&part)[2][4], float (&rsv)[2][4]) const {
#pragma unroll
        for (int ai = 0; ai < 2; ++ai)
#pragma unroll
            for (int m = 0; m < 4; ++m) { float t = (part[ai][m].x + part[ai][m].y) + (part[ai][m].z + part[ai][m].w); t += __shfl_xor(t, 16); t += __shfl_xor(t, 32); rsv[ai][m] = rsqrtf(t * (1.0f / 1024.0f) + EPS); }
    }
    __device__ __forceinline__ void operator()(const f32x4 (&acc)[2][2][4][2], const Unit& u, int wr, int wc, int fr, int fq, const float (&rsv)[2][4]) const {
        const int row0 = u.pm * BM + wr * 64 + fr, col0 = u.pn * BM + wc * 32 + 8 * fq;
        const bool act = (MODE == 1) && (u.pn < 4);
#pragma unroll
        for (int ai = 0; ai < 2; ++ai)
#pragma unroll
            for (int m = 0; m < 4; ++m) { const int row = row0 + ai * HALF + m * 16; const float rs = rsv[ai][m]; bf16_t* rowp = O + (size_t)row * ldc + col0;
#pragma unroll
                for (int bj = 0; bj < 2; ++bj) { f32x4 v0 = acc[ai][bj][m][0], v1 = acc[ai][bj][m][1];
                    if (MODE != 2) { v0 = v0 * rs; v1 = v1 * rs; }
                    if (MODE == 1) { if (act) {
#pragma unroll
                        for (int e = 0; e < 4; ++e) { v0[e] = gelu_tanh(v0[e]); v1[e] = gelu_tanh(v1[e]); } } }
                    if (MODE == 2) {
#pragma unroll
                        for (int e = 0; e < 4; ++e) { const float a = fmaxf(v0[e], 0.f), b = fmaxf(v1[e], 0.f); v0[e] = a * a; v1[e] = b * b; } }
                    u32x4 w; w.x = cvt_pk_bf16(v0[0], v0[1]); w.y = cvt_pk_bf16(v0[2], v0[3]); w.z = cvt_pk_bf16(v1[0], v1[1]); w.w = cvt_pk_bf16(v1[2], v1[3]);
                    store16_wt(rowp + bj * HALF, w); } }
    }
};
struct EpiGate {
    static constexpr bool PERM = true;
    static constexpr bool HAS_PRE = false;
    bf16_t* R; bf16_t* I; const float* ba; const float* bx;
    __device__ __forceinline__ void pre_load(const Unit&, int, int, int, f32x4 (&)[2][4]) const {}
    __device__ __forceinline__ void pre_reduce(const f32x4 (&)[2][4], float (&)[2][4]) const {}
    __device__ __forceinline__ void operator()(const f32x4 (&acc)[2][2][4][2], const Unit& u, int wr, int wc, int fr, int fq, const float (&)[2][4]) const {
        const int which = u.pn >> 2, blk = u.pn & 3;
        bf16_t* O = which ? I : R; const float* bias = which ? bx : ba;
        const int row0 = u.pm * BM + wr * 64 + fr, col0 = blk * BM + wc * 32 + 8 * fq;
#pragma unroll
        for (int bj = 0; bj < 2; ++bj) {
            const f32x4 bv0 = *(const f32x4*)(bias + col0 + bj * HALF), bv1 = *(const f32x4*)(bias + col0 + bj * HALF + 4);
#pragma unroll
            for (int ai = 0; ai < 2; ++ai)
#pragma unroll
                for (int m = 0; m < 4; ++m) { bf16_t* rowp = O + (size_t)(row0 + ai * HALF + m * 16) * D + col0;
                    f32x4 v0 = acc[ai][bj][m][0] + bv0, v1 = acc[ai][bj][m][1] + bv1;
#pragma unroll
                    for (int e = 0; e < 4; ++e) { v0[e] = sigmoidf_(v0[e]); v1[e] = sigmoidf_(v1[e]); }
                    u32x4 w; w.x = cvt_pk_bf16(v0[0], v0[1]); w.y = cvt_pk_bf16(v0[2], v0[3]); w.z = cvt_pk_bf16(v1[0], v1[1]); w.w = cvt_pk_bf16(v1[2], v1[3]);
                    store16_wt(rowp + bj * HALF, w); }
        }
    }
};
template <bool SCALE> struct EpiRes {
    static constexpr bool PERM = true;
    static constexpr bool HAS_PRE = false;
    bf16_t* xb; float* ssq; const float* ssq_in;
    __device__ __forceinline__ void pre_load(const Unit&, int, int, int, f32x4 (&)[2][4]) const {}
    __device__ __forceinline__ void pre_reduce(const f32x4 (&)[2][4], float (&)[2][4]) const {}
    __device__ __forceinline__ void operator()(const f32x4 (&acc)[2][2][4][2], const Unit& u, int wr, int wc, int fr, int fq, const float (&)[2][4]) const {
        const int col0 = u.pn * BM + wc * 32 + 8 * fq;
        u32x4 o[2][4][2];
#define EPIRES_LOAD(ai) do { _Pragma("unroll") for (int m = 0; m < 4; ++m) { const size_t off_ = (size_t)(u.pm * BM + (ai) * HALF + wr * 64 + m * 16 + fr) * D + col0; \
            _Pragma("unroll") for (int bj = 0; bj < 2; ++bj) o[ai][m][bj] = *(const u32x4*)(xb + off_ + bj * HALF); } } while (0)
        if (!SCALE) { EPIRES_LOAD(0); EPIRES_LOAD(1); }
#pragma unroll
        for (int ai = 0; ai < 2; ++ai) {
            f32x4 part_[4];
            if (SCALE) {
#pragma unroll
                for (int m = 0; m < 4; ++m) part_[m] = *(const f32x4*)(ssq_in + (size_t)(u.pm * BM + ai * HALF + wr * 64 + m * 16 + fr) * 16 + 4 * fq);
                if (ai == 0) EPIRES_LOAD(0); else EPIRES_LOAD(1); }
#pragma unroll
            for (int m = 0; m < 4; ++m) { const int row = u.pm * BM + ai * HALF + wr * 64 + m * 16 + fr; const size_t off = (size_t)row * D + col0; float part = 0.f;
                float rs2 = 1.0f;
                if (SCALE) { float t = (part_[m].x + part_[m].y) + (part_[m].z + part_[m].w); t += __shfl_xor(t, 16); t += __shfl_xor(t, 32); rs2 = __builtin_amdgcn_rcpf(t * (1.0f / 1024.0f) + EPS); }
#pragma unroll
                for (int bj = 0; bj < 2; ++bj) { const u32x4 xo = o[ai][m][bj]; f32x4 a0 = acc[ai][bj][m][0], a1 = acc[ai][bj][m][1];
                    if (SCALE) { a0 = a0 * rs2; a1 = a1 * rs2; }
                    const float v0 = bflo(xo.x) + a0[0], v1 = bfhi(xo.x) + a0[1], v2 = bflo(xo.y) + a0[2], v3 = bfhi(xo.y) + a0[3];
                    const float v4 = bflo(xo.z) + a1[0], v5 = bfhi(xo.z) + a1[1], v6 = bflo(xo.w) + a1[2], v7 = bfhi(xo.w) + a1[3];
                    u32x4 w; w.x = cvt_pk_bf16(v0, v1); w.y = cvt_pk_bf16(v2, v3); w.z = cvt_pk_bf16(v4, v5); w.w = cvt_pk_bf16(v6, v7); store16_wt(xb + off + bj * HALF, w);
                    part += ((v0 * v0 + v1 * v1) + (v2 * v2 + v3 * v3)) + ((v4 * v4 + v5 * v5) + (v6 * v6 + v7 * v7)); }
                part += __shfl_xor(part, 16); part += __shfl_xor(part, 32);
                if (fq == 0) ssq[(size_t)row * 16 + u.pn * 4 + wc] = part; }
            asm volatile("" ::: "memory");
        }
#undef EPIRES_LOAD
    }
};
}

struct Args { const float* in[21]; float* out; unsigned char* ws; int ph_lo, ph_hi; };
static_assert(sizeof(Args) == 21 * 8 + 8 + 8 + 8, "Args has no padding");

struct Frame {
    LAS unsigned char* lds;
    int tid, lane, wave, G, vcu, bid;
};
__device__ __forceinline__ Frame launder(const Frame& F0) {
    Frame F = F0; int t = F0.tid, w = F0.wave, g = F0.G, v = F0.vcu, b = F0.bid;
    asm volatile("" : "+v"(t)); asm volatile("" : "+s"(w)); asm volatile("" : "+s"(g)); asm volatile("" : "+s"(v)); asm volatile("" : "+s"(b));
    F.tid = t; F.lane = t & 63; F.wave = w; F.G = g; F.vcu = v; F.bid = b; return F;
}

__device__ __forceinline__ void cvt_item(const float* W, int ldw, const float* gamma, float scale, bf16_t* Bt, int ldb, int nblk, int nvalid, LAS float* scr, int item, int lane) {
    const int kb = item / nblk, nb = item % nblk, k0 = 64 * kb, n0 = 32 * nb;
    const int nn = lane & 31; const bool ok = (n0 + nn) < nvalid;
    if (n0 + 32 <= nvalid && ((((size_t)W) | ((size_t)ldw * 4u)) & 15u) == 0) {
        const int c4 = (lane & 7) * 4, r8 = lane >> 3; f32x4 v[8];
#pragma unroll
        for (int i = 0; i < 8; ++i) v[i] = __builtin_nontemporal_load((const f32x4*)(W + (size_t)(k0 + 8 * i + r8) * ldw + n0 + c4));
#pragma unroll
        for (int i = 0; i < 8; ++i) { const int kk = 8 * i + r8; const float gs = (gamma ? gamma[k0 + kk] : 1.0f) * scale; LAS float* d = scr + kk * 33 + c4;
            d[0] = v[i].x * gs; d[1] = v[i].y * gs; d[2] = v[i].z * gs; d[3] = v[i].w * gs; }
    } else
#pragma unroll 8
    for (int i = 0; i < 32; ++i) { const int kk = 2 * i + (lane >> 5); float v = ok ? __builtin_nontemporal_load(W + (size_t)(k0 + kk) * ldw + n0 + nn) : 0.f;     v *= (gamma ? gamma[k0 + kk] : 1.0f) * scale; scr[kk * 33 + nn] = v; }
    LDS_WAIT(); asm volatile("" ::: "memory");
    const int c = lane & 7;
#pragma unroll
    for (int j = 0; j < 4; ++j) { const int n = (lane >> 3) + 8 * j; const LAS float* s = scr + (8 * c) * 33 + n;
        u32x4 o; o.x = cvt_pk_bf16(s[0 * 33], s[1 * 33]); o.y = cvt_pk_bf16(s[2 * 33], s[3 * 33]); o.z = cvt_pk_bf16(s[4 * 33], s[5 * 33]); o.w = cvt_pk_bf16(s[6 * 33], s[7 * 33]);
        store16_wt(Bt + (size_t)(n0 + n) * ldb + k0 + 8 * c, o); }
    LDS_WAIT(); asm volatile("" ::: "memory");
}
__device__ __forceinline__ bf16x8 pack8(const f32x4 a, const f32x4 b) { const u32x4 w = {cvt_pk_bf16(a.x, a.y), cvt_pk_bf16(a.z, a.w), cvt_pk_bf16(b.x, b.y), cvt_pk_bf16(b.z, b.w)}; return __builtin_bit_cast(bf16x8, w); }
__device__ __forceinline__ void qlat_item(const float* Win, const float* wuk, const float* gamma, float scale, bf16_t* Bt, int item, int chalf, int lane) {
    const int h = item >> 4, k0 = (item & 15) << 6, cb = 64 * chalf, fr = lane & 15, fq = lane >> 4;
    bf16x8 X[4][2], Y[4][2];
    { f32x4 xa[4][2], xb[4][2]; float gs[4];
#pragma unroll
      for (int kt = 0; kt < 4; ++kt) { const int k = k0 + 16 * kt + fr; gs[kt] = gamma[k] * scale; const f32x4* p = (const f32x4*)(Win + (size_t)k * ATT_IN + h * 64 + 8 * fq);
#pragma unroll
          for (int s_ = 0; s_ < 2; ++s_) { xa[kt][s_] = p[8 * s_]; xb[kt][s_] = p[8 * s_ + 1]; } }
#pragma unroll
      for (int kt = 0; kt < 4; ++kt)
#pragma unroll
          for (int s_ = 0; s_ < 2; ++s_) X[kt][s_] = pack8(xa[kt][s_] * gs[kt], xb[kt][s_] * gs[kt]); }
#pragma unroll
    for (int ct = 0; ct < 4; ++ct)
#pragma unroll
        for (int s_ = 0; s_ < 2; ++s_) { const float* p = wuk + (size_t)h * 64 * 128 + (size_t)(32 * s_ + 8 * fq) * 128 + cb + 16 * ct + fr;
            const f32x4 ya = {p[0], p[128], p[256], p[384]}, yb = {p[512], p[640], p[768], p[896]}; Y[ct][s_] = pack8(ya, yb); }
#pragma unroll
    for (int ct = 0; ct < 4; ++ct)
#pragma unroll
        for (int kt = 0; kt < 4; ++kt) { f32x4 acc = {0.f, 0.f, 0.f, 0.f};
#pragma unroll
            for (int s_ = 0; s_ < 2; ++s_) acc = __builtin_amdgcn_mfma_f32_16x16x32_bf16(X[kt][s_], Y[ct][s_], acc, 0, 0, 0);
            u32x2 o; o.x = cvt_pk_bf16(acc[0], acc[1]); o.y = cvt_pk_bf16(acc[2], acc[3]);
            *(u32x2*)(Bt + (size_t)(h * 128 + cb + 16 * ct + fr) * D + k0 + 16 * kt + 4 * fq) = o; }
}
__device__ __forceinline__ void comb_item(const float* wuv, const float* wo, bf16_t* Bt, int item, int chalf, int lane) {
    const int h = item >> 4, n0 = (item & 15) << 6, cb = 64 * chalf, fr = lane & 15, fq = lane >> 4;
    bf16x8 X[4][2], Y[4][2];
#pragma unroll
    for (int ct = 0; ct < 4; ++ct) { const f32x4* p = (const f32x4*)(wuv + (size_t)h * 128 * 64 + (size_t)(cb + 16 * ct + fr) * 64 + 8 * fq);
#pragma unroll
        for (int s_ = 0; s_ < 2; ++s_) X[ct][s_] = pack8(p[8 * s_], p[8 * s_ + 1]); }
#pragma unroll
    for (int nt = 0; nt < 4; ++nt)
#pragma unroll
        for (int s_ = 0; s_ < 2; ++s_) { const float* p = wo + (size_t)(h * 64 + 32 * s_ + 8 * fq) * D + n0 + 16 * nt + fr;
            const f32x4 ya = {p[0], p[D], p[2 * D], p[3 * D]}, yb = {p[4 * D], p[5 * D], p[6 * D], p[7 * D]}; Y[nt][s_] = pack8(ya, yb); }
#pragma unroll
    for (int nt = 0; nt < 4; ++nt)
#pragma unroll
        for (int ct = 0; ct < 4; ++ct) { f32x4 acc = {0.f, 0.f, 0.f, 0.f};
#pragma unroll
            for (int s_ = 0; s_ < 2; ++s_) acc = __builtin_amdgcn_mfma_f32_16x16x32_bf16(X[ct][s_], Y[nt][s_], acc, 0, 0, 0);
            u32x2 o; o.x = cvt_pk_bf16(acc[0], acc[1]); o.y = cvt_pk_bf16(acc[2], acc[3]);
            *(u32x2*)(Bt + (size_t)(n0 + 16 * nt + fr) * 2048 + h * 128 + cb + 16 * ct + 4 * fq) = o; }
}

struct Ptrs {
    const float* in[21]; float* out; unsigned char* ws;
};
__device__ __forceinline__ unsigned long long argq(int k) {
    asm volatile("" : "+s"(k));
    return ((const __attribute__((address_space(4))) unsigned long long*)__builtin_amdgcn_kernarg_segment_ptr())[k];
}
__device__ __forceinline__ Ptrs load_ptrs() {
    Ptrs P;
#pragma unroll
    for (int i = 0; i < 21; ++i) P.in[i] = (const float*)(GAS const float*)argq(i);
    P.out = (float*)(GAS float*)argq(21); P.ws = (unsigned char*)(GAS unsigned char*)argq(22);
    return P;
}

__device__ __forceinline__ void cvt_rec_mix(const Frame& F, const Ptrs& P, int j, int L) {
    LAS float* scr = (LAS float*)(F.lds + F.wave * 16384);
    bf16_t* WM = (bf16_t*)(P.ws + WS_WMIX);
    const int gw = F.vcu * NWAVES + F.wave, NGW = F.G * NWAVES;
    constexpr int I_IN = 16 * 64, I_G = 4 * 8, I_OUT = 16 * 32, I_Z = 8 * 3 * 8;
    constexpr int NITEMS = I_IN + 8 * I_G + I_OUT + I_Z;
    for (int it = gw; it < NITEMS; it += NGW) {
        int r = it;
        if (r < I_IN) { cvt_item(P.in[4] + (size_t)j * D * 2048, 2048, P.in[1] + L * D, 1.f, WM, D, 64, 2048, scr, r, F.lane); continue; } r -= I_IN;
        if (r < 8 * I_G) { const int blk = r / (2 * I_G), which = (r / I_G) & 1, ri = r % I_G;
            cvt_item(P.in[which ? 9 : 7] + (size_t)(j * 4 + blk) * 65536, 256, nullptr, 1.f, WM + WM_REC_GATE + (size_t)(which * 1024 + blk * 256) * D + blk * 256, D, 8, 256, scr, ri, F.lane); continue; } r -= 8 * I_G;
        if (r < I_OUT) { cvt_item(P.in[12] + (size_t)j * D * D, D, nullptr, 1.f, WM + WM_REC_OUT, D, 32, D, scr, r, F.lane); continue; } r -= I_OUT;
        {
            const int rb = r / 24, cbi = (r / 8) % 3, piece = r & 7, blk = rb & 3, cb = cbi + (cbi >= blk ? 1 : 0);
            bf16_t* z = WM + WM_REC_GATE + (size_t)(rb * 256 + piece * 32) * D + cb * 256;
#pragma unroll
            for (int q = 0; q < 16; ++q) { const int e = q * 64 + F.lane, rr = e >> 5, cc = (e & 31) * 8; *(u32x4*)(z + (size_t)rr * D + cc) = (u32x4){0u, 0u, 0u, 0u}; }
        }
    }
}
__device__ __forceinline__ void cvt_att_mix(const Frame& F, const Ptrs& P, int j, int L, int rot = 0) {
    LAS float* scr = (LAS float*)(F.lds + F.wave * 16384);
    bf16_t* WM = (bf16_t*)(P.ws + WS_WATT + (size_t)j * 10 * MiB);
    const int NGW = F.G * NWAVES, gw = (F.vcu * NWAVES + F.wave + NGW - rot) % NGW;
    const float* Win = P.in[13] + (size_t)j * D * ATT_IN; const float* gam = P.in[1] + L * D;
    constexpr int I_H = 512, I_C = 16 * 22, I_W = 16 * 2;
    constexpr int NITEMS = 2 * I_H + I_C + I_W;
    for (int it = gw; it < NITEMS; it += NGW) {
        int r = it;
        if (r < I_H) { qlat_item(Win, P.in[15] + (size_t)j * 16 * 64 * 128, gam, 0.125f, WM, r >> 1, r & 1, F.lane); continue; } r -= I_H;
        if (r < I_H) { comb_item(P.in[16] + (size_t)j * 16 * 128 * 64, P.in[17] + (size_t)j * D * D, WM + WM_ATT_COMB, r >> 1, r & 1, F.lane); continue; } r -= I_H;
        if (r < I_C) { cvt_item(Win + 1024, ATT_IN, gam, 1.f, WM + (size_t)2048 * D, D, 22, 704, scr, r, F.lane); continue; } r -= I_C;
        cvt_item(Win + 1728, ATT_IN, gam, 0.044194173824159216f, WM + (size_t)2752 * D, D, 2, 8, scr, r, F.lane);
    }
}
__device__ __forceinline__ void cvt_up(const Frame& F, const Ptrs& P, int L) {
    LAS float* scr = (LAS float*)(F.lds + F.wave * 16384);
    const int gw = F.vcu * NWAVES + F.wave, NGW = F.G * NWAVES;
    for (int it = gw; it < 16 * 128; it += NGW) cvt_item(P.in[19] + (size_t)L * D * FF, FF, P.in[2] + L * D, 1.f, (bf16_t*)(P.ws + WS_WUP), D, 128, FF, scr, it, F.lane);
}
__device__ __forceinline__ void cvt_down(const Frame& F, const Ptrs& P, int L) {
    LAS float* scr = (LAS float*)(F.lds + F.wave * 16384);
    const int gw = F.vcu * NWAVES + F.wave, NGW = F.G * NWAVES;
    for (int it = gw; it < 64 * 32; it += NGW) cvt_item(P.in[20] + (size_t)L * FF * D, D, nullptr, 1.f, (bf16_t*)(P.ws + WS_WDOWN), FF, 32, D, scr, it, F.lane);
}

__device__ __forceinline__ void p0_rows(const Frame& F, const Ptrs& P) {
    const int gw = F.vcu * NWAVES + F.wave, NGW = F.G * NWAVES;
    bf16_t* XB = (bf16_t*)(P.ws + WS_XB); float* SSQ = (float*)(P.ws + WS_SSQ);
    for (int m = gw; m < M; m += NGW) {
        const f32x4* xr = (const f32x4*)(P.in[0] + (size_t)m * D) + F.lane; float s = 0.f; f32x4 v[4];
#pragma unroll
        for (int jj = 0; jj < 4; ++jj) { v[jj] = __builtin_nontemporal_load(xr + 64 * jj); s += (v[jj].x * v[jj].x + v[jj].y * v[jj].y) + (v[jj].z * v[jj].z + v[jj].w * v[jj].w); }
        s = wave_sum(s);
        u32x2* o = (u32x2*)(XB + (size_t)m * D) + F.lane;
#pragma unroll
        for (int jj = 0; jj < 4; ++jj) { u32x2 w; w.x = cvt_pk_bf16(v[jj].x, v[jj].y); w.y = cvt_pk_bf16(v[jj].z, v[jj].w); o[64 * jj] = w; }
        if (F.lane < 16) SSQ[(size_t)m * 16 + F.lane] = (F.lane == 0) ? s : 0.f;
    }
}
__device__ __forceinline__ void final_norm(const Frame& F, const Ptrs& P, bool dry = false) {
    const int gw = F.vcu * NWAVES + F.wave, NGW = F.G * NWAVES;
    const float* SSQ = (const float*)(P.ws + WS_SSQ); const bf16_t* XB = (const bf16_t*)(P.ws + WS_XB);
    f32x4 gg[4];
#pragma unroll
    for (int jj = 0; jj < 4; ++jj) gg[jj] = ((const f32x4*)P.in[3])[F.lane + 64 * jj];
    u32x2 xn[4]; f32x4 sn = {0.f, 0.f, 0.f, 0.f};
    if (gw < M) { const u32x2* xi = (const u32x2*)(XB + (size_t)gw * D) + F.lane;
#pragma unroll
        for (int jj = 0; jj < 4; ++jj) xn[jj] = xi[64 * jj];
        sn = *(const f32x4*)(SSQ + (size_t)gw * 16 + 4 * (F.lane & 3)); }
    for (int m = gw; m < M; m += NGW) {
        u32x2 xv[4]; const f32x4 sp = sn;
#pragma unroll
        for (int jj = 0; jj < 4; ++jj) xv[jj] = xn[jj];
        if (m + NGW < M) { const u32x2* xi = (const u32x2*)(XB + (size_t)(m + NGW) * D) + F.lane;
#pragma unroll
            for (int jj = 0; jj < 4; ++jj) xn[jj] = xi[64 * jj];
            sn = *(const f32x4*)(SSQ + (size_t)(m + NGW) * 16 + 4 * (F.lane & 3)); }
        float t = (sp.x + sp.y) + (sp.z + sp.w); t += __shfl_xor(t, 1); t += __shfl_xor(t, 2);
        const float rs = rsqrtf(t * (1.0f / 1024.0f) + EPS);
        f32x4* xr = (f32x4*)(P.out + (size_t)m * D) + F.lane;
#pragma unroll
        for (int jj = 0; jj < 4; ++jj) { const u32x2 x2 = xv[jj]; const f32x4 v = {bflo(x2.x), bfhi(x2.x), bflo(x2.y), bfhi(x2.y)}; const f32x4 w = v * rs * gg[jj]; __builtin_nontemporal_store(dry ? v : w, xr + 64 * jj); }
    }
}
__device__ __forceinline__ void conv_tile(const Frame& F, const Ptrs& P, int j, int pm, int blk) {
    const bf16_t* GX = (const bf16_t*)(P.ws + WS_GX); bf16_t* XC = (bf16_t*)(P.ws + WS_XC);
    const int cp = F.tid & 127, rq = F.tid >> 7, ch = blk * 256 + 2 * cp, r0 = pm * 256 + rq * 64;
    const float* cw = P.in[5] + (size_t)j * 4 * D + ch; const float* cb = P.in[6] + (size_t)j * D + ch;
    const f32x2 w0 = *(const f32x2*)(cw), w1 = *(const f32x2*)(cw + D), w2 = *(const f32x2*)(cw + 2 * D), w3 = *(const f32x2*)(cw + 3 * D), bb = *(const f32x2*)cb;
    const unsigned* xr = (const unsigned*)(GX + (size_t)r0 * 2048 + 1024 + ch);
    unsigned x0 = 0u, x1 = 0u, x2 = 0u;
    if ((r0 & (SEQ - 1)) != 0) { x0 = xr[-3 * 1024]; x1 = xr[-2 * 1024]; x2 = xr[-1 * 1024]; }
    unsigned* xo = (unsigned*)(XC + (size_t)r0 * D + ch);
    for (int tb = 0; tb < 64; tb += 16) {
        unsigned xin[16];
#pragma unroll
        for (int q = 0; q < 16; ++q) xin[q] = xr[(size_t)(tb + q) * 1024];
#pragma unroll
        for (int q = 0; q < 16; ++q) {
            const unsigned x3 = xin[q];
            const float a = bb.x + w0.x * bflo(x0) + w1.x * bflo(x1) + w2.x * bflo(x2) + w3.x * bflo(x3);
            const float b = bb.y + w0.y * bfhi(x0) + w1.y * bfhi(x1) + w2.y * bfhi(x2) + w3.y * bfhi(x3);
            xo[(size_t)(tb + q) * 512] = cvt_pk_bf16(a, b);
            x0 = x1; x1 = x2; x2 = x3;
        }
    }
}

__device__ __forceinline__ void scan_phase(const Frame& F, const Ptrs& P, int j, bool dry = false) {
    LAS float* sA = (LAS float*)F.lds; LAS float* sH = sA + 32 * 32; LAS unsigned* sU = (LAS unsigned*)(F.lds + 16384);
    bf16_t* GX = (bf16_t*)(P.ws + WS_GX); const bf16_t* XC = (const bf16_t*)(P.ws + WS_XC);
    const bf16_t* RB = (const bf16_t*)(P.ws + WS_RB); const bf16_t* IB = (const bf16_t*)(P.ws + WS_IB);
    const int c2 = F.tid & 15, chunk = F.tid >> 4;
    for (int u = F.vcu; u < BATCH * 32; u += F.G) {
        const int b = u >> 5, cg = u & 31, ch = cg * 32 + 2 * c2; const size_t row0 = (size_t)b * SEQ + chunk * 64;
        const f32x2 lam = *(const f32x2*)(P.in[11] + (size_t)j * D + ch);
        const float sp0 = -8.0f * log1pf(expf(-lam.x)), sp1 = -8.0f * log1pf(expf(-lam.y));
        const unsigned* rp = (const unsigned*)(RB + row0 * D + ch); const unsigned* ip = (const unsigned*)(IB + row0 * D + ch); const unsigned* xp = (const unsigned*)(XC + row0 * D + ch);
        float A0 = 1.f, A1 = 1.f, h0 = 0.f, h1 = 0.f;
        constexpr int SB = 16;
        unsigned rn[SB], in_[SB], xn[SB];
#pragma unroll
        for (int q = 0; q < SB; ++q) { rn[q] = rp[(size_t)q * 512]; in_[q] = ip[(size_t)q * 512]; xn[q] = xp[(size_t)q * 512]; }
        for (int tb = 0; tb < 64; tb += SB) {
            unsigned rr[SB], ii[SB], xx[SB];
#pragma unroll
            for (int q = 0; q < SB; ++q) { rr[q] = rn[q]; ii[q] = in_[q]; xx[q] = xn[q]; }
            if (tb + SB < 64) {
#pragma unroll
                for (int q = 0; q < SB; ++q) { rn[q] = rp[(size_t)(tb + SB + q) * 512]; in_[q] = ip[(size_t)(tb + SB + q) * 512]; xn[q] = xp[(size_t)(tb + SB + q) * 512]; } }
#pragma unroll
            for (int q = 0; q < SB; ++q) { const unsigned r = rr[q], i = ii[q], x = xx[q];
                const float a0 = __expf(sp0 * bflo(r)), a1 = __expf(sp1 * bfhi(r));
                const float u0 = sqrtf(fmaxf(fmaf(-a0, a0, 1.0f), 0.f)) * (bflo(i) * bflo(x)), u1 = sqrtf(fmaxf(fmaf(-a1, a1, 1.0f), 0.f)) * (bfhi(i) * bfhi(x));
                A0 *= a0; A1 *= a1; h0 = fmaf(a0, h0, u0); h1 = fmaf(a1, h1, u1);
                sU[(tb + q) * 512 + F.tid] = cvt_pk_bf16(u0, u1); }
        }
        unsigned* gp = (unsigned*)(GX + row0 * 2048 + ch);
        unsigned gn[SB];
#pragma unroll
        for (int q = 0; q < SB; ++q) { rn[q] = rp[(size_t)q * 512]; gn[q] = gp[(size_t)q * 1024]; }
        sA[chunk * 32 + 2 * c2] = A0; sA[chunk * 32 + 2 * c2 + 1] = A1; sH[chunk * 32 + 2 * c2] = h0; sH[chunk * 32 + 2 * c2 + 1] = h1;
        __syncthreads();
        h0 = 0.f; h1 = 0.f;
        for (int k = 0; k < chunk; ++k) { h0 = fmaf(sA[k * 32 + 2 * c2], h0, sH[k * 32 + 2 * c2]); h1 = fmaf(sA[k * 32 + 2 * c2 + 1], h1, sH[k * 32 + 2 * c2 + 1]); }
        for (int tb = 0; tb < 64; tb += SB) {
            unsigned rr[SB], gg[SB];
#pragma unroll
            for (int q = 0; q < SB; ++q) { rr[q] = rn[q]; gg[q] = gn[q]; }
            if (tb + SB < 64) {
#pragma unroll
                for (int q = 0; q < SB; ++q) { rn[q] = rp[(size_t)(tb + SB + q) * 512]; gn[q] = gp[(size_t)(tb + SB + q) * 1024]; } }
#pragma unroll
            for (int q = 0; q < SB; ++q) { const unsigned r = rr[q], gt = gg[q], uu = sU[(tb + q) * 512 + F.tid];
                const float a0 = __expf(sp0 * bflo(r)), a1 = __expf(sp1 * bfhi(r));
                const float u0 = bflo(uu), u1 = bfhi(uu);
                h0 = fmaf(a0, h0, u0); h1 = fmaf(a1, h1, u1);
                gp[(size_t)(tb + q) * 1024] = dry ? gt : cvt_pk_bf16(h0 * bflo(gt), h1 * bfhi(gt)); }
        }
        __syncthreads();
    }
}

__device__ __forceinline__ unsigned f2key(float f) { const unsigned u = __float_as_uint(f + 0.0f); return u ^ ((unsigned)((int)u >> 31) | 0x80000000u); }
__device__ __forceinline__ int wave_sum_dpp(int x) {
    x += __builtin_amdgcn_update_dpp(0, x, 0x111, 0xF, 0xF, false);
    x += __builtin_amdgcn_update_dpp(0, x, 0x112, 0xF, 0xF, false);
    x += __builtin_amdgcn_update_dpp(0, x, 0x114, 0xF, 0xF, false);
    x += __builtin_amdgcn_update_dpp(0, x, 0x118, 0xF, 0xF, false);
    x += __builtin_amdgcn_update_dpp(0, x, 0x142, 0xA, 0xF, false);
    x += __builtin_amdgcn_update_dpp(0, x, 0x143, 0xC, 0xF, false);
    return __builtin_amdgcn_readlane(x, 63);
}
__device__ __forceinline__ float wave_sum_f32_dpp(float v) {
#define WSF_STEP(ctrl, rmask) v += __int_as_float(__builtin_amdgcn_update_dpp(0, __float_as_int(v), ctrl, rmask, 0xF, false))
    WSF_STEP(0x111, 0xF); WSF_STEP(0x112, 0xF); WSF_STEP(0x114, 0xF); WSF_STEP(0x118, 0xF); WSF_STEP(0x142, 0xA); WSF_STEP(0x143, 0xC);
#undef WSF_STEP
    return __int_as_float(__builtin_amdgcn_readlane(__float_as_int(v), 63));
}
__device__ __forceinline__ int wave_scan_dpp(int x) {
    x += __builtin_amdgcn_update_dpp(0, x, 0x111, 0xF, 0xF, false);
    x += __builtin_amdgcn_update_dpp(0, x, 0x112, 0xF, 0xF, false);
    x += __builtin_amdgcn_update_dpp(0, x, 0x114, 0xF, 0xF, false);
    x += __builtin_amdgcn_update_dpp(0, x, 0x118, 0xF, 0xF, false);
    x += __builtin_amdgcn_update_dpp(0, x, 0x142, 0xA, 0xF, false);
    x += __builtin_amdgcn_update_dpp(0, x, 0x143, 0xC, 0xF, false);
    return x;
}
template <int NR>
__device__ __forceinline__ void idx_select(const LAS float* scq, int pos, int lane, const LAS unsigned char* bkL, unsigned short* out) {
    unsigned keys[NR];
#pragma unroll
    for (int jj = 0; jj < NR; ++jj) { const int idx = lane + 64 * jj; const float v = scq[idx]; keys[jj] = (idx <= pos) ? f2key(v) : 0u; }
    unsigned T = 0u; bool exact = false; int cl_last = 0;
    for (int bit = 31; bit >= 0; --bit) {
        const unsigned cand = (unsigned)__builtin_amdgcn_readfirstlane((int)(T | (1u << bit)));
        unsigned c0 = 0, c1 = 0, c2 = 0, c3 = 0;
#define IDX_CMP4(a_, b_, c_, d_) "v_cmp_ge_u32_e64 %4, %" #a_ ", %[cd]\n\tv_cmp_ge_u32_e64 %5, %" #b_ ", %[cd]\n\tv_cmp_ge_u32_e64 %6, %" #c_ ", %[cd]\n\tv_cmp_ge_u32_e64 %7, %" #d_ ", %[cd]\n\t" \
                                 "v_addc_co_u32_e64 %0, %4, 0, %0, %4\n\tv_addc_co_u32_e64 %1, %5, 0, %1, %5\n\tv_addc_co_u32_e64 %2, %6, 0, %2, %6\n\tv_addc_co_u32_e64 %3, %7, 0, %3, %7\n\t"
#pragma unroll
        for (int jj = 0; jj < NR; jj += 8) { unsigned long long m0, m1, m2, m3;
            asm volatile(IDX_CMP4(8, 9, 10, 11) IDX_CMP4(12, 13, 14, 15)
                         : "+v"(c0), "+v"(c1), "+v"(c2), "+v"(c3), "=&s"(m0), "=&s"(m1), "=&s"(m2), "=&s"(m3)
                         : "v"(keys[jj]), "v"(keys[jj + 1]), "v"(keys[jj + 2]), "v"(keys[jj + 3]), "v"(keys[jj + 4]), "v"(keys[jj + 5]), "v"(keys[jj + 6]), "v"(keys[jj + 7]), [cd] "s"(cand)); }
#undef IDX_CMP4
        cl_last = (int)((c0 + c1) + (c2 + c3));
        const int cnt = wave_sum_dpp(cl_last);
        if (cnt >= TOPK) T = cand;
        if (cnt == TOPK) { exact = true; break; }
    }
    if (exact) {
        int k = wave_scan_dpp(cl_last) - cl_last;
#pragma unroll
        for (int jj = 0; jj < NR; ++jj) {
            const bool sel = keys[jj] >= T;
            if (sel) { const int idx = lane + 64 * jj; const int dist = pos - idx; const unsigned bk = dist >= 128 ? 31u : (unsigned)bkL[dist]; out[k] = (unsigned short)(idx | (bk << 11)); }
            k += sel ? 1 : 0;
        }
        return;
    }
    int cgt = 0;
#pragma unroll
    for (int jj = 0; jj < NR; ++jj) cgt += __builtin_popcountll(__builtin_amdgcn_ballot_w64(keys[jj] > T));
    const int need = TOPK - cgt; int obase = 0, ebase = 0;
#pragma unroll
    for (int jj = 0; jj < NR; ++jj) {
        const bool gt = keys[jj] > T, eq = keys[jj] == T;
        const unsigned long long em = __builtin_amdgcn_ballot_w64(eq);
        const int erank = ebase + (int)__builtin_amdgcn_mbcnt_hi((unsigned)(em >> 32), __builtin_amdgcn_mbcnt_lo((unsigned)em, 0u));
        const bool sel = gt || (eq && erank < need);
        const unsigned long long sm = __builtin_amdgcn_ballot_w64(sel);
        const int opos = obase + (int)__builtin_amdgcn_mbcnt_hi((unsigned)(sm >> 32), __builtin_amdgcn_mbcnt_lo((unsigned)sm, 0u));
        if (sel) { const int idx = lane + 64 * jj; const int dist = pos - idx; const unsigned bk = dist >= 128 ? 31u : (unsigned)bkL[dist]; out[opos] = (unsigned short)(idx | (bk << 11)); }
        obase += __builtin_popcountll(sm); ebase += __builtin_popcountll(em);
    }
}
__device__ __forceinline__ void index_phase(const Frame& F, const Ptrs& P, int j) {
    LAS float* scb = (LAS float*)F.lds;
    LAS float* wiB = (LAS float*)(F.lds + 131072);
    LAS unsigned char* bkL = (LAS unsigned char*)(F.lds + 131072 + 4096);
    const bf16_t* QC = (const bf16_t*)(P.ws + WS_QC); bf16_t* CN = (bf16_t*)(P.ws + WS_CN); unsigned short* IDX = (unsigned short*)(P.ws + WS_IDX);
    const int lane = F.lane, w = F.wave, half = lane >> 5;
    if (F.tid < 128) { const int n = F.tid; int bk = n; if (n >= 16) { bk = 16 + (int)(logf((float)n / 16.0f) / 2.0794415416798357f * 16.0f); bk = bk > 31 ? 31 : bk; } bkL[n] = (unsigned char)bk; }
    __syncthreads();
    const int nunits = M / 8;
    const int ar = lane & 31, ahalf_r = (ar >> 2) & 1, areg_r = (ar & 3) + 4 * (ar >> 3), aq = 2 * ahalf_r + (areg_r >> 3), ah = areg_r & 7;
#define IDX_UNIT(i_) (((i_) * F.G < nunits) ? ((i_) * F.G + (((i_) & 1) ? (F.G - 1 - F.vcu) : F.vcu)) : -1)
#define IDX_OK(u_) ((u_) >= 0 && (u_) < nunits)
#define IDX_FETCH(u_, A_, cw_, wi_) do { const int T0_ = (u_) * 8; \
        cw_ = *(const unsigned*)(QC + ((size_t)T0_ + w) * NATT + QC_C + 2 * lane); \
        wi_ = QC[(size_t)(T0_ + (lane >> 3)) * NATT + QC_WI + (lane & 7)]; \
        _Pragma("unroll") for (int g = 0; g < 2; ++g) { const bf16_t* p_ = QC + (size_t)(T0_ + 4 * g + aq) * NATT + QC_QI + ah * 64 + 32 * half; \
            _Pragma("unroll") for (int s = 0; s < 4; ++s) A_[g][s] = *(const bf16x8*)(p_ + 8 * s); } } while (0)
#define IDX_SCORE(u_, par_, unext_) do { const int T0 = (u_) * 8, b = T0 >> 11, p0 = T0 & (SEQ - 1); \
        LAS float* sc = scb + (par_) * 16384; LAS float* wiL = wiB + ((par_) * 8 + w) * 64; \
        bf16x8 Af[2][4]; \
        _Pragma("unroll") for (int g = 0; g < 2; ++g) _Pragma("unroll") for (int s = 0; s < 4; ++s) Af[g][s] = An[g][s]; \
        const unsigned cw = cwn; wiL[lane] = bf2f(win); \
        if (IDX_OK(unext_)) IDX_FETCH(unext_, An, cwn, win); \
        { const size_t tok = (size_t)T0 + w; const float c0 = bflo(cw), c1 = bfhi(cw); \
          const float ss = wave_sum_f32_dpp(c0 * c0 + c1 * c1); const float rs = rsqrtf(ss * (1.0f / 128.0f) + EPS); const f32x2 gg = gg_lat; \
          *(unsigned*)(CN + tok * 128 + 2 * lane) = cvt_pk_bf16(c0 * rs * gg.x, c1 * rs * gg.y); } \
        LDS_WAIT(); asm volatile("" ::: "memory"); \
        const int nkt = (p0 + 8 + 31) >> 5; \
        for (int kt0 = w; kt0 < nkt; kt0 += 16) { \
            bf16x8 Bf[2][4]; \
            _Pragma("unroll") for (int bi = 0; bi < 2; ++bi) { const int kt = kt0 + 8 * bi; if (kt < nkt) { const bf16_t* kp = QC + ((size_t)b * SEQ + 32 * kt + (lane & 31)) * NATT + QC_KI + 32 * half; \
                _Pragma("unroll") for (int s4 = 0; s4 < 4; ++s4) Bf[bi][s4] = *(const bf16x8*)(kp + 8 * s4); } } \
            _Pragma("unroll") for (int bi = 0; bi < 2; ++bi) { const int kt = kt0 + 8 * bi; if (kt < nkt) { const int key = 32 * kt + (lane & 31); \
                _Pragma("unroll") for (int g = 0; g < 2; ++g) { \
                    f32x16 acc; \
                    _Pragma("unroll") for (int e = 0; e < 16; ++e) acc[e] = 0.f; \
                    _Pragma("unroll") for (int s4 = 0; s4 < 4; ++s4) acc = __builtin_amdgcn_mfma_f32_32x32x16_bf16(Af[g][s4], Bf[bi][s4], acc, 0, 0, 0); \
                    _Pragma("unroll") for (int e = 0; e < 2; ++e) { float sv = 0.f; const f32x4 wlo = *(const LAS f32x4*)(wiL + (4 * g + 2 * half + e) * 8), whi = *(const LAS f32x4*)(wiL + (4 * g + 2 * half + e) * 8 + 4); \
                        _Pragma("unroll") for (int h = 0; h < 4; ++h) { sv = fmaf(wlo[h], fmaxf(acc[8 * e + h], 0.f), sv); sv = fmaf(whi[h], fmaxf(acc[8 * e + 4 + h], 0.f), sv); } \
                        const int qi = 4 * g + 2 * half + e; \
                        sc[qi * 2048 + key] = (key <= p0 + qi) ? sv : -INFINITY; } \
                } } } \
        } } while (0)
    const f32x2 gg_lat = *(const f32x2*)(P.in[14] + (size_t)j * 128 + 2 * lane);
    bf16x8 An[2][4]; unsigned cwn = 0u; unsigned short win = 0;
    { const int u0 = IDX_UNIT(0); if (IDX_OK(u0)) { IDX_FETCH(u0, An, cwn, win); const int u1 = IDX_UNIT(1); IDX_SCORE(u0, 0, u1); } }
    __syncthreads();
    for (int i = 0;; ++i) {
        const int u = IDX_UNIT(i); if (u < 0) break;
        if (IDX_OK(u)) {
            const int T0 = u * 8, p0 = T0 & (SEQ - 1); const LAS float* sc = scb + (i & 1) * 16384;
            const int pos = p0 + w, n = pos + 1; unsigned short* out = IDX + (size_t)(T0 + w) * 256;
            if (n <= TOPK) {
#pragma unroll
                for (int jj = 0; jj < 4; ++jj) { const int s = lane + 64 * jj; const int dist = pos - s; const unsigned bk = (dist >= 0) ? (dist >= 128 ? 31u : (unsigned)bkL[dist]) : 0u;
                    out[s] = (s < n) ? (unsigned short)(s | (bk << 11)) : (unsigned short)0; }
            } else {
                const LAS float* scq = sc + w * 2048;
                if (n <= 512) idx_select<8>(scq, pos, lane, bkL, out); else if (n <= 1024) idx_select<16>(scq, pos, lane, bkL, out);
                else if (n <= 1536) idx_select<24>(scq, pos, lane, bkL, out); else idx_select<32>(scq, pos, lane, bkL, out);
            }
        }
        { const int un = IDX_UNIT(i + 1); if (IDX_OK(un)) { const int un2 = IDX_UNIT(i + 2); IDX_SCORE(un, (i + 1) & 1, un2); } }
        __syncthreads();
    }
#undef IDX_UNIT
#undef IDX_OK
#undef IDX_FETCH
#undef IDX_SCORE
}

__device__ __forceinline__ s16x4 tr_read(const LAS unsigned char* p) {
    typedef short v4i16_t __attribute__((ext_vector_type(4)));
    return __builtin_bit_cast(s16x4, __builtin_amdgcn_ds_read_tr16_b64_v4i16((LAS v4i16_t*)p));
}
struct AttState { float mrun, lrun; f32x4 O[8]; };
__device__ __forceinline__ float xmax16(float v) { const auto r = __builtin_amdgcn_permlane16_swap(__float_as_uint(v), __float_as_uint(v), false, false); return fmaxf(__uint_as_float(r[0]), __uint_as_float(r[1])); }
__device__ __forceinline__ float xmax32(float v) { const auto r = __builtin_amdgcn_permlane32_swap(__float_as_uint(v), __float_as_uint(v), false, false); return fmaxf(__uint_as_float(r[0]), __uint_as_float(r[1])); }
__device__ __forceinline__ float xsum16(float v) { const auto r = __builtin_amdgcn_permlane16_swap(__float_as_uint(v), __float_as_uint(v), false, false); return __uint_as_float(r[0]) + __uint_as_float(r[1]); }
__device__ __forceinline__ float xsum32(float v) { const auto r = __builtin_amdgcn_permlane32_swap(__float_as_uint(v), __float_as_uint(v), false, false); return __uint_as_float(r[0]) + __uint_as_float(r[1]); }
__device__ __forceinline__ void att_stage(const bf16x8 (&cf)[16], LAS unsigned char* V, int lane) {
    constexpr int VROW = 288;
#pragma unroll
    for (int i = 0; i < 16; ++i) *(LAS bf16x8*)(V + (16 * (lane >> 4) + i) * VROW + (lane & 15) * 16) = cf[i];
    asm volatile("" ::: "memory");
}
__device__ __forceinline__ void att_qk(const bf16x8 (&qf)[4], f32x4 (&S)[4], const LAS unsigned char* V, int lane, int g) {
    constexpr int VROW = 288;
    const LAS unsigned char* ab = V + (lane & 15) * VROW + 16 * g;
#pragma unroll
    for (int t = 0; t < 4; ++t) { S[t] = (f32x4){0.f, 0.f, 0.f, 0.f};
#pragma unroll
        for (int ks = 0; ks < 4; ++ks) { const bf16x8 af = *(const LAS bf16x8*)(ab + 16 * t * VROW + 64 * ks); S[t] = __builtin_amdgcn_mfma_f32_16x16x32_bf16(af, qf[ks], S[t], 0, 0, 0); } }
}
template <bool MASKED>
__device__ __forceinline__ void att_sm_pv(const f32x4 (&S)[4], int s, int cnt, AttState& st, const LAS unsigned short* listL, const LAS float* biasL, const LAS unsigned char* trbase, int head, int g) {
    constexpr int VROW = 288; constexpr float L2E = 1.44269504089f;
    float val[4][4]; float cmax = -INFINITY;
#pragma unroll
    for (int t = 0; t < 4; ++t) { const u16x4 pk4 = *(const LAS u16x4*)(listL + 64 * s + 16 * t + 4 * g);
#pragma unroll
        for (int r = 0; r < 4; ++r) { const float bias = *(const LAS float*)((const LAS unsigned char*)biasL + ((pk4[r] >> 5) & 0x7C0u) + head * 4);
            float v = S[t][r] + bias; if (MASKED) v = (64 * s + 16 * t + 4 * g + r < cnt) ? v : -INFINITY; val[t][r] = v; cmax = fmaxf(cmax, v); } }
    cmax = xmax32(xmax16(cmax));
    const float mnew = fmaxf(st.mrun, cmax), mneg = -mnew * L2E;
    const float alpha = __builtin_amdgcn_exp2f(fmaf(st.mrun, L2E, mneg));
    float p[4][4]; float psum = 0.f;
#pragma unroll
    for (int t = 0; t < 4; ++t)
#pragma unroll
        for (int r = 0; r < 4; ++r) { p[t][r] = __builtin_amdgcn_exp2f(fmaf(val[t][r], L2E, mneg)); psum += p[t][r]; }
    psum = xsum32(xsum16(psum));
    const bool moved = __builtin_amdgcn_ballot_w64(mnew > st.mrun) != 0ull;
    st.lrun = st.lrun * alpha + psum; st.mrun = mnew;
    if (moved) {
#pragma unroll
        for (int dt = 0; dt < 8; ++dt) st.O[dt] = st.O[dt] * alpha; }
    union { bf16x8 v; unsigned u[4]; } pf[2];
#pragma unroll
    for (int hh = 0; hh < 2; ++hh) { pf[hh].u[0] = cvt_pk_bf16(p[2 * hh][0], p[2 * hh][1]); pf[hh].u[1] = cvt_pk_bf16(p[2 * hh][2], p[2 * hh][3]); pf[hh].u[2] = cvt_pk_bf16(p[2 * hh + 1][0], p[2 * hh + 1][1]); pf[hh].u[3] = cvt_pk_bf16(p[2 * hh + 1][2], p[2 * hh + 1][3]); }
#pragma unroll
    for (int dt = 0; dt < 8; ++dt)
#pragma unroll
        for (int hh = 0; hh < 2; ++hh) {
            union { bf16x8 v; s16x4 h[2]; } vf;
            vf.h[0] = tr_read(trbase + hh * 32 * VROW + dt * 32); vf.h[1] = tr_read(trbase + (hh * 32 + 16) * VROW + dt * 32);
            st.O[dt] = __builtin_amdgcn_mfma_f32_16x16x32_bf16(vf.v, pf[hh].v, st.O[dt], 0, 0, 0);
        }
    asm volatile("" ::: "memory");
}
__device__ __forceinline__ void attn_phase(const Frame& F, const Ptrs& P, bool dry = false) {
    constexpr int VROW = 288, VBYTES = 64 * VROW;
    LAS unsigned char* V = F.lds + F.wave * VBYTES;
    LAS unsigned short* listB = (LAS unsigned short*)(F.lds + 8 * VBYTES + F.wave * 1024);
    LAS float* biasL = (LAS float*)(F.lds + 8 * VBYTES + 8 * 1024);
    static_assert(8 * VBYTES + 8 * 1024 + 2048 <= MISC_OFF, "attention LDS map");
    bf16_t* QC = (bf16_t*)(P.ws + WS_QC); const bf16_t* CN = (const bf16_t*)(P.ws + WS_CN); const unsigned short* IDX = (const unsigned short*)(P.ws + WS_IDX);
    const int lane = F.lane, head = lane & 15, g = lane >> 4;
    if (F.tid < 512) biasL[F.tid] = P.in[18][F.tid];
    __syncthreads();
    const int gw = F.vcu * NWAVES + F.wave, NGW = F.G * NWAVES;
    const int trq = (lane & 15) >> 2, trp = lane & 3;
    const LAS unsigned char* trbase = V + (4 * g + trq) * VROW + 8 * trp;
#define ATT_LOAD(buf, ss, listL, cnb) do { const u32x4 l0_ = *(const LAS u32x4*)(listL + 64 * (ss) + 16 * (lane >> 4)), l1_ = *(const LAS u32x4*)(listL + 64 * (ss) + 16 * (lane >> 4) + 8); \
        _Pragma("unroll") for (int i = 0; i < 16; ++i) { const unsigned w_ = (i < 8) ? l0_[(i & 7) >> 1] : l1_[(i & 7) >> 1]; const unsigned pk = (i & 1) ? (w_ >> 16) : (w_ & 0xffffu); \
            buf[i] = *(const bf16x8*)(cnb + (((pk & 2047u) << 8) + (unsigned)(lane & 15) * 16u)); } } while (0)
#define ATT_TOKEN(k_) ((k_) * NGW + ((gw + 256 * (k_)) % NGW))
    unsigned long long lstn = 0ull; bf16x8 qfn[4]; bf16x8 cf[16];
    if (ATT_TOKEN(0) < M) { const int t0_ = ATT_TOKEN(0); lstn = *(const unsigned long long*)(IDX + (size_t)t0_ * 256 + 4 * lane); const bf16_t* qp = QC + (size_t)t0_ * NATT + head * 128 + 8 * g;
#pragma unroll
        for (int ks = 0; ks < 4; ++ks) qfn[ks] = *(const bf16x8*)(qp + 32 * ks);
        asm volatile("" ::: "memory");
        *(LAS unsigned long long*)(listB + 4 * lane) = lstn;
        asm volatile("" ::: "memory");
        const char* cnb0 = (const char*)(CN + (size_t)__builtin_amdgcn_readfirstlane(t0_ >> 11) * SEQ * 128);
        ATT_LOAD(cf, 0, listB, cnb0); }
    for (int kr = 0; kr * NGW < M; ++kr) {
        const int token = ATT_TOKEN(kr); if (token >= M) break;
        const int b = token >> 11, pos = token & (SEQ - 1), cnt = pos + 1 < TOPK ? pos + 1 : TOPK, nstep = (cnt + 63) >> 6;
        LAS unsigned short* listL = listB + (kr & 1) * 256;
        bf16x8 qf[4];
#pragma unroll
        for (int ks = 0; ks < 4; ++ks) qf[ks] = qfn[ks];
        const char* cnb = (const char*)(CN + (size_t)__builtin_amdgcn_readfirstlane(b) * SEQ * 128);
        const int nt_ = ((kr + 1) * NGW < M) ? ATT_TOKEN(kr + 1) : M;
        if (nt_ < M) { lstn = *(const unsigned long long*)(IDX + (size_t)nt_ * 256 + 4 * lane); const bf16_t* qp = QC + (size_t)nt_ * NATT + head * 128 + 8 * g;
#pragma unroll
            for (int ks = 0; ks < 4; ++ks) qfn[ks] = *(const bf16x8*)(qp + 32 * ks); }
        AttState st; st.mrun = -INFINITY; st.lrun = 0.f;
#pragma unroll
        for (int dt = 0; dt < 8; ++dt) st.O[dt] = (f32x4){0.f, 0.f, 0.f, 0.f};
        for (int s = 0; s < nstep; ++s) {
            f32x4 S[4];
            att_stage(cf, V, lane);
            if (s + 1 < nstep) ATT_LOAD(cf, s + 1, listL, cnb);
            else if (nt_ < M) {
                LAS unsigned short* ln = listB + ((kr + 1) & 1) * 256;
                asm volatile("" ::: "memory");
                *(LAS unsigned long long*)(ln + 4 * lane) = lstn;
                asm volatile("" ::: "memory");
                const char* cnbn = (const char*)(CN + (size_t)__builtin_amdgcn_readfirstlane(nt_ >> 11) * SEQ * 128);
                ATT_LOAD(cf, 0, ln, cnbn); }
            att_qk(qf, S, V, lane, g);
            if (64 * (s + 1) > cnt) att_sm_pv<true>(S, s, cnt, st, listL, biasL, trbase, head, g); else att_sm_pv<false>(S, s, cnt, st, listL, biasL, trbase, head, g);
        }
        const float inv = 1.0f / st.lrun;
        bf16_t* op = QC + (size_t)token * NATT + head * 128 + 4 * g;
        if (dry) { asm volatile("" :: "v"(st.O[0]), "v"(st.O[7]), "v"(inv)); bf16_t* qp = QC + (size_t)token * NATT + head * 128 + 8 * g;
#pragma unroll
            for (int ks = 0; ks < 4; ++ks) *(bf16x8*)(qp + 32 * ks) = qf[ks]; continue; }
#pragma unroll
        for (int dt = 0; dt < 8; ++dt) { u32x2 wv; wv.x = cvt_pk_bf16(st.O[dt][0] * inv, st.O[dt][1] * inv); wv.y = cvt_pk_bf16(st.O[dt][2] * inv, st.O[dt][3] * inv); *(u32x2*)(op + 16 * dt) = wv; }
    }
#undef ATT_LOAD
#undef ATT_TOKEN
}


#ifndef NAIVE_IDX
#define NAIVE_IDX 0
#endif
#ifndef NAIVE_ATT
#define NAIVE_ATT 0
#endif
__device__ __forceinline__ void naive_index_phase(const Frame& F, const Ptrs& P, int j) {
    LAS float* sc = (LAS float*)F.lds;
    LAS float* qiL = sc + 2048;
    LAS float* wL = qiL + 512;
    LAS int* cntL = (LAS int*)(wL + 8);
    LAS unsigned char* bkL = (LAS unsigned char*)(cntL + 520);
    const bf16_t* QC = (const bf16_t*)(P.ws + WS_QC); bf16_t* CN = (bf16_t*)(P.ws + WS_CN); unsigned short* IDX = (unsigned short*)(P.ws + WS_IDX);
    const int tid = F.tid;
    if (tid < 128) { const int n = tid; int bk = n; if (n >= 16) { bk = 16 + (int)(logf((float)n / 16.0f) / 2.0794415416798357f * 16.0f); bk = bk > 31 ? 31 : bk; } bkL[n] = (unsigned char)bk; }
    __syncthreads();
    for (int tok = F.vcu; tok < M; tok += F.G) {
        const int b = tok >> 11, pos = tok & (SEQ - 1), n = pos + 1;
        if (tid < 64) {
            const unsigned cw = *(const unsigned*)(QC + (size_t)tok * NATT + QC_C + 2 * tid); const float c0 = bflo(cw), c1 = bfhi(cw);
            const float ss = wave_sum(c0 * c0 + c1 * c1); const float rs = rsqrtf(ss * (1.0f / 128.0f) + EPS); const float* g = P.in[14] + (size_t)j * 128 + 2 * tid;
            *(unsigned*)(CN + (size_t)tok * 128 + 2 * tid) = cvt_pk_bf16(c0 * rs * g[0], c1 * rs * g[1]);
        }
        qiL[tid] = bf2f(QC[(size_t)tok * NATT + QC_QI + tid]);
        if (tid < 8) wL[tid] = bf2f(QC[(size_t)tok * NATT + QC_WI + tid]);
        __syncthreads();
        for (int key = tid; key < SEQ; key += NTHREADS) {
            float s = -INFINITY;
            if (key <= pos) { const bf16_t* kp = QC + ((size_t)b * SEQ + key) * NATT + QC_KI; s = 0.f;
                for (int h = 0; h < 8; ++h) { float d = 0.f; for (int e = 0; e < 64; ++e) d = fmaf(qiL[h * 64 + e], bf2f(kp[e]), d); s = fmaf(wL[h], fmaxf(d, 0.f), s); }
                s = s + 0.0f; }
            sc[key] = s;
        }
        __syncthreads();
        unsigned short* out = IDX + (size_t)tok * 256;
        if (n <= TOPK) { if (tid < 256) { const int dist = pos - tid; const unsigned bk = (dist >= 0) ? (dist >= 128 ? 31u : (unsigned)bkL[dist]) : 0u; out[tid] = (tid < n) ? (unsigned short)(tid | (bk << 11)) : (unsigned short)0; } }
        else {
            bool sel[4]; int mycnt = 0;
            for (int e = 0; e < 4; ++e) { const int i = tid * 4 + e; sel[e] = false;
                if (i <= pos) { const float si = sc[i]; int rank = 0; for (int jx = 0; jx <= pos; ++jx) { const float sj = sc[jx]; rank += (sj > si || (sj == si && jx < i)) ? 1 : 0; } sel[e] = rank < TOPK; }
                mycnt += sel[e] ? 1 : 0; }
            cntL[tid] = mycnt;
            __syncthreads();
            int basep = 0; for (int t2 = 0; t2 < tid; ++t2) basep += cntL[t2];
            for (int e = 0; e < 4; ++e) if (sel[e]) { const int i = tid * 4 + e; const int dist = pos - i; const unsigned bk = dist >= 128 ? 31u : (unsigned)bkL[dist]; out[basep++] = (unsigned short)(i | (bk << 11)); }
        }
        __syncthreads();
    }
}
__device__ __forceinline__ void naive_attn_phase(const Frame& F, const Ptrs& P) {
    bf16_t* QC = (bf16_t*)(P.ws + WS_QC); const bf16_t* CN = (const bf16_t*)(P.ws + WS_CN); const unsigned short* IDX = (const unsigned short*)(P.ws + WS_IDX);
    LAS float* pL = (LAS float*)(F.lds + F.wave * 4096);
    LAS int* kL = (LAS int*)(pL + 256);
    LAS float* oL = (LAS float*)(kL + 256);
    const int lane = F.lane, gw = F.vcu * NWAVES + F.wave, NGW = F.G * NWAVES;
    for (int token = gw; token < M; token += NGW) {
        const int b = token >> 11, pos = token & (SEQ - 1), cnt = pos + 1 < TOPK ? pos + 1 : TOPK;
        float qv[16][2];
#pragma unroll
        for (int h = 0; h < 16; ++h) { qv[h][0] = bf2f(QC[(size_t)token * NATT + h * 128 + lane]); qv[h][1] = bf2f(QC[(size_t)token * NATT + h * 128 + 64 + lane]); }
        for (int s = lane; s < 256; s += 64) kL[s] = IDX[(size_t)token * 256 + s];
        LDS_WAIT(); asm volatile("" ::: "memory");
#pragma unroll
        for (int h = 0; h < 16; ++h) {
            float mx = -INFINITY;
            for (int s = 0; s < cnt; ++s) { const int pk = kL[s]; const bf16_t* cp = CN + ((size_t)b * SEQ + (pk & 2047)) * 128;
                float d = qv[h][0] * bf2f(cp[lane]) + qv[h][1] * bf2f(cp[64 + lane]); d = wave_sum(d);
                d += P.in[18][(pk >> 11) * 16 + h]; if (lane == 0) pL[s] = d; mx = fmaxf(mx, d); }
            LDS_WAIT(); asm volatile("" ::: "memory");
            float sum = 0.f; for (int s = 0; s < cnt; ++s) sum += __expf(pL[s] - mx);
            float o0 = 0.f, o1 = 0.f;
            for (int s = 0; s < cnt; ++s) { const int pk = kL[s]; const bf16_t* cp = CN + ((size_t)b * SEQ + (pk & 2047)) * 128; const float p = __expf(pL[s] - mx) / sum;
                o0 = fmaf(p, bf2f(cp[lane]), o0); o1 = fmaf(p, bf2f(cp[64 + lane]), o1); }
            QC[(size_t)token * NATT + h * 128 + lane] = (bf16_t)(cvt_pk_bf16(o0, 0.f) & 0xffffu); QC[(size_t)token * NATT + h * 128 + 64 + lane] = (bf16_t)(cvt_pk_bf16(o1, 0.f) & 0xffffu);
            asm volatile("" ::: "memory");
        }
    }
}


#ifndef MK_DEBUG_CHECKS
#define MK_DEBUG_CHECKS 0
#endif
#if MK_DEBUG_CHECKS
constexpr size_t WS_DIAG = 224 * MiB, WS_SAVE = 225 * MiB, WS_SAVEG = 226 * MiB, WS_TMPO = 227 * MiB;
constexpr int NS = 256;
__device__ __forceinline__ int srow(int s) { return ((s & 63) << 8) | ((s * 37 + 11) & 255); }
__device__ __forceinline__ float diag_err(float mine, float ref) { float e = fabsf(mine - ref) / (fabsf(ref) + 0.25f); if (!(e == e)) e = 1e9f; return e; }
__device__ __forceinline__ void diag_max(unsigned char* ws, int id, float e) {
    for (int o = 1; o < 64; o <<= 1) e = fmaxf(e, __shfl_xor(e, o));
    if ((threadIdx.x & 63) == 0) atomicMax((unsigned*)(ws + WS_DIAG) + id, __float_as_uint(e));
}
__device__ __forceinline__ void diag_put(unsigned char* ws, int id, float mine, float ref) { diag_max(ws, id, diag_err(mine, ref)); }
__device__ __forceinline__ float d_rs(const unsigned char* ws, int row) { const float* p = (const float*)(ws + WS_SSQ) + (size_t)row * 16; float s = 0.f; for (int i = 0; i < 16; ++i) s += p[i]; return rsqrtf(s / 1024.f + EPS); }
__device__ __forceinline__ float d_bf(const unsigned char* ws, size_t off, size_t idx) { return bf2f(((const bf16_t*)(ws + off))[idx]); }
__global__ void chk_zero(unsigned char* ws) { if (threadIdx.x < 64) ((unsigned*)(ws + WS_DIAG))[threadIdx.x] = 0u; }
__global__ void chk_save_rows(unsigned char* ws, const float* src) { const int s = blockIdx.x; float* d = (float*)(ws + WS_SAVE) + s * 1024; for (int c = threadIdx.x; c < 1024; c += blockDim.x) d[c] = src[(size_t)srow(s) * D + c]; }
__global__ void chk_proj(unsigned char* ws, int id, size_t off_a, int lda, const float* W, int ldw, const float* gam, int K, int N, size_t off_o, int ldo, int mode) {
    const int s = blockIdx.y, row = srow(s), col = blockIdx.x * blockDim.x + threadIdx.x;
    float acc = 0.f; for (int k = 0; k < K; ++k) acc = fmaf(d_bf(ws, off_a, (size_t)row * lda + k) * (gam ? gam[k] : 1.f), W[(size_t)k * ldw + col], acc);
    acc *= d_rs(ws, row);
    if (mode == 1 && col < 1024) acc = 0.5f * acc * (1.f + tanhf(0.7978845608f * (acc + 0.044715f * acc * acc * acc)));
    if (mode == 2) { acc = fmaxf(acc, 0.f); acc *= acc; }
    diag_put(ws, id, d_bf(ws, off_o, (size_t)row * ldo + col), acc);
}
__global__ void chk_res(unsigned char* ws, int id, size_t off_a, int lda, const float* W, int K, const float* outp, const float* xold_full) {
    const int s = blockIdx.y, row = srow(s), col = blockIdx.x * blockDim.x + threadIdx.x;
    float acc = 0.f; for (int k = 0; k < K; ++k) acc = fmaf(d_bf(ws, off_a, (size_t)row * lda + k), W[(size_t)k * D + col], acc);
    const float xo = xold_full ? xold_full[(size_t)row * D + col] : ((const float*)(ws + WS_SAVE))[s * 1024 + col];
    diag_put(ws, id, outp[(size_t)row * D + col], xo + acc);
    diag_put(ws, id, d_bf(ws, WS_XB, (size_t)row * D + col), xo + acc);
}
__global__ void chk_ssq(unsigned char* ws, int id, const float* outp) {
    const int s = blockIdx.x * blockDim.x + threadIdx.x; const int row = srow(s); float q = 0.f; for (int c = 0; c < D; ++c) { const float v = outp[(size_t)row * D + c]; q += v * v; }
    const float* p = (const float*)(ws + WS_SSQ) + (size_t)row * 16; float t = 0.f; for (int i = 0; i < 16; ++i) t += p[i]; diag_put(ws, id, t, q);
}
__global__ void chk_conv(unsigned char* ws, int id, const float* cw, const float* cb) {
    const int s = blockIdx.y, row = srow(s) & ~3 | (s & 3) * 0, ch = blockIdx.x * blockDim.x + threadIdx.x;
    const int rr = (s < 16) ? ((s >> 1) * SEQ + (s & 1) * 256 * 3 + (s & 3)) : srow(s); const int pos = rr & (SEQ - 1);
    float acc = cb[ch]; for (int k = 0; k < 4; ++k) { const int p = pos - 3 + k; if (p >= 0) acc += cw[k * D + ch] * d_bf(ws, WS_GX, (size_t)(rr - 3 + k) * 2048 + 1024 + ch); }
    diag_put(ws, id, d_bf(ws, WS_XC, (size_t)rr * D + ch), acc);
}
__global__ void chk_gates(unsigned char* ws, int id, const float* wa, const float* ba, const float* wx, const float* bx) {
    const int s = blockIdx.y, row = srow(s), ch = blockIdx.x * blockDim.x + threadIdx.x, blk = ch >> 8, i = ch & 255;
    float a = ba[ch], x = bx[ch]; for (int jx = 0; jx < 256; ++jx) { const float v = d_bf(ws, WS_XC, (size_t)row * D + blk * 256 + jx); a = fmaf(v, wa[(size_t)blk * 65536 + jx * 256 + i], a); x = fmaf(v, wx[(size_t)blk * 65536 + jx * 256 + i], x); }
    diag_put(ws, id, d_bf(ws, WS_RB, (size_t)row * D + ch), 1.f / (1.f + expf(-a))); diag_put(ws, id, d_bf(ws, WS_IB, (size_t)row * D + ch), 1.f / (1.f + expf(-x)));
}
__global__ void chk_save_gate(unsigned char* ws) {
    const int p = blockIdx.x, b = p & 7, ch = (p * 61 + 5) & 1023; bf16_t* d = (bf16_t*)(ws + WS_SAVEG) + p * 2048;
    for (int t = threadIdx.x; t < SEQ; t += blockDim.x) d[t] = ((const bf16_t*)(ws + WS_GX))[((size_t)b * SEQ + t) * 2048 + ch];
}
__global__ void chk_scan(unsigned char* ws, int id, const float* lam) {
    const int p = blockIdx.x * blockDim.x + threadIdx.x; const int b = p & 7, ch = (p * 61 + 5) & 1023;
    const float sp = -8.f * log1pf(expf(-lam[ch])); float h = 0.f, em = 0.f;
    for (int t = 0; t < SEQ; ++t) { const size_t r = (size_t)b * SEQ + t; const float rr = d_bf(ws, WS_RB, r * D + ch), ii = d_bf(ws, WS_IB, r * D + ch), xc = d_bf(ws, WS_XC, r * D + ch);
        const float la = sp * rr, a = expf(la), u = sqrtf(-expm1f(2.f * la)) * (ii * xc); h = a * h + u;
        const float g = bf2f(((const bf16_t*)(ws + WS_SAVEG))[p * 2048 + t]); em = fmaxf(em, diag_err(d_bf(ws, WS_GX, r * 2048 + ch), h * g)); }
    diag_max(ws, id, em);
}
__global__ void chk_att_in(unsigned char* ws, int id, const float* Win, const float* wuk, const float* gam) {
    const int s = blockIdx.y, row = srow(s), col = blockIdx.x * blockDim.x + threadIdx.x;
    const float rs = d_rs(ws, row); float ref = 0.f;
    if (col < 2048) { const int h = col >> 7, c = col & 127;
        for (int d = 0; d < 64; ++d) { float q = 0.f; for (int k = 0; k < D; ++k) q = fmaf(d_bf(ws, WS_XB, (size_t)row * D + k) * gam[k], Win[(size_t)k * ATT_IN + h * 64 + d], q); ref = fmaf(q, wuk[((size_t)h * 64 + d) * 128 + c], ref); }
        ref *= rs * 0.125f; }
    else if (col < 2760) { const int wc = 1024 + (col - 2048); for (int k = 0; k < D; ++k) ref = fmaf(d_bf(ws, WS_XB, (size_t)row * D + k) * gam[k], Win[(size_t)k * ATT_IN + wc], ref); ref *= rs * (col >= 2752 ? 0.044194173824159216f : 1.f); }
    diag_put(ws, id, d_bf(ws, WS_QC, (size_t)row * NATT + col), ref);
}
__global__ void chk_cn(unsigned char* ws, int id, const float* g) {
    const int s = blockIdx.x, row = srow(s), c = threadIdx.x; float ss = 0.f; for (int e = 0; e < 128; ++e) { const float v = d_bf(ws, WS_QC, (size_t)row * NATT + QC_C + e); ss += v * v; }
    diag_put(ws, id, d_bf(ws, WS_CN, (size_t)row * 128 + c), d_bf(ws, WS_QC, (size_t)row * NATT + QC_C + c) * rsqrtf(ss / 128.f + EPS) * g[c]);
}
__global__ void chk_att_o(unsigned char* ws, const float* wuv) {
    const int s = blockIdx.y, row = srow(s), n = blockIdx.x * blockDim.x + threadIdx.x, h = n >> 6, v = n & 63; float a = 0.f;
    for (int c = 0; c < 128; ++c) a = fmaf(d_bf(ws, WS_QC, (size_t)row * NATT + h * 128 + c), wuv[((size_t)h * 128 + c) * 64 + v], a);
    ((float*)(ws + WS_TMPO))[s * 1024 + n] = a;
}
__global__ void chk_att_out(unsigned char* ws, int id, const float* wo, const float* outp) {
    const int s = blockIdx.y, row = srow(s), col = blockIdx.x * blockDim.x + threadIdx.x; float a = 0.f;
    for (int k = 0; k < 1024; ++k) a = fmaf(((const float*)(ws + WS_TMPO))[s * 1024 + k], wo[(size_t)k * D + col], a);
    diag_put(ws, id, outp[(size_t)row * D + col], ((const float*)(ws + WS_SAVE))[s * 1024 + col] + a);
}
__global__ void chk_report(unsigned char* ws, float* outp) {
    if (threadIdx.x == 0) { const unsigned* dg = (const unsigned*)(ws + WS_DIAG); for (int id = 1; id < 40; ++id) { const float e = __uint_as_float(dg[id]); if (e > 0.1f) { outp[0] = 100.f * id + 10.f; break; } } }
}
#endif


#ifndef MK_DETCHECK
#define MK_DETCHECK 0
#endif
#if MK_DETCHECK
constexpr size_t WS_CKS = 230 * MiB;
__global__ void cks_zero(unsigned* d) { d[threadIdx.x] = 0u; }
__global__ void lds_poison(unsigned pat) { extern __shared__ unsigned lp[]; for (int i = threadIdx.x; i < LDS_BYTES / 4; i += blockDim.x) lp[i] = pat; __syncthreads(); if (lp[threadIdx.x] != pat) asm volatile("s_nop 0"); }
__global__ void cks_kernel(const unsigned* p, size_t nwords, unsigned* dst) {
    unsigned a = 0u; for (size_t i = (size_t)blockIdx.x * blockDim.x + threadIdx.x; i < nwords; i += (size_t)gridDim.x * blockDim.x) a += p[i] * 2654435761u + (unsigned)i;
    for (int o = 1; o < 64; o <<= 1) a += __shfl_xor(a, o);
    if ((threadIdx.x & 63) == 0) atomicAdd(dst, a);
}
__global__ void cks_report(const unsigned* d, float* outp) { if (threadIdx.x == 0) for (int ph = 0; ph < 64; ++ph) if (d[ph] != d[64 + ph]) { outp[0] = 100.f * (ph + 1) + 10.f; break; } }
#endif

constexpr int N_PHASES = 28;
#ifndef MK_PER_PHASE
#define MK_PER_PHASE 0
#endif

__global__ void __launch_bounds__(NTHREADS, 2) trunk_fwd(Args args) {
    extern __shared__ __attribute__((aligned(16))) unsigned char lds_raw[];
    Frame F0;
    F0.lds = (LAS unsigned char*)lds_raw;
    F0.tid = threadIdx.x; F0.lane = F0.tid & 63; F0.wave = __builtin_amdgcn_readfirstlane(F0.tid >> 6);
    F0.G = gridDim.x; F0.bid = blockIdx.x; { const int bx = blockIdx.x; F0.vcu = (F0.G % 8 == 0) ? (bx % 8) * (F0.G / 8) + bx / 8 : bx; }
    volatile LAS unsigned* MISC = (volatile LAS unsigned*)(F0.lds + MISC_OFF);
    for (int u = F0.tid; u < (LDS_BYTES - LDSCTL_OFF) / 4; u += NTHREADS) ((LAS unsigned*)(F0.lds + LDSCTL_OFF))[u] = 0u;
    __syncthreads();
    unsigned* barw = (unsigned*)(args.ws + WS_CTL) + CW_BAR;
    XcdBarrier bar; bar.bar = barw; bar.x = 0; bar.st = nullptr;
    if (!MK_PER_PHASE) bar = xcd_barrier_post(barw, MISC + 8);
    const int lo = args.ph_lo, hi = args.ph_hi;
#ifndef PHMASK
#define PHMASK 0xFFFFu
#endif
#define PM(b) ((PHMASK >> (b)) & 1u)

#define IN(k) (lo <= (k) && (k) < hi)
#define SEAM(k) do { if (IN(k) && IN((k) + 1)) xcd_barrier(bar); } while (0)

#define PHASE_PTRS const Frame F = launder(F0); const Ptrs P = load_ptrs(); bf16_t* XB = (bf16_t*)(P.ws + WS_XB); float* SSQ = (float*)(P.ws + WS_SSQ); float* SSQM = (float*)(P.ws + WS_SSQM); \
    bf16_t* WM = (bf16_t*)(P.ws + WS_WMIX); bf16_t* WA = (bf16_t*)(P.ws + WS_WATT); bf16_t* WUP = (bf16_t*)(P.ws + WS_WUP); bf16_t* WDN = (bf16_t*)(P.ws + WS_WDOWN); \
    (void)XB; (void)SSQ; (void)SSQM; (void)WM; (void)WA; (void)WUP; (void)WDN

    if (PM(0) && IN(0)) { PHASE_PTRS; if (DB(0)) { cvt_att_mix(F, P, 0, 1); cvt_rec_mix(F, P, 0, 0); cvt_up(F, P, 0); cvt_down(F, P, 0); p0_rows(F, P); __syncthreads(); } cvt_att_mix(F, P, 0, 1, 0); cvt_att_mix(F, P, 1, 3, 1024); cvt_rec_mix(F, P, 0, 0); cvt_up(F, P, 0); cvt_down(F, P, 0); p0_rows(F, P); }
    SEAM(0);

    for (int L = 0; L < DEPTH; ++L) {
        const int pb = 1 + 7 * ((L + 1) >> 1) + 6 * (L >> 1), j = L >> 1, mo = (L & 1) ? 0 : 1;
        if ((L & 1) == 0) {
            if (PM(1) && IN(pb)) { PHASE_PTRS;
                { const Frame& F1 = F; (void)F1;
                pg8::Gemm g{XB, WM, D, D, D, -1}; pg8::StaticOrder S; S.init(M, 2048, F.G, F.bid);
                pg8::EpiScale<1> E{(bf16_t*)(P.ws + WS_GX), 2048, SSQ};
                if (DB(1)) pg8::gemm_phase(F.lds, F.tid, g, S, E);
                pg8::gemm_phase(F.lds, F.tid, g, S, E); } }
            SEAM(pb);
            if (PM(2) && IN(pb + 1)) { PHASE_PTRS;
                for (int rep = 0; rep < (DB(2) ? 2 : 1); ++rep) for (int p = F.vcu; p < 256; p += F.G) conv_tile(F, P, j, p >> 2, p & 3);
                if (L > 0) cvt_down(F, P, L);
                asm volatile("s_waitcnt vmcnt(0)" ::: "memory"); __syncthreads();
                pg8::Gemm g{(const bf16_t*)(P.ws + WS_XC), WM + WM_REC_GATE, D, D, 256, 3}; pg8::GateOrder S{F.G, F.vcu};
                pg8::EpiGate E{(bf16_t*)(P.ws + WS_RB), (bf16_t*)(P.ws + WS_IB), P.in[8] + (size_t)j * D, P.in[10] + (size_t)j * D};
                pg8::gemm_phase(F.lds, F.tid, g, S, E); }
            SEAM(pb + 2);
            if (PM(3) && IN(pb + 3)) { PHASE_PTRS; if (DB(3)) { scan_phase(F, P, j, true); __syncthreads(); } if (L > 0) { cvt_up(F, P, L); __syncthreads(); } scan_phase(F, P, j); }
            SEAM(pb + 3);
            if (PM(4) && IN(pb + 4)) { PHASE_PTRS;
                pg8::Gemm g{(const bf16_t*)(P.ws + WS_GX), WM + WM_REC_OUT, 2048, D, D, -1}; pg8::StaticOrder S; S.init(M, D, F.G, F.bid);
                pg8::EpiRes<false> E{XB, SSQM, nullptr};
                pg8::gemm_phase(F.lds, F.tid, g, S, E); }
            SEAM(pb + 4);
        } else {
            if (PM(5) && IN(pb)) { PHASE_PTRS;
                { const Frame& F1 = F; (void)F1;
                pg8::Gemm g{XB, WA + (size_t)j * 5 * MiB, D, D, D, -1}; pg8::StaticOrder S; S.init(M, NATT, F.G, F.bid);
                pg8::EpiScale<0> E{(bf16_t*)(P.ws + WS_QC), NATT, SSQ};
                pg8::gemm_phase(F.lds, F.tid, g, S, E); } }
            SEAM(pb);
            if (PM(6) && IN(pb + 1)) { PHASE_PTRS; cvt_down(F, P, L); if (L + 1 < DEPTH) cvt_rec_mix(F, P, (L + 1) >> 1, L + 1); __syncthreads(); if (DB(6)) { index_phase(F, P, j); __syncthreads(); } if (NAIVE_IDX) naive_index_phase(F, P, j); else index_phase(F, P, j); }
            SEAM(pb + 1);
            if (PM(7) && IN(pb + 2)) { PHASE_PTRS; cvt_up(F, P, L); __syncthreads(); if (DB(7)) { attn_phase(F, P, true); __syncthreads(); } if (NAIVE_ATT) naive_attn_phase(F, P); else attn_phase(F, P); }
            SEAM(pb + 2);
            if (PM(8) && IN(pb + 3)) { PHASE_PTRS;
                pg8::Gemm g{(const bf16_t*)(P.ws + WS_QC), WA + (size_t)j * 5 * MiB + WM_ATT_COMB, NATT, 2048, 2048, -1}; pg8::StaticOrder S; S.init(M, D, F.G, F.bid);
                pg8::EpiRes<false> E{XB, SSQM, nullptr};
                pg8::gemm_phase(F.lds, F.tid, g, S, E); }
            SEAM(pb + 3);
        }
        if (PM(9) && IN(pb + 4 + mo)) { PHASE_PTRS;
            { const Frame& F1 = F; (void)F1;
            pg8::Gemm g{XB, WUP, D, D, D, -1}; pg8::StaticOrder S; S.init(M, FF, F.G, F.bid);
            pg8::EpiScale<2> E{(bf16_t*)(P.ws + WS_H), FF, nullptr};
            if (DB(9)) pg8::gemm_phase(F.lds, F.tid, g, S, E);
            pg8::gemm_phase(F.lds, F.tid, g, S, E); } }
        SEAM(pb + 4 + mo);
        if (PM(10) && IN(pb + 5 + mo)) { PHASE_PTRS;
            { const Frame& F1 = F; (void)F1;
            pg8::Gemm g{(const bf16_t*)(P.ws + WS_H), WDN, FF, FF, FF, -1}; pg8::StaticOrder S; S.init(M, D, F.G, F.bid);
            pg8::EpiRes<true> E{XB, SSQ, SSQM};
            pg8::gemm_phase(F.lds, F.tid, g, S, E); } }
        SEAM(pb + 5 + mo);
    }
    if (PM(11) && IN(27)) { PHASE_PTRS; if (DB(11)) final_norm(F, P, true); final_norm(F, P); }
#undef IN
#undef SEAM
}

extern "C" void kernel_launch(void* const* d_in, const int* in_sizes, int n_in, void* d_out, int out_size, void* d_ws, size_t ws_size, hipStream_t stream) {
    static int grid = 0;
    if (grid == 0) {
        if (n_in != 21 || in_sizes[0] != M * D || out_size != M * D || ws_size < WS_END) { fprintf(stderr, "kernel_launch: unexpected shapes (n_in %d, in0 %d, out %d, ws %zu)\n", n_in, n_in > 0 ? in_sizes[0] : -1, out_size, ws_size); grid = -1; return; }
        int dev = 0, cus = 0, per_cu = 0;
        if (hipGetDevice(&dev) != hipSuccess || hipDeviceGetAttribute(&cus, hipDeviceAttributeMultiprocessorCount, dev) != hipSuccess) { grid = -1; return; }
        if (hipFuncSetAttribute((const void*)trunk_fwd, hipFuncAttributeMaxDynamicSharedMemorySize, LDS_BYTES) != hipSuccess) { fprintf(stderr, "kernel_launch: hipFuncSetAttribute failed\n"); grid = -1; return; }
        if (hipOccupancyMaxActiveBlocksPerMultiprocessor(&per_cu, (const void*)trunk_fwd, NTHREADS, LDS_BYTES) != hipSuccess || per_cu < 1) fprintf(stderr, "kernel_launch: occupancy query reports %d\n", per_cu);
        (void)hipGetLastError();
        grid = cus;
    }
    if (grid < 0) return;
    (void)hipMemsetAsync((char*)d_ws + WS_CTL, 0, CTL_ZERO_BYTES, stream);
    Args a{};
    for (int i = 0; i < 21; ++i) a.in[i] = (const float*)d_in[i];
    a.out = (float*)d_out; a.ws = (unsigned char*)d_ws;
#if MK_PER_PHASE
#if MK_DETCHECK
    unsigned char* wsb = (unsigned char*)d_ws; unsigned* ck = (unsigned*)(wsb + WS_CKS);
    cks_zero<<<1, 128, 0, stream>>>(ck);
    (void)hipFuncSetAttribute((const void*)lds_poison, hipFuncAttributeMaxDynamicSharedMemorySize, LDS_BYTES);
    for (int pass = 0; pass < 2; ++pass)
    for (int ph = 0; ph < N_PHASES; ++ph) {
        if (ph == 0) { (void)hipMemsetAsync(wsb + 65536, pass ? 0x55 : 0xAA, 224 * MiB - 65536, stream); (void)hipMemsetAsync(d_out, pass ? 0x55 : 0xAA, (size_t)M * D * 4, stream);
            hipLaunchKernelGGL(lds_poison, dim3(grid), dim3(NTHREADS), LDS_BYTES, stream, pass ? 0x55555555u : 0xAAAAAAAAu); }
        a.ph_lo = ph; a.ph_hi = ph + 1; hipLaunchKernelGGL(trunk_fwd, dim3(grid), dim3(NTHREADS), LDS_BYTES, stream, a);
        int L = -1, k = -1; { const int pbs[5] = {1, 8, 14, 21, 27}; for (int l = 0; l < 4; ++l) if (ph >= pbs[l] && ph < pbs[l + 1]) { L = l; k = ph - pbs[l]; } }
        const bool rec = (L & 1) == 0; unsigned* dst = ck + pass * 64 + ph;
        auto CK = [&](size_t off, size_t bytes) { cks_kernel<<<1024, 256, 0, stream>>>((const unsigned*)(wsb + off), bytes / 4, dst); };
        auto CKO = [&]() { cks_kernel<<<1024, 256, 0, stream>>>((const unsigned*)d_out, (size_t)M * D, dst); CK(WS_XB, 32 * MiB); CK(WS_SSQ, 1 * MiB); };
        if (ph == 0) { CK(WS_WMIX, 10 * MiB); CK(WS_WUP, 8 * MiB); CK(WS_WDOWN, 8 * MiB); CK(WS_XB, 32 * MiB); CK(WS_SSQ, 1 * MiB); }
        else if (ph == 27) { cks_kernel<<<1024, 256, 0, stream>>>((const unsigned*)d_out, (size_t)M * D, dst); }
        else if (rec) {
            if (k == 0) { CK(WS_GX, 64 * MiB); CK(WS_WDOWN, 8 * MiB); }
            if (k == 1) CK(WS_XC, 32 * MiB);
            if (k == 2) { CK(WS_RB, 32 * MiB); CK(WS_IB, 32 * MiB); }
            if (k == 3) CK(WS_GX, 64 * MiB);
            if (k == 4) CKO();
            if (k == 5) { CK(WS_H, 128 * MiB); CK(WS_WMIX, 10 * MiB); }
            if (k == 6) { CKO(); CK(WS_WUP, 8 * MiB); }
        } else {
            if (k == 0) { CK(WS_QC, 88 * MiB); CK(WS_WDOWN, 8 * MiB); }
            if (k == 1) { CK(WS_CN, 4 * MiB); CK(WS_IDX, 8 * MiB); }
            if (k == 2) CK(WS_QC, 88 * MiB);
            if (k == 3) CKO();
            if (k == 4) { CK(WS_H, 128 * MiB); CK(WS_WMIX, 10 * MiB); }
            if (k == 5) { CKO(); CK(WS_WUP, 8 * MiB); }
        }
    }
    cks_report<<<1, 64, 0, stream>>>(ck, (float*)d_out);
#else
#if MK_DEBUG_CHECKS
    unsigned char* ws = (unsigned char*)d_ws; const float** in = (const float**)a.in; float* outp = (float*)d_out;
    chk_zero<<<1, 64, 0, stream>>>(ws);
#endif
    for (int ph = 0; ph < N_PHASES; ++ph) {
#if MK_DEBUG_CHECKS
        int L = -1, k = -1; { const int pbs[5] = {1, 8, 14, 21, 27}; for (int l = 0; l < 4; ++l) if (ph >= pbs[l] && ph < pbs[l + 1]) { L = l; k = ph - pbs[l]; } }
        const int j = L >> 1, id0 = 10 * L; const bool rec = (L & 1) == 0;
        if (L >= 0) {
            if ((rec && k == 4 && L > 0) || (!rec && k == 3) || (rec && k == 6) || (!rec && k == 5)) chk_save_rows<<<NS, 256, 0, stream>>>(ws, outp);
            if (rec && k == 3) chk_save_gate<<<128, 256, 0, stream>>>(ws);
        }
#endif
        a.ph_lo = ph; a.ph_hi = ph + 1; hipLaunchKernelGGL(trunk_fwd, dim3(grid), dim3(NTHREADS), LDS_BYTES, stream, a);
#if MK_DEBUG_CHECKS
        if (L >= 0) {
          if (rec) {
            if (k == 0) chk_proj<<<dim3(8, NS), 256, 0, stream>>>(ws, id0 + 1, WS_XB, D, in[4] + (size_t)j * D * 2048, 2048, in[1] + L * D, D, 2048, WS_GX, 2048, 1);
            if (k == 1) chk_conv<<<dim3(4, NS), 256, 0, stream>>>(ws, id0 + 2, in[5] + (size_t)j * 4 * D, in[6] + (size_t)j * D);
            if (k == 2) chk_gates<<<dim3(4, NS), 256, 0, stream>>>(ws, id0 + 3, in[7] + (size_t)j * 4 * 65536, in[8] + (size_t)j * D, in[9] + (size_t)j * 4 * 65536, in[10] + (size_t)j * D);
            if (k == 3) chk_scan<<<2, 64, 0, stream>>>(ws, id0 + 4, in[11] + (size_t)j * D);
            if (k == 4) { chk_res<<<dim3(4, NS), 256, 0, stream>>>(ws, id0 + 5, WS_GX, 2048, in[12] + (size_t)j * D * D, D, outp, L == 0 ? in[0] : nullptr); chk_ssq<<<NS / 64, 64, 0, stream>>>(ws, id0 + 5, outp); }
            if (k == 5) chk_proj<<<dim3(16, NS), 256, 0, stream>>>(ws, id0 + 6, WS_XB, D, in[19] + (size_t)L * D * FF, FF, in[2] + L * D, D, FF, WS_H, FF, 2);
            if (k == 6) { chk_res<<<dim3(4, NS), 256, 0, stream>>>(ws, id0 + 7, WS_H, FF, in[20] + (size_t)L * FF * D, FF, outp, nullptr); chk_ssq<<<NS / 64, 64, 0, stream>>>(ws, id0 + 7, outp); }
          } else {
            if (k == 0) chk_att_in<<<dim3(11, NS), 256, 0, stream>>>(ws, id0 + 1, in[13] + (size_t)j * D * ATT_IN, in[15] + (size_t)j * 16 * 64 * 128, in[1] + L * D);
            if (k == 1) chk_cn<<<NS, 128, 0, stream>>>(ws, id0 + 2, in[14] + (size_t)j * 128);
            if (k == 3) { chk_att_o<<<dim3(4, NS), 256, 0, stream>>>(ws, in[16] + (size_t)j * 16 * 128 * 64); chk_att_out<<<dim3(4, NS), 256, 0, stream>>>(ws, id0 + 5, in[17] + (size_t)j * D * D, outp); chk_ssq<<<NS / 64, 64, 0, stream>>>(ws, id0 + 5, outp); }
            if (k == 4) chk_proj<<<dim3(16, NS), 256, 0, stream>>>(ws, id0 + 6, WS_XB, D, in[19] + (size_t)L * D * FF, FF, in[2] + L * D, D, FF, WS_H, FF, 2);
            if (k == 5) { chk_res<<<dim3(4, NS), 256, 0, stream>>>(ws, id0 + 7, WS_H, FF, in[20] + (size_t)L * FF * D, FF, outp, nullptr); chk_ssq<<<NS / 64, 64, 0, stream>>>(ws, id0 + 7, outp); }
          }
        }
#endif
    }
#if MK_DEBUG_CHECKS
    chk_report<<<1, 64, 0, stream>>>(ws, outp);
#endif
#endif
#else
    a.ph_lo = 0; a.ph_hi = N_PHASES;
    hipLaunchKernelGGL(trunk_fwd, dim3(grid), dim3(NTHREADS), LDS_BYTES, stream, a);
#endif
}
```

```cpp
#include <hip/hip_runtime.h>
#include <cstdio>
#include <cstdint>

#define LAS __attribute__((address_space(3)))
#define GAS __attribute__((address_space(1)))
typedef unsigned short bf16_t;
typedef short bf16x8 __attribute__((ext_vector_type(8)));
typedef short s16x4 __attribute__((ext_vector_type(4)));
typedef float f32x4 __attribute__((ext_vector_type(4)));
typedef float f32x2 __attribute__((ext_vector_type(2)));
typedef float f32x16 __attribute__((ext_vector_type(16)));
typedef unsigned u32x4 __attribute__((ext_vector_type(4)));
typedef unsigned u32x2 __attribute__((ext_vector_type(2)));
typedef unsigned short u16x4 __attribute__((ext_vector_type(4)));

constexpr int BATCH = 8, SEQ = 2048, D = 1024, M = BATCH * SEQ, DEPTH = 4, FF = 4096;
constexpr int H_ATT = 16, D_LAT = 128, H_IDX = 8, D_IDX = 64, TOPK = 256;
constexpr int ATT_IN = 1736;
constexpr int NATT = 2816;
constexpr int QC_C = 2048, QC_QI = 2176, QC_KI = 2688, QC_WI = 2752;
constexpr float EPS = 1e-6f;
constexpr int NWAVES = 8, NTHREADS = 512;

constexpr size_t MiB = 1u << 20;
constexpr size_t WS_CTL = 0, CTL_ZERO_BYTES = 64 * 1024;
constexpr size_t WS_SSQ = 1 * MiB;
constexpr size_t WS_WMIX = 2 * MiB;
constexpr size_t WS_WUP = 12 * MiB, WS_WDOWN = 20 * MiB;
constexpr size_t WS_XB = 28 * MiB;
constexpr size_t WS_BIG = 60 * MiB;
constexpr size_t WS_H = WS_BIG;
constexpr size_t WS_GX = WS_BIG;
constexpr size_t WS_XC = WS_BIG + 64 * MiB;
constexpr size_t WS_RB = WS_BIG + 96 * MiB;
constexpr size_t WS_IB = WS_BIG + 128 * MiB;
constexpr size_t WS_QC = WS_BIG;
constexpr size_t WS_CN = WS_BIG + 88 * MiB;
constexpr size_t WS_IDX = WS_BIG + 92 * MiB;
constexpr size_t WS_WATT = WS_BIG + 160 * MiB;
constexpr size_t WS_SSQM = WS_WATT + 20 * MiB;
constexpr size_t WS_END = WS_SSQM + 1 * MiB;
constexpr size_t WM_REC_GATE = (size_t)2048 * 1024, WM_REC_OUT = WM_REC_GATE + (size_t)2048 * 1024;
constexpr size_t WM_ATT_COMB = (size_t)NATT * 1024;

constexpr int RING_BYTES = 131072;
constexpr int LDSCTL_OFF = RING_BYTES;
constexpr int LDS_BYTES = 163840;
constexpr int MISC_OFF = LDS_BYTES - 512;
constexpr int BSL_OFF = 132096;

#ifndef DBLMASK
#define DBLMASK 0u
#endif
#define DB(b) ((DBLMASK >> (b)) & 1u)
typedef __bf16 bf16x2_t __attribute__((ext_vector_type(2)));
__device__ __forceinline__ unsigned cvt_pk_bf16(float lo, float hi) { const f32x2 v = {lo, hi}; return __builtin_bit_cast(unsigned, __builtin_convertvector(v, bf16x2_t)); }
__device__ __forceinline__ float bf2f(unsigned h) { return __uint_as_float(h << 16); }
__device__ __forceinline__ float bflo(unsigned w) { return __uint_as_float(w << 16); }
__device__ __forceinline__ float bfhi(unsigned w) { return __uint_as_float(w & 0xffff0000u); }
__device__ __forceinline__ float wave_sum(float v) {
#pragma unroll
    for (int o = 1; o < 64; o <<= 1) v += __shfl_xor(v, o);
    return v;
}
#ifndef WT_STORES
#define WT_STORES 1
#endif
__device__ __forceinline__ void store16_wt(void* p, u32x4 v) {
#if WT_STORES
    asm volatile("global_store_dwordx4 %0, %1, off sc1\n\ts_nop 1" :: "v"(p), "v"(v) : "memory");
#else
    *(u32x4*)p = v;
#endif
}
#define LDS_WAIT() asm volatile("s_waitcnt lgkmcnt(0)" ::: "memory")
#define VM_WAIT() asm volatile("s_waitcnt vmcnt(0)" ::: "memory")

#define XB_TMO      128
#define XB_XCNT(j)  (256  + 64 * (j))
#define XB_XSUB(j)  (1280 + 64 * (j))
#define XB_XGEN(j)  (2304 + 64 * (j))
#define XB_TOP      3328
#define XB_TOPGEN   3392
#define XCD_BAR_WORDS 3456
#define XB_SPIN_CAP (1u << 22)
constexpr int CW_BAR = 4096;
static_assert((CW_BAR + XCD_BAR_WORDS) * 4 <= (int)CTL_ZERO_BYTES, "barrier words inside the memset region");

__device__ __forceinline__ unsigned xb_ld(unsigned* p)              { return __hip_atomic_load(p, __ATOMIC_RELAXED, __HIP_MEMORY_SCOPE_AGENT); }
__device__ __forceinline__ unsigned xb_add(unsigned* p, unsigned v) { return __hip_atomic_fetch_add(p, v, __ATOMIC_RELAXED, __HIP_MEMORY_SCOPE_AGENT); }
__device__ __forceinline__ unsigned xb_xcc_id() { return (unsigned)__builtin_amdgcn_s_getreg((3 << 11) | 20) & 0xFu; }
#define XB_SPIN(cond, bar) do { unsigned _sp = 0; while (cond) { __builtin_amdgcn_s_sleep(1); \
    if ((++_sp & 255u) == 0u) { if (xb_ld(&(bar)[XB_TMO])) break; if (_sp > XB_SPIN_CAP) { atomicAdd(&(bar)[XB_TMO], 1u); break; } } } } while (0)

struct XcdBarrier { unsigned* bar; unsigned x; volatile LAS unsigned* st; };

__device__ __forceinline__ XcdBarrier xcd_barrier_post(unsigned* bar, volatile LAS unsigned* st) {
    XcdBarrier b; b.bar = bar; b.x = xb_xcc_id(); b.st = st;
    if (threadIdx.x == 0) (void)xb_add(&bar[XB_XCNT(b.x)], 1u);
    return b;
}
__device__ __forceinline__ void xcd_barrier_complete(unsigned* bar, unsigned x, unsigned& nloc, unsigned& nx) {
    const unsigned G = gridDim.x * gridDim.y * gridDim.z;
    unsigned sum, cnt, mine, sp = 0u;
    for (;;) {
        sum = 0u; cnt = 0u; mine = 0u;
#pragma unroll
        for (unsigned j = 0; j < 16; ++j) { const unsigned c = xb_ld(&bar[XB_XCNT(j)]); sum += c; cnt += (c > 0u) ? 1u : 0u; mine = (j == x) ? c : mine; }
        if (sum == G) break;
        __builtin_amdgcn_s_sleep(1);
        if ((++sp & 255u) == 0u) { if (xb_ld(&bar[XB_TMO])) break; if (sp > XB_SPIN_CAP) { atomicAdd(&bar[XB_TMO], 1u); break; } }
    }
    nloc = mine > 0u ? mine : 1u; nx = cnt > 0u ? cnt : 1u;
}
__device__ __forceinline__ void xcd_barrier(const XcdBarrier& b) {
    asm volatile("s_waitcnt vmcnt(0)" ::: "memory");
    __syncthreads();
    if (threadIdx.x == 0) {
        unsigned* bar = b.bar;
        __builtin_amdgcn_s_waitcnt(0);
        unsigned nloc = b.st[0], nx = b.st[1];
        if (nloc == 0u) { xcd_barrier_complete(bar, b.x, nloc, nx); b.st[0] = nloc; b.st[1] = nx; }
        const unsigned old = xb_add(&bar[XB_XSUB(b.x)], 1u);
        const unsigned gen = old / nloc;
        if (old + 1u == (gen + 1u) * nloc) {
            __builtin_amdgcn_fence(__ATOMIC_RELEASE, "agent");
            asm volatile("s_waitcnt vmcnt(0)" ::: "memory");
            const unsigned og = xb_add(&bar[XB_TOP], 1u);
            const unsigned tg = og / nx;
            if (og + 1u == (tg + 1u) * nx) xb_add(&bar[XB_TOPGEN], 1u);
            else XB_SPIN(xb_ld(&bar[XB_TOPGEN]) == tg, bar);
            __builtin_amdgcn_fence(__ATOMIC_ACQUIRE, "agent");
            xb_add(&bar[XB_XGEN(b.x)], 1u);
            asm volatile("s_waitcnt vmcnt(0)" ::: "memory");
        } else {
            XB_SPIN(xb_ld(&bar[XB_XGEN(b.x)]) == gen, bar);
            __builtin_amdgcn_fence(__ATOMIC_ACQUIRE, "agent");
            asm volatile("s_waitcnt vmcnt(0)" ::: "memory");
        }
    }
    __syncthreads();
}

namespace pg8 {
constexpr int BM = 256, BK = 64, HALF = 128, HTB = HALF * BK * 2, NXCD = 8, WGM = 8;
__device__ __forceinline__ int lds_byte(int r, int c) { const int st = (r >> 4) * 2 + (c >> 5), rr = r & 15, cc = c & 31, ob = rr * 64 + cc * 2; return st * 1024 + (ob ^ (((ob >> 9) & 1) << 5)); }
__device__ __forceinline__ void stage_rc(int b, int& R, int& C) { const int st = b / 1024, sb = b % 1024, swz = sb ^ (((sb >> 9) & 1) << 5); R = (st >> 1) * 16 + swz / 64; C = (st & 1) * 32 + (swz % 64) / 2; }
__device__ __forceinline__ int perm32(int rho) { const int n = rho >> 4, i = rho & 15; return 8 * (i >> 2) + 4 * n + (i & 3); }

struct Unit { int pm, pn; };
struct Gemm { const bf16_t* A; const bf16_t* Bt; int lda, ldb, K, a_shift; };

struct StaticOrder {
    int nM, nN, nwg, G, c;
    __device__ void init(int Mr, int N, int G_, int c_) { nM = Mr / BM; nN = N / BM; nwg = nM * nN; G = G_; c = c_; }
    __device__ bool next(int i, Unit& u) const {
        const long L = (long)i * G + c; if (L >= nwg) return false;
        int wgid = (int)L; { const int q = nwg / NXCD, r = nwg % NXCD, xcd = wgid % NXCD, off = wgid / NXCD; wgid = (xcd < r ? xcd * (q + 1) : r * (q + 1) + (xcd - r) * q) + off; }
        const int nig = WGM * nN, gid = wgid / nig, fm = gid * WGM, gsz = (nM - fm) < WGM ? (nM - fm) : WGM;
        u.pm = fm + ((wgid % nig) % gsz); u.pn = (wgid % nig) / gsz; return true;
    }
};
struct GateOrder {
    int G, c;
    __device__ bool next(int i, Unit& u) const { const int p = c + (i >> 1) * G; if (p >= 256) return false; u.pm = p >> 2; u.pn = 4 * (i & 1) + (p & 3); return true; }
};

template <class Epi, class Sched>
__device__ __forceinline__ void gemm_phase(LAS unsigned char* lds, int tid, const Gemm g, const Sched& S, const Epi& E) {
    const int wid = __builtin_amdgcn_readfirstlane(tid >> 6), lane = tid & 63, wr = wid >> 2, wc = wid & 3, fr = lane & 15, fq = lane >> 4;
    int Kq = g.K; asm volatile("" : "+s"(Kq)); const int nt = Kq / BK;
    unsigned voffA[2], voffB[2];
#pragma unroll
    for (int i = 0; i < 2; ++i) { int R, C; stage_rc(tid * 16 + i * 8192, R, C); const int Rb = Epi::PERM ? ((R & ~31) + perm32(R & 31)) : R;
        voffA[i] = (unsigned)(R * g.lda + C) * 2u; voffB[i] = (unsigned)(Rb * g.ldb + C) * 2u; }
    const size_t kstep = (size_t)(BK * 2);
    const size_t hA = (size_t)HALF * g.lda * 2, hB = (size_t)HALF * g.ldb * 2;
    const size_t tA = 2 * hA, tB = 2 * hB;
    const unsigned ldsw = (unsigned)wid * 1024u;
    const int aoff = lds_byte(wr * 64 + fr, fq * 8), boff = lds_byte(wc * 32 + fr, fq * 8);
#define PG8_SA(b, h) (((b) * 2 + (h)) * HTB)
#define PG8_SB(b, h) ((4 + (b) * 2 + (h)) * HTB)
#define PG8_STAGE(bufoff, gbase, voff) do { _Pragma("unroll") for (int _i = 0; _i < 2; ++_i) \
        __builtin_amdgcn_global_load_lds((const unsigned*)((const char*)(gbase) + (voff)[_i]), (LAS unsigned*)(lds + (bufoff) + ldsw + _i * 8192), 16, 0, 0); } while (0)
#define PG8_LDA(dst, b, h) do { _Pragma("unroll") for (int m = 0; m < 4; ++m) _Pragma("unroll") for (int k = 0; k < 2; ++k) dst[m][k] = *(const LAS bf16x8*)(lds + PG8_SA(b, h) + aoff + m * 2048 + k * 1024); } while (0)
#define PG8_LDB(dst, b, h) do { _Pragma("unroll") for (int n = 0; n < 2; ++n) _Pragma("unroll") for (int k = 0; k < 2; ++k) dst[n][k] = *(const LAS bf16x8*)(lds + PG8_SB(b, h) + boff + n * 2048 + k * 1024); } while (0)
#define PG8_MMA(ai, bj, At, Bt) do { __builtin_amdgcn_s_setprio(1); _Pragma("unroll") for (int m = 0; m < 4; ++m) _Pragma("unroll") for (int n = 0; n < 2; ++n) _Pragma("unroll") for (int k = 0; k < 2; ++k) \
        acc[ai][bj][m][n] = __builtin_amdgcn_mfma_f32_16x16x32_bf16(Bt[n][k], At[m][k], acc[ai][bj][m][n], 0, 0, 0); __builtin_amdgcn_s_setprio(0); } while (0)
#define PG8_WAIT_V(n) asm volatile("s_waitcnt vmcnt(" #n ")" ::: "memory")
#define PG8_WAIT_L(n) asm volatile("s_waitcnt lgkmcnt(" #n ")" ::: "memory")
#define PG8_BAR __builtin_amdgcn_s_barrier()
#define PG8_SCHED __builtin_amdgcn_sched_barrier(0)
#define PG8_ABASE(u) ((const char*)g.A + (size_t)(u).pm * tA + (g.a_shift >= 0 ? (size_t)(((u).pn & g.a_shift) * 512) : (size_t)0))
#define PG8_BBASE(u) ((const char*)g.Bt + (size_t)(u).pn * tB + (g.a_shift >= 0 ? (size_t)(((u).pn & g.a_shift) * 512) : (size_t)0))
    Unit cur, nxt; int ui = 0;
    if (!S.next(0, cur)) return;
    f32x4 acc[2][2][4][2];
#pragma unroll
    for (int a = 0; a < 2; ++a)
#pragma unroll
        for (int b = 0; b < 2; ++b)
#pragma unroll
            for (int m = 0; m < 4; ++m)
#pragma unroll
                for (int n = 0; n < 2; ++n) acc[a][b][m][n] = (f32x4){0.f, 0.f, 0.f, 0.f};
    bf16x8 At[4][2], B0[2][2], B1[2][2];
    float rsv[2][4];
#pragma unroll
    for (int a = 0; a < 2; ++a)
#pragma unroll
        for (int m = 0; m < 4; ++m) rsv[a][m] = 1.0f;
    const char* cA = PG8_ABASE(cur); const char* cB = PG8_BBASE(cur);
    if (Epi::HAS_PRE) { f32x4 part[2][4]; E.pre_load(cur, wr, fr, fq, part);
        PG8_STAGE(PG8_SB(0, 0), cB, voffB); PG8_STAGE(PG8_SB(0, 1), cB + hB, voffB); PG8_STAGE(PG8_SA(0, 0), cA, voffA); PG8_STAGE(PG8_SA(0, 1), cA + hA, voffA);
        if (wr == 1) PG8_BAR;
        PG8_WAIT_V(2); PG8_BAR;
        E.pre_reduce(part, rsv);
    } else {
    PG8_STAGE(PG8_SB(0, 0), cB, voffB); PG8_STAGE(PG8_SB(0, 1), cB + hB, voffB); PG8_STAGE(PG8_SA(0, 0), cA, voffA); PG8_STAGE(PG8_SA(0, 1), cA + hA, voffA);
    if (wr == 1) PG8_BAR;
    PG8_WAIT_V(2); PG8_BAR; }
    PG8_STAGE(PG8_SB(1, 0), cB + kstep, voffB); PG8_STAGE(PG8_SA(1, 0), cA + kstep, voffA); PG8_STAGE(PG8_SB(1, 1), cB + hB + kstep, voffB);
    PG8_WAIT_V(6); PG8_BAR;
    for (;;) {
        const bool has_next = S.next(ui + 1, nxt);
        const char* nA = has_next ? PG8_ABASE(nxt) : cA; const char* nB = has_next ? PG8_BBASE(nxt) : cB;
        for (int t = 0; t < nt; t += 2) {
            const bool last = (t == nt - 2);
            const char* a1 = cA + (size_t)(t + 1) * kstep;
            const char* a2 = last ? nA : cA + (size_t)(t + 2) * kstep; const char* b2 = last ? nB : cB + (size_t)(t + 2) * kstep;
            const char* a3 = a2 + kstep; const char* b3 = b2 + kstep;
            PG8_LDB(B0, 0, 0); PG8_LDB(B1, 0, 1); PG8_SCHED; PG8_LDA(At, 0, 0); PG8_STAGE(PG8_SA(1, 1), a1 + hA, voffA);
            PG8_WAIT_V(8); PG8_WAIT_L(0); PG8_BAR; PG8_MMA(0, 0, At, B0); PG8_MMA(0, 1, At, B1); PG8_BAR; PG8_SCHED;
            PG8_LDA(At, 0, 1); PG8_STAGE(PG8_SB(0, 0), b2, voffB); PG8_STAGE(PG8_SB(0, 1), b2 + hB, voffB); PG8_STAGE(PG8_SA(0, 0), a2, voffA);
            PG8_WAIT_V(8); PG8_WAIT_L(0); PG8_BAR; PG8_MMA(1, 0, At, B0); PG8_MMA(1, 1, At, B1); PG8_BAR; PG8_SCHED;
            PG8_LDB(B0, 1, 0); PG8_LDB(B1, 1, 1); PG8_SCHED; PG8_LDA(At, 1, 0); PG8_STAGE(PG8_SA(0, 1), a2 + hA, voffA);
            PG8_WAIT_V(8); PG8_WAIT_L(0); PG8_BAR; PG8_MMA(0, 0, At, B0); PG8_MMA(0, 1, At, B1); PG8_BAR; PG8_SCHED;
            PG8_LDA(At, 1, 1); PG8_STAGE(PG8_SB(1, 0), b3, voffB); PG8_STAGE(PG8_SB(1, 1), b3 + hB, voffB); PG8_STAGE(PG8_SA(1, 0), a3, voffA);
            PG8_WAIT_V(8); PG8_WAIT_L(0); PG8_BAR; PG8_MMA(1, 0, At, B0); PG8_MMA(1, 1, At, B1); PG8_BAR; PG8_SCHED;
        }
        if (wr == 0) PG8_BAR;
        E(acc, cur, wr, wc, fr, fq, rsv);
        if (!has_next) break;
#pragma unroll
        for (int a = 0; a < 2; ++a)
#pragma unroll
            for (int b = 0; b < 2; ++b)
#pragma unroll
                for (int m = 0; m < 4; ++m)
#pragma unroll
                    for (int n = 0; n < 2; ++n) acc[a][b][m][n] = (f32x4){0.f, 0.f, 0.f, 0.f};
        cur = nxt; cA = nA; cB = nB; ++ui;
        if (Epi::HAS_PRE) { f32x4 part[2][4]; E.pre_load(cur, wr, fr, fq, part); E.pre_reduce(part, rsv); }
        if (wr == 1) PG8_BAR;
    }
    PG8_WAIT_V(0);
    PG8_BAR;
#undef PG8_SA
#undef PG8_SB
#undef PG8_STAGE
#undef PG8_LDA
#undef PG8_LDB
#undef PG8_MMA
#undef PG8_WAIT_V
#undef PG8_WAIT_L
#undef PG8_BAR
#undef PG8_SCHED
#undef PG8_ABASE
#undef PG8_BBASE
}

__device__ __forceinline__ float row_rs(const float* ssq, int row) {
    const f32x4* p = (const f32x4*)(ssq + (size_t)row * 16); const f32x4 a = p[0], b = p[1], c = p[2], d = p[3];
    const float s = ((a.x + a.y) + (a.z + a.w)) + ((b.x + b.y) + (b.z + b.w)) + ((c.x + c.y) + (c.z + c.w)) + ((d.x + d.y) + (d.z + d.w));
    return rsqrtf(s * (1.0f / 1024.0f) + EPS);
}
__device__ __forceinline__ float gelu_tanh(float v) {
    const float u = 1.5957691216f * (v + 0.044715f * v * v * v);
    return v * __builtin_amdgcn_rcpf(1.0f + __builtin_amdgcn_exp2f(-1.44269504089f * u));
}
__device__ __forceinline__ float sigmoidf_(float z) { return __builtin_amdgcn_rcpf(1.0f + __builtin_amdgcn_exp2f(-1.44269504089f * z)); }

template <int MODE> struct EpiScale {
    static constexpr bool PERM = true;
    static constexpr bool HAS_PRE = (MODE != 2);
    bf16_t* O; int ldc; const float* ssq;
    __device__ __forceinline__ void pre_load(const Unit& u, int wr, int fr, int fq, f32x4 (&part)[2][4]) const {
        const int row0 = u.pm * BM + wr * 64 + fr;
#pragma unroll
        for (int ai = 0; ai < 2; ++ai)
#pragma unroll
            for (int m = 0; m < 4; ++m) part[ai][m] = *(const f32x4*)(ssq + (size_t)(row0 + ai * HALF + m * 16) * 16 + 4 * fq);
    }
    __device__ __forceinline__ void pre_reduce(const f32x4 (&part)[2][4], float (&rsv)[2][4]) const {
#pragma unroll
        for (int ai = 0; ai < 2; ++ai)
#pragma unroll
            for (int m = 0; m < 4; ++m) { float t = (part[ai][m].x + part[ai][m].y) + (part[ai][m].z + part[ai][m].w); t += __shfl_xor(t, 16); t += __shfl_xor(t, 32); rsv[ai][m] = rsqrtf(t * (1.0f / 1024.0f) + EPS); }
    }
    __device__ __forceinline__ void operator()(const f32x4 (&acc)[2][2][4][2], const Unit& u, int wr, int wc, int fr, int fq, const float (&rsv)[2][4]) const {
        const int row0 = u.pm * BM + wr * 64 + fr, col0 = u.pn * BM + wc * 32 + 8 * fq;
        const bool act = (MODE == 1) && (u.pn < 4);
#pragma unroll
        for (int ai = 0; ai < 2; ++ai)
#pragma unroll
            for (int m = 0; m < 4; ++m) { const int row = row0 + ai * HALF + m * 16; const float rs = rsv[ai][m]; bf16_t* rowp = O + (size_t)row * ldc + col0;
#pragma unroll
                for (int bj = 0; bj < 2; ++bj) { f32x4 v0 = acc[ai][bj][m][0], v1 = acc[ai][bj][m][1];
                    if (MODE != 2) { v0 = v0 * rs; v1 = v1 * rs; }
                    if (MODE == 1) { if (act) {
#pragma unroll
                        for (int e = 0; e < 4; ++e) { v0[e] = gelu_tanh(v0[e]); v1[e] = gelu_tanh(v1[e]); } } }
                    if (MODE == 2) {
#pragma unroll
                        for (int e = 0; e < 4; ++e) { const float a = fmaxf(v0[e], 0.f), b = fmaxf(v1[e], 0.f); v0[e] = a * a; v1[e] = b * b; } }
                    u32x4 w; w.x = cvt_pk_bf16(v0[0], v0[1]); w.y = cvt_pk_bf16(v0[2], v0[3]); w.z = cvt_pk_bf16(v1[0], v1[1]); w.w = cvt_pk_bf16(v1[2], v1[3]);
                    store16_wt(rowp + bj * HALF, w); } }
    }
};
struct EpiGate {
    static constexpr bool PERM = true;
    static constexpr bool HAS_PRE = false;
    bf16_t* R; bf16_t* I; const float* ba; const float* bx;
    __device__ __forceinline__ void pre_load(const Unit&, int, int, int, f32x4 (&)[2][4]) const {}
    __device__ __forceinline__ void pre_reduce(const f32x4 (&)[2][4], float (&)[2][4]) const {}
    __device__ __forceinline__ void operator()(const f32x4 (&acc)[2][2][4][2], const Unit& u, int wr, int wc, int fr, int fq, const float (&)[2][4]) const {
        const int which = u.pn >> 2, blk = u.pn & 3;
        bf16_t* O = which ? I : R; const float* bias = which ? bx : ba;
        const int row0 = u.pm * BM + wr * 64 + fr, col0 = blk * BM + wc * 32 + 8 * fq;
#pragma unroll
        for (int bj = 0; bj < 2; ++bj) {
            const f32x4 bv0 = *(const f32x4*)(bias + col0 + bj * HALF), bv1 = *(const f32x4*)(bias + col0 + bj * HALF + 4);
#pragma unroll
            for (int ai = 0; ai < 2; ++ai)
#pragma unroll
                for (int m = 0; m < 4; ++m) { bf16_t* rowp = O + (size_t)(row0 + ai * HALF + m * 16) * D + col0;
                    f32x4 v0 = acc[ai][bj][m][0] + bv0, v1 = acc[ai][bj][m][1] + bv1;
#pragma unroll
                    for (int e = 0; e < 4; ++e) { v0[e] = sigmoidf_(v0[e]); v1[e] = sigmoidf_(v1[e]); }
                    u32x4 w; w.x = cvt_pk_bf16(v0[0], v0[1]); w.y = cvt_pk_bf16(v0[2], v0[3]); w.z = cvt_pk_bf16(v1[0], v1[1]); w.w = cvt_pk_bf16(v1[2], v1[3]);
                    store16_wt(rowp + bj * HALF, w); }
        }
    }
};
template <bool SCALE> struct EpiRes {
    static constexpr bool PERM = true;
    static constexpr bool HAS_PRE = false;
    bf16_t* xb; float* ssq; const float* ssq_in;
    __device__ __forceinline__ void pre_load(const Unit&, int, int, int, f32x4 (&)[2][4]) const {}
    __device__ __forceinline__ void pre_reduce(const f32x4 (&)[2][4], float (&)[2][4]) const {}
    __device__ __forceinline__ void operator()(const f32x4 (&acc)[2][2][4][2], const Unit& u, int wr, int wc, int fr, int fq, const float (&)[2][4]) const {
        const int col0 = u.pn * BM + wc * 32 + 8 * fq;
        u32x4 o[2][4][2];
#define EPIRES_LOAD(ai) do { _Pragma("unroll") for (int m = 0; m < 4; ++m) { const size_t off_ = (size_t)(u.pm * BM + (ai) * HALF + wr * 64 + m * 16 + fr) * D + col0; \
            _Pragma("unroll") for (int bj = 0; bj < 2; ++bj) o[ai][m][bj] = *(const u32x4*)(xb + off_ + bj * HALF); } } while (0)
        if (!SCALE) { EPIRES_LOAD(0); EPIRES_LOAD(1); }
#pragma unroll
        for (int ai = 0; ai < 2; ++ai) {
            f32x4 part_[4];
            if (SCALE) {
#pragma unroll
                for (int m = 0; m < 4; ++m) part_[m] = *(const f32x4*)(ssq_in + (size_t)(u.pm * BM + ai * HALF + wr * 64 + m * 16 + fr) * 16 + 4 * fq);
                if (ai == 0) EPIRES_LOAD(0); else EPIRES_LOAD(1); }
#pragma unroll
            for (int m = 0; m < 4; ++m) { const int row = u.pm * BM + ai * HALF + wr * 64 + m * 16 + fr; const size_t off = (size_t)row * D + col0; float part = 0.f;
                float rs2 = 1.0f;
                if (SCALE) { float t = (part_[m].x + part_[m].y) + (part_[m].z + part_[m].w); t += __shfl_xor(t, 16); t += __shfl_xor(t, 32); rs2 = __builtin_amdgcn_rcpf(t * (1.0f / 1024.0f) + EPS); }
#pragma unroll
                for (int bj = 0; bj < 2; ++bj) { const u32x4 xo = o[ai][m][bj]; f32x4 a0 = acc[ai][bj][m][0], a1 = acc[ai][bj][m][1];
                    if (SCALE) { a0 = a0 * rs2; a1 = a1 * rs2; }
                    const float v0 = bflo(xo.x) + a0[0], v1 = bfhi(xo.x) + a0[1], v2 = bflo(xo.y) + a0[2], v3 = bfhi(xo.y) + a0[3];
                    const float v4 = bflo(xo.z) + a1[0], v5 = bfhi(xo.z) + a1[1], v6 = bflo(xo.w) + a1[2], v7 = bfhi(xo.w) + a1[3];
                    u32x4 w; w.x = cvt_pk_bf16(v0, v1); w.y = cvt_pk_bf16(v2, v3); w.z = cvt_pk_bf16(v4, v5); w.w = cvt_pk_bf16(v6, v7); store16_wt(xb + off + bj * HALF, w);
                    part += ((v0 * v0 + v1 * v1) + (v2 * v2 + v3 * v3)) + ((v4 * v4 + v5 * v5) + (v6 * v6 + v7 * v7)); }
                part += __shfl_xor(part, 16); part += __shfl_xor(part, 32);
                if (fq == 0) ssq[(size_t)row * 16 + u.pn * 4 + wc] = part; }
            asm volatile("" ::: "memory");
        }
#undef EPIRES_LOAD
    }
};
}

struct Args { const float* in[21]; float* out; unsigned char* ws; int ph_lo, ph_hi; };
static_assert(sizeof(Args) == 21 * 8 + 8 + 8 + 8, "Args has no padding");

struct Frame {
    LAS unsigned char* lds;
    int tid, lane, wave, G, vcu, bid;
};
__device__ __forceinline__ Frame launder(const Frame& F0) {
    Frame F = F0; int t = F0.tid, w = F0.wave, g = F0.G, v = F0.vcu, b = F0.bid;
    asm volatile("" : "+v"(t)); asm volatile("" : "+s"(w)); asm volatile("" : "+s"(g)); asm volatile("" : "+s"(v)); asm volatile("" : "+s"(b));
    F.tid = t; F.lane = t & 63; F.wave = w; F.G = g; F.vcu = v; F.bid = b; return F;
}

__device__ __forceinline__ void cvt_item(const float* W, int ldw, const float* gamma, float scale, bf16_t* Bt, int ldb, int nblk, int nvalid, LAS float* scr, int item, int lane) {
    const int kb = item / nblk, nb = item % nblk, k0 = 64 * kb, n0 = 32 * nb;
    const int nn = lane & 31; const bool ok = (n0 + nn) < nvalid;
    if (n0 + 32 <= nvalid && ((((size_t)W) | ((size_t)ldw * 4u)) & 15u) == 0) {
        const int c4 = (lane & 7) * 4, r8 = lane >> 3; f32x4 v[8];
#pragma unroll
        for (int i = 0; i < 8; ++i) v[i] = __builtin_nontemporal_load((const f32x4*)(W + (size_t)(k0 + 8 * i + r8) * ldw + n0 + c4));
#pragma unroll
        for (int i = 0; i < 8; ++i) { const int kk = 8 * i + r8; const float gs = (gamma ? gamma[k0 + kk] : 1.0f) * scale; LAS float* d = scr + kk * 33 + c4;
            d[0] = v[i].x * gs; d[1] = v[i].y * gs; d[2] = v[i].z * gs; d[3] = v[i].w * gs; }
    } else
#pragma unroll 8
    for (int i = 0; i < 32; ++i) { const int kk = 2 * i + (lane >> 5); float v = ok ? __builtin_nontemporal_load(W + (size_t)(k0 + kk) * ldw + n0 + nn) : 0.f;     v *= (gamma ? gamma[k0 + kk] : 1.0f) * scale; scr[kk * 33 + nn] = v; }
    LDS_WAIT(); asm volatile("" ::: "memory");
    const int c = lane & 7;
#pragma unroll
    for (int j = 0; j < 4; ++j) { const int n = (lane >> 3) + 8 * j; const LAS float* s = scr + (8 * c) * 33 + n;
        u32x4 o; o.x = cvt_pk_bf16(s[0 * 33], s[1 * 33]); o.y = cvt_pk_bf16(s[2 * 33], s[3 * 33]); o.z = cvt_pk_bf16(s[4 * 33], s[5 * 33]); o.w = cvt_pk_bf16(s[6 * 33], s[7 * 33]);
        store16_wt(Bt + (size_t)(n0 + n) * ldb + k0 + 8 * c, o); }
    LDS_WAIT(); asm volatile("" ::: "memory");
}
__device__ __forceinline__ bf16x8 pack8(const f32x4 a, const f32x4 b) { const u32x4 w = {cvt_pk_bf16(a.x, a.y), cvt_pk_bf16(a.z, a.w), cvt_pk_bf16(b.x, b.y), cvt_pk_bf16(b.z, b.w)}; return __builtin_bit_cast(bf16x8, w); }
__device__ __forceinline__ void qlat_item(const float* Win, const float* wuk, const float* gamma, float scale, bf16_t* Bt, int item, int chalf, int lane) {
    const int h = item >> 4, k0 = (item & 15) << 6, cb = 64 * chalf, fr = lane & 15, fq = lane >> 4;
    bf16x8 X[4][2], Y[4][2];
    { f32x4 xa[4][2], xb[4][2]; float gs[4];
#pragma unroll
      for (int kt = 0; kt < 4; ++kt) { const int k = k0 + 16 * kt + fr; gs[kt] = gamma[k] * scale; const f32x4* p = (const f32x4*)(Win + (size_t)k * ATT_IN + h * 64 + 8 * fq);
#pragma unroll
          for (int s_ = 0; s_ < 2; ++s_) { xa[kt][s_] = p[8 * s_]; xb[kt][s_] = p[8 * s_ + 1]; } }
#pragma unroll
      for (int kt = 0; kt < 4; ++kt)
#pragma unroll
          for (int s_ = 0; s_ < 2; ++s_) X[kt][s_] = pack8(xa[kt][s_] * gs[kt], xb[kt][s_] * gs[kt]); }
#pragma unroll
    for (int ct = 0; ct < 4; ++ct)
#pragma unroll
        for (int s_ = 0; s_ < 2; ++s_) { const float* p = wuk + (size_t)h * 64 * 128 + (size_t)(32 * s_ + 8 * fq) * 128 + cb + 16 * ct + fr;
            const f32x4 ya = {p[0], p[128], p[256], p[384]}, yb = {p[512], p[640], p[768], p[896]}; Y[ct][s_] = pack8(ya, yb); }
#pragma unroll
    for (int ct = 0; ct < 4; ++ct)
#pragma unroll
        for (int kt = 0; kt < 4; ++kt) { f32x4 acc = {0.f, 0.f, 0.f, 0.f};
#pragma unroll
            for (int s_ = 0; s_ < 2; ++s_) acc = __builtin_amdgcn_mfma_f32_16x16x32_bf16(X[kt][s_], Y[ct][s_], acc, 0, 0, 0);
            u32x2 o; o.x = cvt_pk_bf16(acc[0], acc[1]); o.y = cvt_pk_bf16(acc[2], acc[3]);
            *(u32x2*)(Bt + (size_t)(h * 128 + cb + 16 * ct + fr) * D + k0 + 16 * kt + 4 * fq) = o; }
}
__device__ __forceinline__ void comb_item(const float* wuv, const float* wo, bf16_t* Bt, int item, int chalf, int lane) {
    const int h = item >> 4, n0 = (item & 15) << 6, cb = 64 * chalf, fr = lane & 15, fq = lane >> 4;
    bf16x8 X[4][2], Y[4][2];
#pragma unroll
    for (int ct = 0; ct < 4; ++ct) { const f32x4* p = (const f32x4*)(wuv + (size_t)h * 128 * 64 + (size_t)(cb + 16 * ct + fr) * 64 + 8 * fq);
#pragma unroll
        for (int s_ = 0; s_ < 2; ++s_) X[ct][s_] = pack8(p[8 * s_], p[8 * s_ + 1]); }
#pragma unroll
    for (int nt = 0; nt < 4; ++nt)
#pragma unroll
        for (int s_ = 0; s_ < 2; ++s_) { const float* p = wo + (size_t)(h * 64 + 32 * s_ + 8 * fq) * D + n0 + 16 * nt + fr;
            const f32x4 ya = {p[0], p[D], p[2 * D], p[3 * D]}, yb = {p[4 * D], p[5 * D], p[6 * D], p[7 * D]}; Y[nt][s_] = pack8(ya, yb); }
#pragma unroll
    for (int nt = 0; nt < 4; ++nt)
#pragma unroll
        for (int ct = 0; ct < 4; ++ct) { f32x4 acc = {0.f, 0.f, 0.f, 0.f};
#pragma unroll
            for (int s_ = 0; s_ < 2; ++s_) acc = __builtin_amdgcn_mfma_f32_16x16x32_bf16(X[ct][s_], Y[nt][s_], acc, 0, 0, 0);
            u32x2 o; o.x = cvt_pk_bf16(acc[0], acc[1]); o.y = cvt_pk_bf16(acc[2], acc[3]);
            *(u32x2*)(Bt + (size_t)(n0 + 16 * nt + fr) * 2048 + h * 128 + cb + 16 * ct + 4 * fq) = o; }
}

struct Ptrs {
    const float* in[21]; float* out; unsigned char* ws;
};
__device__ __forceinline__ unsigned long long argq(int k) {
    asm volatile("" : "+s"(k));
    return ((const __attribute__((address_space(4))) unsigned long long*)__builtin_amdgcn_kernarg_segment_ptr())[k];
}
__device__ __forceinline__ Ptrs load_ptrs() {
    Ptrs P;
#pragma unroll
    for (int i = 0; i < 21; ++i) P.in[i] = (const float*)(GAS const float*)argq(i);
    P.out = (float*)(GAS float*)argq(21); P.ws = (unsigned char*)(GAS unsigned char*)argq(22);
    return P;
}

__device__ __forceinline__ void cvt_rec_mix(const Frame& F, const Ptrs& P, int j, int L) {
    LAS float* scr = (LAS float*)(F.lds + F.wave * 16384);
    bf16_t* WM = (bf16_t*)(P.ws + WS_WMIX);
    const int gw = F.vcu * NWAVES + F.wave, NGW = F.G * NWAVES;
    constexpr int I_IN = 16 * 64, I_G = 4 * 8, I_OUT = 16 * 32, I_Z = 8 * 3 * 8;
    constexpr int NITEMS = I_IN + 8 * I_G + I_OUT + I_Z;
    for (int it = gw; it < NITEMS; it += NGW) {
        int r = it;
        if (r < I_IN) { cvt_item(P.in[4] + (size_t)j * D * 2048, 2048, P.in[1] + L * D, 1.f, WM, D, 64, 2048, scr, r, F.lane); continue; } r -= I_IN;
        if (r < 8 * I_G) { const int blk = r / (2 * I_G), which = (r / I_G) & 1, ri = r % I_G;
            cvt_item(P.in[which ? 9 : 7] + (size_t)(j * 4 + blk) * 65536, 256, nullptr, 1.f, WM + WM_REC_GATE + (size_t)(which * 1024 + blk * 256) * D + blk * 256, D, 8, 256, scr, ri, F.lane); continue; } r -= 8 * I_G;
        if (r < I_OUT) { cvt_item(P.in[12] + (size_t)j * D * D, D, nullptr, 1.f, WM + WM_REC_OUT, D, 32, D, scr, r, F.lane); continue; } r -= I_OUT;
        {
            const int rb = r / 24, cbi = (r / 8) % 3, piece = r & 7, blk = rb & 3, cb = cbi + (cbi >= blk ? 1 : 0);
            bf16_t* z = WM + WM_REC_GATE + (size_t)(rb * 256 + piece * 32) * D + cb * 256;
#pragma unroll
            for (int q = 0; q < 16; ++q) { const int e = q * 64 + F.lane, rr = e >> 5, cc = (e & 31) * 8; *(u32x4*)(z + (size_t)rr * D + cc) = (u32x4){0u, 0u, 0u, 0u}; }
        }
    }
}
__device__ __forceinline__ void cvt_att_mix(const Frame& F, const Ptrs& P, int j, int L, int rot = 0) {
    LAS float* scr = (LAS float*)(F.lds + F.wave * 16384);
    bf16_t* WM = (bf16_t*)(P.ws + WS_WATT + (size_t)j * 10 * MiB);
    const int NGW = F.G * NWAVES, gw = (F.vcu * NWAVES + F.wave + NGW - rot) % NGW;
    const float* Win = P.in[13] + (size_t)j * D * ATT_IN; const float* gam = P.in[1] + L * D;
    constexpr int I_H = 512, I_C = 16 * 22, I_W = 16 * 2;
    constexpr int NITEMS = 2 * I_H + I_C + I_W;
    for (int it = gw; it < NITEMS; it += NGW) {
        int r = it;
        if (r < I_H) { qlat_item(Win, P.in[15] + (size_t)j * 16 * 64 * 128, gam, 0.125f, WM, r >> 1, r & 1, F.lane); continue; } r -= I_H;
        if (r < I_H) { comb_item(P.in[16] + (size_t)j * 16 * 128 * 64, P.in[17] + (size_t)j * D * D, WM + WM_ATT_COMB, r >> 1, r & 1, F.lane); continue; } r -= I_H;
        if (r < I_C) { cvt_item(Win + 1024, ATT_IN, gam, 1.f, WM + (size_t)2048 * D, D, 22, 704, scr, r, F.lane); continue; } r -= I_C;
        cvt_item(Win + 1728, ATT_IN, gam, 0.044194173824159216f, WM + (size_t)2752 * D, D, 2, 8, scr, r, F.lane);
    }
}
__device__ __forceinline__ void cvt_up(const Frame& F, const Ptrs& P, int L) {
    LAS float* scr = (LAS float*)(F.lds + F.wave * 16384);
    const int gw = F.vcu * NWAVES + F.wave, NGW = F.G * NWAVES;
    for (int it = gw; it < 16 * 128; it += NGW) cvt_item(P.in[19] + (size_t)L * D * FF, FF, P.in[2] + L * D, 1.f, (bf16_t*)(P.ws + WS_WUP), D, 128, FF, scr, it, F.lane);
}
__device__ __forceinline__ void cvt_down(const Frame& F, const Ptrs& P, int L) {
    LAS float* scr = (LAS float*)(F.lds + F.wave * 16384);
    const int gw = F.vcu * NWAVES + F.wave, NGW = F.G * NWAVES;
    for (int it = gw; it < 64 * 32; it += NGW) cvt_item(P.in[20] + (size_t)L * FF * D, D, nullptr, 1.f, (bf16_t*)(P.ws + WS_WDOWN), FF, 32, D, scr, it, F.lane);
}

__device__ __forceinline__ void p0_rows(const Frame& F, const Ptrs& P) {
    const int gw = F.vcu * NWAVES + F.wave, NGW = F.G * NWAVES;
    bf16_t* XB = (bf16_t*)(P.ws + WS_XB); float* SSQ = (float*)(P.ws + WS_SSQ);
    for (int m = gw; m < M; m += NGW) {
        const f32x4* xr = (const f32x4*)(P.in[0] + (size_t)m * D) + F.lane; float s = 0.f; f32x4 v[4];
#pragma unroll
        for (int jj = 0; jj < 4; ++jj) { v[jj] = __builtin_nontemporal_load(xr + 64 * jj); s += (v[jj].x * v[jj].x + v[jj].y * v[jj].y) + (v[jj].z * v[jj].z + v[jj].w * v[jj].w); }
        s = wave_sum(s);
        u32x2* o = (u32x2*)(XB + (size_t)m * D) + F.lane;
#pragma unroll
        for (int jj = 0; jj < 4; ++jj) { u32x2 w; w.x = cvt_pk_bf16(v[jj].x, v[jj].y); w.y = cvt_pk_bf16(v[jj].z, v[jj].w); o[64 * jj] = w; }
        if (F.lane < 16) SSQ[(size_t)m * 16 + F.lane] = (F.lane == 0) ? s : 0.f;
    }
}
__device__ __forceinline__ void final_norm(const Frame& F, const Ptrs& P, bool dry = false) {
    const int gw = F.vcu * NWAVES + F.wave, NGW = F.G * NWAVES;
    const float* SSQ = (const float*)(P.ws + WS_SSQ); const f32x4* g = (const f32x4*)P.in[3] + F.lane; const bf16_t* XB = (const bf16_t*)(P.ws + WS_XB);
    for (int m = gw; m < M; m += NGW) {
        f32x4* xr = (f32x4*)(P.out + (size_t)m * D) + F.lane; const u32x2* xi = (const u32x2*)(XB + (size_t)m * D) + F.lane; const float rs = pg8::row_rs(SSQ, m);
#pragma unroll
        for (int jj = 0; jj < 4; ++jj) { const u32x2 xv = xi[64 * jj]; const f32x4 v = {bflo(xv.x), bfhi(xv.x), bflo(xv.y), bfhi(xv.y)}; const f32x4 gg = g[64 * jj]; const f32x4 w = v * rs * gg; __builtin_nontemporal_store(dry ? v : w, xr + 64 * jj); }
    }
}
__device__ __forceinline__ void conv_tile(const Frame& F, const Ptrs& P, int j, int pm, int blk) {
    const bf16_t* GX = (const bf16_t*)(P.ws + WS_GX); bf16_t* XC = (bf16_t*)(P.ws + WS_XC);
    const int cp = F.tid & 127, rq = F.tid >> 7, ch = blk * 256 + 2 * cp, r0 = pm * 256 + rq * 64;
    const float* cw = P.in[5] + (size_t)j * 4 * D + ch; const float* cb = P.in[6] + (size_t)j * D + ch;
    const f32x2 w0 = *(const f32x2*)(cw), w1 = *(const f32x2*)(cw + D), w2 = *(const f32x2*)(cw + 2 * D), w3 = *(const f32x2*)(cw + 3 * D), bb = *(const f32x2*)cb;
    const unsigned* xr = (const unsigned*)(GX + (size_t)r0 * 2048 + 1024 + ch);
    unsigned x0 = 0u, x1 = 0u, x2 = 0u;
    if ((r0 & (SEQ - 1)) != 0) { x0 = xr[-3 * 1024]; x1 = xr[-2 * 1024]; x2 = xr[-1 * 1024]; }
    unsigned* xo = (unsigned*)(XC + (size_t)r0 * D + ch);
    for (int tb = 0; tb < 64; tb += 16) {
        unsigned xin[16];
#pragma unroll
        for (int q = 0; q < 16; ++q) xin[q] = xr[(size_t)(tb + q) * 1024];
#pragma unroll
        for (int q = 0; q < 16; ++q) {
            const unsigned x3 = xin[q];
            const float a = bb.x + w0.x * bflo(x0) + w1.x * bflo(x1) + w2.x * bflo(x2) + w3.x * bflo(x3);
            const float b = bb.y + w0.y * bfhi(x0) + w1.y * bfhi(x1) + w2.y * bfhi(x2) + w3.y * bfhi(x3);
            xo[(size_t)(tb + q) * 512] = cvt_pk_bf16(a, b);
            x0 = x1; x1 = x2; x2 = x3;
        }
    }
}

__device__ __forceinline__ void scan_phase(const Frame& F, const Ptrs& P, int j, bool dry = false) {
    LAS float* sA = (LAS float*)F.lds; LAS float* sH = sA + 32 * 32; LAS unsigned* sU = (LAS unsigned*)(F.lds + 16384);
    bf16_t* GX = (bf16_t*)(P.ws + WS_GX); const bf16_t* XC = (const bf16_t*)(P.ws + WS_XC);
    const bf16_t* RB = (const bf16_t*)(P.ws + WS_RB); const bf16_t* IB = (const bf16_t*)(P.ws + WS_IB);
    const int c2 = F.tid & 15, chunk = F.tid >> 4;
    for (int u = F.vcu; u < BATCH * 32; u += F.G) {
        const int b = u >> 5, cg = u & 31, ch = cg * 32 + 2 * c2; const size_t row0 = (size_t)b * SEQ + chunk * 64;
        const f32x2 lam = *(const f32x2*)(P.in[11] + (size_t)j * D + ch);
        const float sp0 = -8.0f * log1pf(expf(-lam.x)), sp1 = -8.0f * log1pf(expf(-lam.y));
        const unsigned* rp = (const unsigned*)(RB + row0 * D + ch); const unsigned* ip = (const unsigned*)(IB + row0 * D + ch); const unsigned* xp = (const unsigned*)(XC + row0 * D + ch);
        float A0 = 1.f, A1 = 1.f, h0 = 0.f, h1 = 0.f;
        constexpr int SB = 16;
        unsigned rn[SB], in_[SB], xn[SB];
#pragma unroll
        for (int q = 0; q < SB; ++q) { rn[q] = rp[(size_t)q * 512]; in_[q] = ip[(size_t)q * 512]; xn[q] = xp[(size_t)q * 512]; }
        for (int tb = 0; tb < 64; tb += SB) {
            unsigned rr[SB], ii[SB], xx[SB];
#pragma unroll
            for (int q = 0; q < SB; ++q) { rr[q] = rn[q]; ii[q] = in_[q]; xx[q] = xn[q]; }
            if (tb + SB < 64) {
#pragma unroll
                for (int q = 0; q < SB; ++q) { rn[q] = rp[(size_t)(tb + SB + q) * 512]; in_[q] = ip[(size_t)(tb + SB + q) * 512]; xn[q] = xp[(size_t)(tb + SB + q) * 512]; } }
#pragma unroll
            for (int q = 0; q < SB; ++q) { const unsigned r = rr[q], i = ii[q], x = xx[q];
                const float a0 = __expf(sp0 * bflo(r)), a1 = __expf(sp1 * bfhi(r));
                const float u0 = sqrtf(fmaxf(fmaf(-a0, a0, 1.0f), 0.f)) * (bflo(i) * bflo(x)), u1 = sqrtf(fmaxf(fmaf(-a1, a1, 1.0f), 0.f)) * (bfhi(i) * bfhi(x));
                A0 *= a0; A1 *= a1; h0 = fmaf(a0, h0, u0); h1 = fmaf(a1, h1, u1);
                sU[(tb + q) * 512 + F.tid] = cvt_pk_bf16(u0, u1); }
        }
        unsigned* gp = (unsigned*)(GX + row0 * 2048 + ch);
        unsigned gn[SB];
#pragma unroll
        for (int q = 0; q < SB; ++q) { rn[q] = rp[(size_t)q * 512]; gn[q] = gp[(size_t)q * 1024]; }
        sA[chunk * 32 + 2 * c2] = A0; sA[chunk * 32 + 2 * c2 + 1] = A1; sH[chunk * 32 + 2 * c2] = h0; sH[chunk * 32 + 2 * c2 + 1] = h1;
        __syncthreads();
        h0 = 0.f; h1 = 0.f;
        for (int k = 0; k < chunk; ++k) { h0 = fmaf(sA[k * 32 + 2 * c2], h0, sH[k * 32 + 2 * c2]); h1 = fmaf(sA[k * 32 + 2 * c2 + 1], h1, sH[k * 32 + 2 * c2 + 1]); }
        for (int tb = 0; tb < 64; tb += SB) {
            unsigned rr[SB], gg[SB];
#pragma unroll
            for (int q = 0; q < SB; ++q) { rr[q] = rn[q]; gg[q] = gn[q]; }
            if (tb + SB < 64) {
#pragma unroll
                for (int q = 0; q < SB; ++q) { rn[q] = rp[(size_t)(tb + SB + q) * 512]; gn[q] = gp[(size_t)(tb + SB + q) * 1024]; } }
#pragma unroll
            for (int q = 0; q < SB; ++q) { const unsigned r = rr[q], gt = gg[q], uu = sU[(tb + q) * 512 + F.tid];
                const float a0 = __expf(sp0 * bflo(r)), a1 = __expf(sp1 * bfhi(r));
                const float u0 = bflo(uu), u1 = bfhi(uu);
                h0 = fmaf(a0, h0, u0); h1 = fmaf(a1, h1, u1);
                gp[(size_t)(tb + q) * 1024] = dry ? gt : cvt_pk_bf16(h0 * bflo(gt), h1 * bfhi(gt)); }
        }
        __syncthreads();
    }
}

__device__ __forceinline__ unsigned f2key(float f) { const unsigned u = __float_as_uint(f + 0.0f); return u ^ ((unsigned)((int)u >> 31) | 0x80000000u); }
__device__ __forceinline__ int wave_sum_dpp(int x) {
    x += __builtin_amdgcn_update_dpp(0, x, 0x111, 0xF, 0xF, false);
    x += __builtin_amdgcn_update_dpp(0, x, 0x112, 0xF, 0xF, false);
    x += __builtin_amdgcn_update_dpp(0, x, 0x114, 0xF, 0xF, false);
    x += __builtin_amdgcn_update_dpp(0, x, 0x118, 0xF, 0xF, false);
    x += __builtin_amdgcn_update_dpp(0, x, 0x142, 0xA, 0xF, false);
    x += __builtin_amdgcn_update_dpp(0, x, 0x143, 0xC, 0xF, false);
    return __builtin_amdgcn_readlane(x, 63);
}
__device__ __forceinline__ float wave_sum_f32_dpp(float v) {
#define WSF_STEP(ctrl, rmask) v += __int_as_float(__builtin_amdgcn_update_dpp(0, __float_as_int(v), ctrl, rmask, 0xF, false))
    WSF_STEP(0x111, 0xF); WSF_STEP(0x112, 0xF); WSF_STEP(0x114, 0xF); WSF_STEP(0x118, 0xF); WSF_STEP(0x142, 0xA); WSF_STEP(0x143, 0xC);
#undef WSF_STEP
    return __int_as_float(__builtin_amdgcn_readlane(__float_as_int(v), 63));
}
__device__ __forceinline__ int wave_scan_dpp(int x) {
    x += __builtin_amdgcn_update_dpp(0, x, 0x111, 0xF, 0xF, false);
    x += __builtin_amdgcn_update_dpp(0, x, 0x112, 0xF, 0xF, false);
    x += __builtin_amdgcn_update_dpp(0, x, 0x114, 0xF, 0xF, false);
    x += __builtin_amdgcn_update_dpp(0, x, 0x118, 0xF, 0xF, false);
    x += __builtin_amdgcn_update_dpp(0, x, 0x142, 0xA, 0xF, false);
    x += __builtin_amdgcn_update_dpp(0, x, 0x143, 0xC, 0xF, false);
    return x;
}
template <int NR>
__device__ __forceinline__ void idx_select(const LAS float* scq, int pos, int lane, const LAS unsigned char* bkL, unsigned short* out) {
    unsigned keys[NR];
#pragma unroll
    for (int jj = 0; jj < NR; ++jj) { const int idx = lane + 64 * jj; const float v = scq[idx]; keys[jj] = (idx <= pos) ? f2key(v) : 0u; }
    unsigned T = 0u; bool exact = false; int cl_last = 0;
    for (int bit = 31; bit >= 0; --bit) {
        const unsigned cand = (unsigned)__builtin_amdgcn_readfirstlane((int)(T | (1u << bit)));
        unsigned c0 = 0, c1 = 0, c2 = 0, c3 = 0;
#define IDX_CMP4(a_, b_, c_, d_) "v_cmp_ge_u32_e64 %4, %" #a_ ", %[cd]\n\tv_cmp_ge_u32_e64 %5, %" #b_ ", %[cd]\n\tv_cmp_ge_u32_e64 %6, %" #c_ ", %[cd]\n\tv_cmp_ge_u32_e64 %7, %" #d_ ", %[cd]\n\t" \
                                 "v_addc_co_u32_e64 %0, %4, 0, %0, %4\n\tv_addc_co_u32_e64 %1, %5, 0, %1, %5\n\tv_addc_co_u32_e64 %2, %6, 0, %2, %6\n\tv_addc_co_u32_e64 %3, %7, 0, %3, %7\n\t"
#pragma unroll
        for (int jj = 0; jj < NR; jj += 8) { unsigned long long m0, m1, m2, m3;
            asm volatile(IDX_CMP4(8, 9, 10, 11) IDX_CMP4(12, 13, 14, 15)
                         : "+v"(c0), "+v"(c1), "+v"(c2), "+v"(c3), "=&s"(m0), "=&s"(m1), "=&s"(m2), "=&s"(m3)
                         : "v"(keys[jj]), "v"(keys[jj + 1]), "v"(keys[jj + 2]), "v"(keys[jj + 3]), "v"(keys[jj + 4]), "v"(keys[jj + 5]), "v"(keys[jj + 6]), "v"(keys[jj + 7]), [cd] "s"(cand)); }
#undef IDX_CMP4
        cl_last = (int)((c0 + c1) + (c2 + c3));
        const int cnt = wave_sum_dpp(cl_last);
        if (cnt >= TOPK) T = cand;
        if (cnt == TOPK) { exact = true; break; }
    }
    if (exact) {
        int k = wave_scan_dpp(cl_last) - cl_last;
#pragma unroll
        for (int jj = 0; jj < NR; ++jj) {
            const bool sel = keys[jj] >= T;
            if (sel) { const int idx = lane + 64 * jj; const int dist = pos - idx; const unsigned bk = dist >= 128 ? 31u : (unsigned)bkL[dist]; out[k] = (unsigned short)(idx | (bk << 11)); }
            k += sel ? 1 : 0;
        }
        return;
    }
    int cgt = 0;
#pragma unroll
    for (int jj = 0; jj < NR; ++jj) cgt += __builtin_popcountll(__builtin_amdgcn_ballot_w64(keys[jj] > T));
    const int need = TOPK - cgt; int obase = 0, ebase = 0;
#pragma unroll
    for (int jj = 0; jj < NR; ++jj) {
        const bool gt = keys[jj] > T, eq = keys[jj] == T;
        const unsigned long long em = __builtin_amdgcn_ballot_w64(eq);
        const int erank = ebase + (int)__builtin_amdgcn_mbcnt_hi((unsigned)(em >> 32), __builtin_amdgcn_mbcnt_lo((unsigned)em, 0u));
        const bool sel = gt || (eq && erank < need);
        const unsigned long long sm = __builtin_amdgcn_ballot_w64(sel);
        const int opos = obase + (int)__builtin_amdgcn_mbcnt_hi((unsigned)(sm >> 32), __builtin_amdgcn_mbcnt_lo((unsigned)sm, 0u));
        if (sel) { const int idx = lane + 64 * jj; const int dist = pos - idx; const unsigned bk = dist >= 128 ? 31u : (unsigned)bkL[dist]; out[opos] = (unsigned short)(idx | (bk << 11)); }
        obase += __builtin_popcountll(sm); ebase += __builtin_popcountll(em);
    }
}
__device__ __forceinline__ void index_phase(const Frame& F, const Ptrs& P, int j) {
    LAS float* scb = (LAS float*)F.lds;
    LAS float* wiB = (LAS float*)(F.lds + 131072);
    LAS unsigned char* bkL = (LAS unsigned char*)(F.lds + 131072 + 4096);
    const bf16_t* QC = (const bf16_t*)(P.ws + WS_QC); bf16_t* CN = (bf16_t*)(P.ws + WS_CN); unsigned short* IDX = (unsigned short*)(P.ws + WS_IDX);
    const int lane = F.lane, w = F.wave, half = lane >> 5;
    if (F.tid < 128) { const int n = F.tid; int bk = n; if (n >= 16) { bk = 16 + (int)(logf((float)n / 16.0f) / 2.0794415416798357f * 16.0f); bk = bk > 31 ? 31 : bk; } bkL[n] = (unsigned char)bk; }
    __syncthreads();
    const int nunits = M / 8;
    const int ar = lane & 31, ahalf_r = (ar >> 2) & 1, areg_r = (ar & 3) + 4 * (ar >> 3), aq = 2 * ahalf_r + (areg_r >> 3), ah = areg_r & 7;
#define IDX_UNIT(i_) (((i_) * F.G < nunits) ? ((i_) * F.G + (((i_) & 1) ? (F.G - 1 - F.vcu) : F.vcu)) : -1)
#define IDX_OK(u_) ((u_) >= 0 && (u_) < nunits)
#define IDX_FETCH(u_, A_, cw_, wi_) do { const int T0_ = (u_) * 8; \
        cw_ = *(const unsigned*)(QC + ((size_t)T0_ + w) * NATT + QC_C + 2 * lane); \
        wi_ = QC[(size_t)(T0_ + (lane >> 3)) * NATT + QC_WI + (lane & 7)]; \
        _Pragma("unroll") for (int g = 0; g < 2; ++g) { const bf16_t* p_ = QC + (size_t)(T0_ + 4 * g + aq) * NATT + QC_QI + ah * 64 + 32 * half; \
            _Pragma("unroll") for (int s = 0; s < 4; ++s) A_[g][s] = *(const bf16x8*)(p_ + 8 * s); } } while (0)
#define IDX_SCORE(u_, par_, unext_) do { const int T0 = (u_) * 8, b = T0 >> 11, p0 = T0 & (SEQ - 1); \
        LAS float* sc = scb + (par_) * 16384; LAS float* wiL = wiB + ((par_) * 8 + w) * 64; \
        bf16x8 Af[2][4]; \
        _Pragma("unroll") for (int g = 0; g < 2; ++g) _Pragma("unroll") for (int s = 0; s < 4; ++s) Af[g][s] = An[g][s]; \
        const unsigned cw = cwn; wiL[lane] = bf2f(win); \
        if (IDX_OK(unext_)) IDX_FETCH(unext_, An, cwn, win); \
        { const size_t tok = (size_t)T0 + w; const float c0 = bflo(cw), c1 = bfhi(cw); \
          const float ss = wave_sum_f32_dpp(c0 * c0 + c1 * c1); const float rs = rsqrtf(ss * (1.0f / 128.0f) + EPS); const f32x2 gg = gg_lat; \
          *(unsigned*)(CN + tok * 128 + 2 * lane) = cvt_pk_bf16(c0 * rs * gg.x, c1 * rs * gg.y); } \
        LDS_WAIT(); asm volatile("" ::: "memory"); \
        const int nkt = (p0 + 8 + 31) >> 5; \
        for (int kt0 = w; kt0 < nkt; kt0 += 16) { \
            bf16x8 Bf[2][4]; \
            _Pragma("unroll") for (int bi = 0; bi < 2; ++bi) { const int kt = kt0 + 8 * bi; if (kt < nkt) { const bf16_t* kp = QC + ((size_t)b * SEQ + 32 * kt + (lane & 31)) * NATT + QC_KI + 32 * half; \
                _Pragma("unroll") for (int s4 = 0; s4 < 4; ++s4) Bf[bi][s4] = *(const bf16x8*)(kp + 8 * s4); } } \
            _Pragma("unroll") for (int bi = 0; bi < 2; ++bi) { const int kt = kt0 + 8 * bi; if (kt < nkt) { const int key = 32 * kt + (lane & 31); \
                _Pragma("unroll") for (int g = 0; g < 2; ++g) { \
                    f32x16 acc; \
                    _Pragma("unroll") for (int e = 0; e < 16; ++e) acc[e] = 0.f; \
                    _Pragma("unroll") for (int s4 = 0; s4 < 4; ++s4) acc = __builtin_amdgcn_mfma_f32_32x32x16_bf16(Af[g][s4], Bf[bi][s4], acc, 0, 0, 0); \
                    _Pragma("unroll") for (int e = 0; e < 2; ++e) { float sv = 0.f; const f32x4 wlo = *(const LAS f32x4*)(wiL + (4 * g + 2 * half + e) * 8), whi = *(const LAS f32x4*)(wiL + (4 * g + 2 * half + e) * 8 + 4); \
                        _Pragma("unroll") for (int h = 0; h < 4; ++h) { sv = fmaf(wlo[h], fmaxf(acc[8 * e + h], 0.f), sv); sv = fmaf(whi[h], fmaxf(acc[8 * e + 4 + h], 0.f), sv); } \
                        const int qi = 4 * g + 2 * half + e; \
                        sc[qi * 2048 + key] = (key <= p0 + qi) ? sv : -INFINITY; } \
                } } } \
        } } while (0)
    const f32x2 gg_lat = *(const f32x2*)(P.in[14] + (size_t)j * 128 + 2 * lane);
    bf16x8 An[2][4]; unsigned cwn = 0u; unsigned short win = 0;
    { const int u0 = IDX_UNIT(0); if (IDX_OK(u0)) { IDX_FETCH(u0, An, cwn, win); const int u1 = IDX_UNIT(1); IDX_SCORE(u0, 0, u1); } }
    __syncthreads();
    for (int i = 0;; ++i) {
        const int u = IDX_UNIT(i); if (u < 0) break;
        if (IDX_OK(u)) {
            const int T0 = u * 8, p0 = T0 & (SEQ - 1); const LAS float* sc = scb + (i & 1) * 16384;
            const int pos = p0 + w, n = pos + 1; unsigned short* out = IDX + (size_t)(T0 + w) * 256;
            if (n <= TOPK) {
#pragma unroll
                for (int jj = 0; jj < 4; ++jj) { const int s = lane + 64 * jj; const int dist = pos - s; const unsigned bk = (dist >= 0) ? (dist >= 128 ? 31u : (unsigned)bkL[dist]) : 0u;
                    out[s] = (s < n) ? (unsigned short)(s | (bk << 11)) : (unsigned short)0; }
            } else {
                const LAS float* scq = sc + w * 2048;
                if (n <= 512) idx_select<8>(scq, pos, lane, bkL, out); else if (n <= 1024) idx_select<16>(scq, pos, lane, bkL, out);
                else if (n <= 1536) idx_select<24>(scq, pos, lane, bkL, out); else idx_select<32>(scq, pos, lane, bkL, out);
            }
        }
        { const int un = IDX_UNIT(i + 1); if (IDX_OK(un)) { const int un2 = IDX_UNIT(i + 2); IDX_SCORE(un, (i + 1) & 1, un2); } }
        __syncthreads();
    }
#undef IDX_UNIT
#undef IDX_OK
#undef IDX_FETCH
#undef IDX_SCORE
}

__device__ __forceinline__ s16x4 tr_read(const LAS unsigned char* p) {
    typedef short v4i16_t __attribute__((ext_vector_type(4)));
    return __builtin_bit_cast(s16x4, __builtin_amdgcn_ds_read_tr16_b64_v4i16((LAS v4i16_t*)p));
}
struct AttState { float mrun, lrun; f32x4 O[8]; };
__device__ __forceinline__ float xmax16(float v) { const auto r = __builtin_amdgcn_permlane16_swap(__float_as_uint(v), __float_as_uint(v), false, false); return fmaxf(__uint_as_float(r[0]), __uint_as_float(r[1])); }
__device__ __forceinline__ float xmax32(float v) { const auto r = __builtin_amdgcn_permlane32_swap(__float_as_uint(v), __float_as_uint(v), false, false); return fmaxf(__uint_as_float(r[0]), __uint_as_float(r[1])); }
__device__ __forceinline__ float xsum16(float v) { const auto r = __builtin_amdgcn_permlane16_swap(__float_as_uint(v), __float_as_uint(v), false, false); return __uint_as_float(r[0]) + __uint_as_float(r[1]); }
__device__ __forceinline__ float xsum32(float v) { const auto r = __builtin_amdgcn_permlane32_swap(__float_as_uint(v), __float_as_uint(v), false, false); return __uint_as_float(r[0]) + __uint_as_float(r[1]); }
__device__ __forceinline__ void att_stage(const bf16x8 (&cf)[16], LAS unsigned char* V, int lane) {
    constexpr int VROW = 288;
#pragma unroll
    for (int i = 0; i < 16; ++i) *(LAS bf16x8*)(V + (16 * (lane >> 4) + i) * VROW + (lane & 15) * 16) = cf[i];
    asm volatile("" ::: "memory");
}
__device__ __forceinline__ void att_qk(const bf16x8 (&qf)[4], f32x4 (&S)[4], const LAS unsigned char* V, int lane, int g) {
    constexpr int VROW = 288;
    const LAS unsigned char* ab = V + (lane & 15) * VROW + 16 * g;
    __builtin_amdgcn_s_setprio(1);
#pragma unroll
    for (int t = 0; t < 4; ++t) { S[t] = (f32x4){0.f, 0.f, 0.f, 0.f};
#pragma unroll
        for (int ks = 0; ks < 4; ++ks) { const bf16x8 af = *(const LAS bf16x8*)(ab + 16 * t * VROW + 64 * ks); S[t] = __builtin_amdgcn_mfma_f32_16x16x32_bf16(af, qf[ks], S[t], 0, 0, 0); } }
    __builtin_amdgcn_s_setprio(0);
}
template <bool MASKED>
__device__ __forceinline__ void att_sm_pv(const f32x4 (&S)[4], int s, int cnt, AttState& st, const LAS unsigned short* listL, const LAS float* biasL, const LAS unsigned char* trbase, int head, int g) {
    constexpr int VROW = 288; constexpr float L2E = 1.44269504089f;
    float val[4][4]; float cmax = -INFINITY;
#pragma unroll
    for (int t = 0; t < 4; ++t) { const u16x4 pk4 = *(const LAS u16x4*)(listL + 64 * s + 16 * t + 4 * g);
#pragma unroll
        for (int r = 0; r < 4; ++r) { const float bias = *(const LAS float*)((const LAS unsigned char*)biasL + ((pk4[r] >> 5) & 0x7C0u) + head * 4);
            float v = S[t][r] + bias; if (MASKED) v = (64 * s + 16 * t + 4 * g + r < cnt) ? v : -INFINITY; val[t][r] = v; cmax = fmaxf(cmax, v); } }
    cmax = xmax32(xmax16(cmax));
    const float mnew = fmaxf(st.mrun, cmax), mneg = -mnew * L2E;
    const float alpha = __builtin_amdgcn_exp2f(fmaf(st.mrun, L2E, mneg));
    float p[4][4]; float psum = 0.f;
#pragma unroll
    for (int t = 0; t < 4; ++t)
#pragma unroll
        for (int r = 0; r < 4; ++r) { p[t][r] = __builtin_amdgcn_exp2f(fmaf(val[t][r], L2E, mneg)); psum += p[t][r]; }
    psum = xsum32(xsum16(psum));
    const bool moved = __builtin_amdgcn_ballot_w64(mnew > st.mrun) != 0ull;
    st.lrun = st.lrun * alpha + psum; st.mrun = mnew;
    if (moved) {
#pragma unroll
        for (int dt = 0; dt < 8; ++dt) st.O[dt] = st.O[dt] * alpha; }
    union { bf16x8 v; unsigned u[4]; } pf[2];
#pragma unroll
    for (int hh = 0; hh < 2; ++hh) { pf[hh].u[0] = cvt_pk_bf16(p[2 * hh][0], p[2 * hh][1]); pf[hh].u[1] = cvt_pk_bf16(p[2 * hh][2], p[2 * hh][3]); pf[hh].u[2] = cvt_pk_bf16(p[2 * hh + 1][0], p[2 * hh + 1][1]); pf[hh].u[3] = cvt_pk_bf16(p[2 * hh + 1][2], p[2 * hh + 1][3]); }
    __builtin_amdgcn_s_setprio(1);
#pragma unroll
    for (int dt = 0; dt < 8; ++dt)
#pragma unroll
        for (int hh = 0; hh < 2; ++hh) {
            union { bf16x8 v; s16x4 h[2]; } vf;
            vf.h[0] = tr_read(trbase + hh * 32 * VROW + dt * 32); vf.h[1] = tr_read(trbase + (hh * 32 + 16) * VROW + dt * 32);
            st.O[dt] = __builtin_amdgcn_mfma_f32_16x16x32_bf16(vf.v, pf[hh].v, st.O[dt], 0, 0, 0);
        }
    __builtin_amdgcn_s_setprio(0);
    asm volatile("" ::: "memory");
}
__device__ __forceinline__ void attn_phase(const Frame& F, const Ptrs& P, bool dry = false) {
    constexpr int VROW = 288, VBYTES = 64 * VROW;
    LAS unsigned char* V = F.lds + F.wave * VBYTES;
    LAS unsigned short* listB = (LAS unsigned short*)(F.lds + 8 * VBYTES + F.wave * 1024);
    LAS float* biasL = (LAS float*)(F.lds + 8 * VBYTES + 8 * 1024);
    static_assert(8 * VBYTES + 8 * 1024 + 2048 <= MISC_OFF, "attention LDS map");
    bf16_t* QC = (bf16_t*)(P.ws + WS_QC); const bf16_t* CN = (const bf16_t*)(P.ws + WS_CN); const unsigned short* IDX = (const unsigned short*)(P.ws + WS_IDX);
    const int lane = F.lane, head = lane & 15, g = lane >> 4;
    if (F.tid < 512) biasL[F.tid] = P.in[18][F.tid];
    __syncthreads();
    const int gw = F.vcu * NWAVES + F.wave, NGW = F.G * NWAVES;
    const int trq = (lane & 15) >> 2, trp = lane & 3;
    const LAS unsigned char* trbase = V + (4 * g + trq) * VROW + 8 * trp;
#define ATT_LOAD(buf, ss, listL, cnb) do { const u32x4 l0_ = *(const LAS u32x4*)(listL + 64 * (ss) + 16 * (lane >> 4)), l1_ = *(const LAS u32x4*)(listL + 64 * (ss) + 16 * (lane >> 4) + 8); \
        _Pragma("unroll") for (int i = 0; i < 16; ++i) { const unsigned w_ = (i < 8) ? l0_[(i & 7) >> 1] : l1_[(i & 7) >> 1]; const unsigned pk = (i & 1) ? (w_ >> 16) : (w_ & 0xffffu); \
            buf[i] = *(const bf16x8*)(cnb + (((pk & 2047u) << 8) + (unsigned)(lane & 15) * 16u)); } } while (0)
#define ATT_TOKEN(k_) ((k_) * NGW + ((gw + 256 * (k_)) % NGW))
    unsigned long long lstn = 0ull; bf16x8 qfn[4]; bf16x8 cf[16];
    if (ATT_TOKEN(0) < M) { const int t0_ = ATT_TOKEN(0); lstn = *(const unsigned long long*)(IDX + (size_t)t0_ * 256 + 4 * lane); const bf16_t* qp = QC + (size_t)t0_ * NATT + head * 128 + 8 * g;
#pragma unroll
        for (int ks = 0; ks < 4; ++ks) qfn[ks] = *(const bf16x8*)(qp + 32 * ks);
        asm volatile("" ::: "memory");
        *(LAS unsigned long long*)(listB + 4 * lane) = lstn;
        asm volatile("" ::: "memory");
        const char* cnb0 = (const char*)(CN + (size_t)__builtin_amdgcn_readfirstlane(t0_ >> 11) * SEQ * 128);
        ATT_LOAD(cf, 0, listB, cnb0); }
    for (int kr = 0; kr * NGW < M; ++kr) {
        const int token = ATT_TOKEN(kr); if (token >= M) break;
        const int b = token >> 11, pos = token & (SEQ - 1), cnt = pos + 1 < TOPK ? pos + 1 : TOPK, nstep = (cnt + 63) >> 6;
        LAS unsigned short* listL = listB + (kr & 1) * 256;
        bf16x8 qf[4];
#pragma unroll
        for (int ks = 0; ks < 4; ++ks) qf[ks] = qfn[ks];
        const char* cnb = (const char*)(CN + (size_t)__builtin_amdgcn_readfirstlane(b) * SEQ * 128);
        const int nt_ = ((kr + 1) * NGW < M) ? ATT_TOKEN(kr + 1) : M;
        if (nt_ < M) { lstn = *(const unsigned long long*)(IDX + (size_t)nt_ * 256 + 4 * lane); const bf16_t* qp = QC + (size_t)nt_ * NATT + head * 128 + 8 * g;
#pragma unroll
            for (int ks = 0; ks < 4; ++ks) qfn[ks] = *(const bf16x8*)(qp + 32 * ks); }
        AttState st; st.mrun = -INFINITY; st.lrun = 0.f;
#pragma unroll
        for (int dt = 0; dt < 8; ++dt) st.O[dt] = (f32x4){0.f, 0.f, 0.f, 0.f};
        for (int s = 0; s < nstep; ++s) {
            f32x4 S[4];
            att_stage(cf, V, lane);
            if (s + 1 < nstep) ATT_LOAD(cf, s + 1, listL, cnb);
            else if (nt_ < M) {
                LAS unsigned short* ln = listB + ((kr + 1) & 1) * 256;
                asm volatile("" ::: "memory");
                *(LAS unsigned long long*)(ln + 4 * lane) = lstn;
                asm volatile("" ::: "memory");
                const char* cnbn = (const char*)(CN + (size_t)__builtin_amdgcn_readfirstlane(nt_ >> 11) * SEQ * 128);
                ATT_LOAD(cf, 0, ln, cnbn); }
            att_qk(qf, S, V, lane, g);
            if (64 * (s + 1) > cnt) att_sm_pv<true>(S, s, cnt, st, listL, biasL, trbase, head, g); else att_sm_pv<false>(S, s, cnt, st, listL, biasL, trbase, head, g);
        }
        const float inv = 1.0f / st.lrun;
        bf16_t* op = QC + (size_t)token * NATT + head * 128 + 4 * g;
        if (dry) { asm volatile("" :: "v"(st.O[0]), "v"(st.O[7]), "v"(inv)); bf16_t* qp = QC + (size_t)token * NATT + head * 128 + 8 * g;
#pragma unroll
            for (int ks = 0; ks < 4; ++ks) *(bf16x8*)(qp + 32 * ks) = qf[ks]; continue; }
#pragma unroll
        for (int dt = 0; dt < 8; ++dt) { u32x2 wv; wv.x = cvt_pk_bf16(st.O[dt][0] * inv, st.O[dt][1] * inv); wv.y = cvt_pk_bf16(st.O[dt][2] * inv, st.O[dt][3] * inv); *(u32x2*)(op + 16 * dt) = wv; }
    }
#undef ATT_LOAD
#undef ATT_TOKEN
}


#ifndef NAIVE_IDX
#define NAIVE_IDX 0
#endif
#ifndef NAIVE_ATT
#define NAIVE_ATT 0
#endif
__device__ __forceinline__ void naive_index_phase(const Frame& F, const Ptrs& P, int j) {
    LAS float* sc = (LAS float*)F.lds;
    LAS float* qiL = sc + 2048;
    LAS float* wL = qiL + 512;
    LAS int* cntL = (LAS int*)(wL + 8);
    LAS unsigned char* bkL = (LAS unsigned char*)(cntL + 520);
    const bf16_t* QC = (const bf16_t*)(P.ws + WS_QC); bf16_t* CN = (bf16_t*)(P.ws + WS_CN); unsigned short* IDX = (unsigned short*)(P.ws + WS_IDX);
    const int tid = F.tid;
    if (tid < 128) { const int n = tid; int bk = n; if (n >= 16) { bk = 16 + (int)(logf((float)n / 16.0f) / 2.0794415416798357f * 16.0f); bk = bk > 31 ? 31 : bk; } bkL[n] = (unsigned char)bk; }
    __syncthreads();
    for (int tok = F.vcu; tok < M; tok += F.G) {
        const int b = tok >> 11, pos = tok & (SEQ - 1), n = pos + 1;
        if (tid < 64) {
            const unsigned cw = *(const unsigned*)(QC + (size_t)tok * NATT + QC_C + 2 * tid); const float c0 = bflo(cw), c1 = bfhi(cw);
            const float ss = wave_sum(c0 * c0 + c1 * c1); const float rs = rsqrtf(ss * (1.0f / 128.0f) + EPS); const float* g = P.in[14] + (size_t)j * 128 + 2 * tid;
            *(unsigned*)(CN + (size_t)tok * 128 + 2 * tid) = cvt_pk_bf16(c0 * rs * g[0], c1 * rs * g[1]);
        }
        qiL[tid] = bf2f(QC[(size_t)tok * NATT + QC_QI + tid]);
        if (tid < 8) wL[tid] = bf2f(QC[(size_t)tok * NATT + QC_WI + tid]);
        __syncthreads();
        for (int key = tid; key < SEQ; key += NTHREADS) {
            float s = -INFINITY;
            if (key <= pos) { const bf16_t* kp = QC + ((size_t)b * SEQ + key) * NATT + QC_KI; s = 0.f;
                for (int h = 0; h < 8; ++h) { float d = 0.f; for (int e = 0; e < 64; ++e) d = fmaf(qiL[h * 64 + e], bf2f(kp[e]), d); s = fmaf(wL[h], fmaxf(d, 0.f), s); }
                s = s + 0.0f; }
            sc[key] = s;
        }
        __syncthreads();
        unsigned short* out = IDX + (size_t)tok * 256;
        if (n <= TOPK) { if (tid < 256) { const int dist = pos - tid; const unsigned bk = (dist >= 0) ? (dist >= 128 ? 31u : (unsigned)bkL[dist]) : 0u; out[tid] = (tid < n) ? (unsigned short)(tid | (bk << 11)) : (unsigned short)0; } }
        else {
            bool sel[4]; int mycnt = 0;
            for (int e = 0; e < 4; ++e) { const int i = tid * 4 + e; sel[e] = false;
                if (i <= pos) { const float si = sc[i]; int rank = 0; for (int jx = 0; jx <= pos; ++jx) { const float sj = sc[jx]; rank += (sj > si || (sj == si && jx < i)) ? 1 : 0; } sel[e] = rank < TOPK; }
                mycnt += sel[e] ? 1 : 0; }
            cntL[tid] = mycnt;
            __syncthreads();
            int basep = 0; for (int t2 = 0; t2 < tid; ++t2) basep += cntL[t2];
            for (int e = 0; e < 4; ++e) if (sel[e]) { const int i = tid * 4 + e; const int dist = pos - i; const unsigned bk = dist >= 128 ? 31u : (unsigned)bkL[dist]; out[basep++] = (unsigned short)(i | (bk << 11)); }
        }
        __syncthreads();
    }
}
__device__ __forceinline__ void naive_attn_phase(const Frame& F, const Ptrs& P) {
    bf16_t* QC = (bf16_t*)(P.ws + WS_QC); const bf16_t* CN = (const bf16_t*)(P.ws + WS_CN); const unsigned short* IDX = (const unsigned short*)(P.ws + WS_IDX);
    LAS float* pL = (LAS float*)(F.lds + F.wave * 4096);
    LAS int* kL = (LAS int*)(pL + 256);
    LAS float* oL = (LAS float*)(kL + 256);
    const int lane = F.lane, gw = F.vcu * NWAVES + F.wave, NGW = F.G * NWAVES;
    for (int token = gw; token < M; token += NGW) {
        const int b = token >> 11, pos = token & (SEQ - 1), cnt = pos + 1 < TOPK ? pos + 1 : TOPK;
        float qv[16][2];
#pragma unroll
        for (int h = 0; h < 16; ++h) { qv[h][0] = bf2f(QC[(size_t)token * NATT + h * 128 + lane]); qv[h][1] = bf2f(QC[(size_t)token * NATT + h * 128 + 64 + lane]); }
        for (int s = lane; s < 256; s += 64) kL[s] = IDX[(size_t)token * 256 + s];
        LDS_WAIT(); asm volatile("" ::: "memory");
#pragma unroll
        for (int h = 0; h < 16; ++h) {
            float mx = -INFINITY;
            for (int s = 0; s < cnt; ++s) { const int pk = kL[s]; const bf16_t* cp = CN + ((size_t)b * SEQ + (pk & 2047)) * 128;
                float d = qv[h][0] * bf2f(cp[lane]) + qv[h][1] * bf2f(cp[64 + lane]); d = wave_sum(d);
                d += P.in[18][(pk >> 11) * 16 + h]; if (lane == 0) pL[s] = d; mx = fmaxf(mx, d); }
            LDS_WAIT(); asm volatile("" ::: "memory");
            float sum = 0.f; for (int s = 0; s < cnt; ++s) sum += __expf(pL[s] - mx);
            float o0 = 0.f, o1 = 0.f;
            for (int s = 0; s < cnt; ++s) { const int pk = kL[s]; const bf16_t* cp = CN + ((size_t)b * SEQ + (pk & 2047)) * 128; const float p = __expf(pL[s] - mx) / sum;
                o0 = fmaf(p, bf2f(cp[lane]), o0); o1 = fmaf(p, bf2f(cp[64 + lane]), o1); }
            QC[(size_t)token * NATT + h * 128 + lane] = (bf16_t)(cvt_pk_bf16(o0, 0.f) & 0xffffu); QC[(size_t)token * NATT + h * 128 + 64 + lane] = (bf16_t)(cvt_pk_bf16(o1, 0.f) & 0xffffu);
            asm volatile("" ::: "memory");
        }
    }
}


#ifndef MK_DEBUG_CHECKS
#define MK_DEBUG_CHECKS 0
#endif
#if MK_DEBUG_CHECKS
constexpr size_t WS_DIAG = 224 * MiB, WS_SAVE = 225 * MiB, WS_SAVEG = 226 * MiB, WS_TMPO = 227 * MiB;
constexpr int NS = 256;
__device__ __forceinline__ int srow(int s) { return ((s & 63) << 8) | ((s * 37 + 11) & 255); }
__device__ __forceinline__ float diag_err(float mine, float ref) { float e = fabsf(mine - ref) / (fabsf(ref) + 0.25f); if (!(e == e)) e = 1e9f; return e; }
__device__ __forceinline__ void diag_max(unsigned char* ws, int id, float e) {
    for (int o = 1; o < 64; o <<= 1) e = fmaxf(e, __shfl_xor(e, o));
    if ((threadIdx.x & 63) == 0) atomicMax((unsigned*)(ws + WS_DIAG) + id, __float_as_uint(e));
}
__device__ __forceinline__ void diag_put(unsigned char* ws, int id, float mine, float ref) { diag_max(ws, id, diag_err(mine, ref)); }
__device__ __forceinline__ float d_rs(const unsigned char* ws, int row) { const float* p = (const float*)(ws + WS_SSQ) + (size_t)row * 16; float s = 0.f; for (int i = 0; i < 16; ++i) s += p[i]; return rsqrtf(s / 1024.f + EPS); }
__device__ __forceinline__ float d_bf(const unsigned char* ws, size_t off, size_t idx) { return bf2f(((const bf16_t*)(ws + off))[idx]); }
__global__ void chk_zero(unsigned char* ws) { if (threadIdx.x < 64) ((unsigned*)(ws + WS_DIAG))[threadIdx.x] = 0u; }
__global__ void chk_save_rows(unsigned char* ws, const float* src) { const int s = blockIdx.x; float* d = (float*)(ws + WS_SAVE) + s * 1024; for (int c = threadIdx.x; c < 1024; c += blockDim.x) d[c] = src[(size_t)srow(s) * D + c]; }
__global__ void chk_proj(unsigned char* ws, int id, size_t off_a, int lda, const float* W, int ldw, const float* gam, int K, int N, size_t off_o, int ldo, int mode) {
    const int s = blockIdx.y, row = srow(s), col = blockIdx.x * blockDim.x + threadIdx.x;
    float acc = 0.f; for (int k = 0; k < K; ++k) acc = fmaf(d_bf(ws, off_a, (size_t)row * lda + k) * (gam ? gam[k] : 1.f), W[(size_t)k * ldw + col], acc);
    acc *= d_rs(ws, row);
    if (mode == 1 && col < 1024) acc = 0.5f * acc * (1.f + tanhf(0.7978845608f * (acc + 0.044715f * acc * acc * acc)));
    if (mode == 2) { acc = fmaxf(acc, 0.f); acc *= acc; }
    diag_put(ws, id, d_bf(ws, off_o, (size_t)row * ldo + col), acc);
}
__global__ void chk_res(unsigned char* ws, int id, size_t off_a, int lda, const float* W, int K, const float* outp, const float* xold_full) {
    const int s = blockIdx.y, row = srow(s), col = blockIdx.x * blockDim.x + threadIdx.x;
    float acc = 0.f; for (int k = 0; k < K; ++k) acc = fmaf(d_bf(ws, off_a, (size_t)row * lda + k), W[(size_t)k * D + col], acc);
    const float xo = xold_full ? xold_full[(size_t)row * D + col] : ((const float*)(ws + WS_SAVE))[s * 1024 + col];
    diag_put(ws, id, outp[(size_t)row * D + col], xo + acc);
    diag_put(ws, id, d_bf(ws, WS_XB, (size_t)row * D + col), xo + acc);
}
__global__ void chk_ssq(unsigned char* ws, int id, const float* outp) {
    const int s = blockIdx.x * blockDim.x + threadIdx.x; const int row = srow(s); float q = 0.f; for (int c = 0; c < D; ++c) { const float v = outp[(size_t)row * D + c]; q += v * v; }
    const float* p = (const float*)(ws + WS_SSQ) + (size_t)row * 16; float t = 0.f; for (int i = 0; i < 16; ++i) t += p[i]; diag_put(ws, id, t, q);
}
__global__ void chk_conv(unsigned char* ws, int id, const float* cw, const float* cb) {
    const int s = blockIdx.y, row = srow(s) & ~3 | (s & 3) * 0, ch = blockIdx.x * blockDim.x + threadIdx.x;
    const int rr = (s < 16) ? ((s >> 1) * SEQ + (s & 1) * 256 * 3 + (s & 3)) : srow(s); const int pos = rr & (SEQ - 1);
    float acc = cb[ch]; for (int k = 0; k < 4; ++k) { const int p = pos - 3 + k; if (p >= 0) acc += cw[k * D + ch] * d_bf(ws, WS_GX, (size_t)(rr - 3 + k) * 2048 + 1024 + ch); }
    diag_put(ws, id, d_bf(ws, WS_XC, (size_t)rr * D + ch), acc);
}
__global__ void chk_gates(unsigned char* ws, int id, const float* wa, const float* ba, const float* wx, const float* bx) {
    const int s = blockIdx.y, row = srow(s), ch = blockIdx.x * blockDim.x + threadIdx.x, blk = ch >> 8, i = ch & 255;
    float a = ba[ch], x = bx[ch]; for (int jx = 0; jx < 256; ++jx) { const float v = d_bf(ws, WS_XC, (size_t)row * D + blk * 256 + jx); a = fmaf(v, wa[(size_t)blk * 65536 + jx * 256 + i], a); x = fmaf(v, wx[(size_t)blk * 65536 + jx * 256 + i], x); }
    diag_put(ws, id, d_bf(ws, WS_RB, (size_t)row * D + ch), 1.f / (1.f + expf(-a))); diag_put(ws, id, d_bf(ws, WS_IB, (size_t)row * D + ch), 1.f / (1.f + expf(-x)));
}
__global__ void chk_save_gate(unsigned char* ws) {
    const int p = blockIdx.x, b = p & 7, ch = (p * 61 + 5) & 1023; bf16_t* d = (bf16_t*)(ws + WS_SAVEG) + p * 2048;
    for (int t = threadIdx.x; t < SEQ; t += blockDim.x) d[t] = ((const bf16_t*)(ws + WS_GX))[((size_t)b * SEQ + t) * 2048 + ch];
}
__global__ void chk_scan(unsigned char* ws, int id, const float* lam) {
    const int p = blockIdx.x * blockDim.x + threadIdx.x; const int b = p & 7, ch = (p * 61 + 5) & 1023;
    const float sp = -8.f * log1pf(expf(-lam[ch])); float h = 0.f, em = 0.f;
    for (int t = 0; t < SEQ; ++t) { const size_t r = (size_t)b * SEQ + t; const float rr = d_bf(ws, WS_RB, r * D + ch), ii = d_bf(ws, WS_IB, r * D + ch), xc = d_bf(ws, WS_XC, r * D + ch);
        const float la = sp * rr, a = expf(la), u = sqrtf(-expm1f(2.f * la)) * (ii * xc); h = a * h + u;
        const float g = bf2f(((const bf16_t*)(ws + WS_SAVEG))[p * 2048 + t]); em = fmaxf(em, diag_err(d_bf(ws, WS_GX, r * 2048 + ch), h * g)); }
    diag_max(ws, id, em);
}
__global__ void chk_att_in(unsigned char* ws, int id, const float* Win, const float* wuk, const float* gam) {
    const int s = blockIdx.y, row = srow(s), col = blockIdx.x * blockDim.x + threadIdx.x;
    const float rs = d_rs(ws, row); float ref = 0.f;
    if (col < 2048) { const int h = col >> 7, c = col & 127;
        for (int d = 0; d < 64; ++d) { float q = 0.f; for (int k = 0; k < D; ++k) q = fmaf(d_bf(ws, WS_XB, (size_t)row * D + k) * gam[k], Win[(size_t)k * ATT_IN + h * 64 + d], q); ref = fmaf(q, wuk[((size_t)h * 64 + d) * 128 + c], ref); }
        ref *= rs * 0.125f; }
    else if (col < 2760) { const int wc = 1024 + (col - 2048); for (int k = 0; k < D; ++k) ref = fmaf(d_bf(ws, WS_XB, (size_t)row * D + k) * gam[k], Win[(size_t)k * ATT_IN + wc], ref); ref *= rs * (col >= 2752 ? 0.044194173824159216f : 1.f); }
    diag_put(ws, id, d_bf(ws, WS_QC, (size_t)row * NATT + col), ref);
}
__global__ void chk_cn(unsigned char* ws, int id, const float* g) {
    const int s = blockIdx.x, row = srow(s), c = threadIdx.x; float ss = 0.f; for (int e = 0; e < 128; ++e) { const float v = d_bf(ws, WS_QC, (size_t)row * NATT + QC_C + e); ss += v * v; }
    diag_put(ws, id, d_bf(ws, WS_CN, (size_t)row * 128 + c), d_bf(ws, WS_QC, (size_t)row * NATT + QC_C + c) * rsqrtf(ss / 128.f + EPS) * g[c]);
}
__global__ void chk_att_o(unsigned char* ws, const float* wuv) {
    const int s = blockIdx.y, row = srow(s), n = blockIdx.x * blockDim.x + threadIdx.x, h = n >> 6, v = n & 63; float a = 0.f;
    for (int c = 0; c < 128; ++c) a = fmaf(d_bf(ws, WS_QC, (size_t)row * NATT + h * 128 + c), wuv[((size_t)h * 128 + c) * 64 + v], a);
    ((float*)(ws + WS_TMPO))[s * 1024 + n] = a;
}
__global__ void chk_att_out(unsigned char* ws, int id, const float* wo, const float* outp) {
    const int s = blockIdx.y, row = srow(s), col = blockIdx.x * blockDim.x + threadIdx.x; float a = 0.f;
    for (int k = 0; k < 1024; ++k) a = fmaf(((const float*)(ws + WS_TMPO))[s * 1024 + k], wo[(size_t)k * D + col], a);
    diag_put(ws, id, outp[(size_t)row * D + col], ((const float*)(ws + WS_SAVE))[s * 1024 + col] + a);
}
__global__ void chk_report(unsigned char* ws, float* outp) {
    if (threadIdx.x == 0) { const unsigned* dg = (const unsigned*)(ws + WS_DIAG); for (int id = 1; id < 40; ++id) { const float e = __uint_as_float(dg[id]); if (e > 0.1f) { outp[0] = 100.f * id + 10.f; break; } } }
}
#endif


#ifndef MK_DETCHECK
#define MK_DETCHECK 0
#endif
#if MK_DETCHECK
constexpr size_t WS_CKS = 230 * MiB;
__global__ void cks_zero(unsigned* d) { d[threadIdx.x] = 0u; }
__global__ void lds_poison(unsigned pat) { extern __shared__ unsigned lp[]; for (int i = threadIdx.x; i < LDS_BYTES / 4; i += blockDim.x) lp[i] = pat; __syncthreads(); if (lp[threadIdx.x] != pat) asm volatile("s_nop 0"); }
__global__ void cks_kernel(const unsigned* p, size_t nwords, unsigned* dst) {
    unsigned a = 0u; for (size_t i = (size_t)blockIdx.x * blockDim.x + threadIdx.x; i < nwords; i += (size_t)gridDim.x * blockDim.x) a += p[i] * 2654435761u + (unsigned)i;
    for (int o = 1; o < 64; o <<= 1) a += __shfl_xor(a, o);
    if ((threadIdx.x & 63) == 0) atomicAdd(dst, a);
}
__global__ void cks_report(const unsigned* d, float* outp) { if (threadIdx.x == 0) for (int ph = 0; ph < 64; ++ph) if (d[ph] != d[64 + ph]) { outp[0] = 100.f * (ph + 1) + 10.f; break; } }
#endif

constexpr int N_PHASES = 28;
#ifndef MK_PER_PHASE
#define MK_PER_PHASE 0
#endif

__global__ void __launch_bounds__(NTHREADS, 2) trunk_fwd(Args args) {
    extern __shared__ __attribute__((aligned(16))) unsigned char lds_raw[];
    Frame F0;
    F0.lds = (LAS unsigned char*)lds_raw;
    F0.tid = threadIdx.x; F0.lane = F0.tid & 63; F0.wave = __builtin_amdgcn_readfirstlane(F0.tid >> 6);
    F0.G = gridDim.x; F0.bid = blockIdx.x; { const int bx = blockIdx.x; F0.vcu = (F0.G % 8 == 0) ? (bx % 8) * (F0.G / 8) + bx / 8 : bx; }
    volatile LAS unsigned* MISC = (volatile LAS unsigned*)(F0.lds + MISC_OFF);
    for (int u = F0.tid; u < (LDS_BYTES - LDSCTL_OFF) / 4; u += NTHREADS) ((LAS unsigned*)(F0.lds + LDSCTL_OFF))[u] = 0u;
    __syncthreads();
    unsigned* barw = (unsigned*)(args.ws + WS_CTL) + CW_BAR;
    XcdBarrier bar; bar.bar = barw; bar.x = 0; bar.st = nullptr;
    if (!MK_PER_PHASE) bar = xcd_barrier_post(barw, MISC + 8);
    const int lo = args.ph_lo, hi = args.ph_hi;
#ifndef PHMASK
#define PHMASK 0xFFFFu
#endif
#define PM(b) ((PHMASK >> (b)) & 1u)

#define IN(k) (lo <= (k) && (k) < hi)
#define SEAM(k) do { if (IN(k) && IN((k) + 1)) xcd_barrier(bar); } while (0)

#define PHASE_PTRS const Frame F = launder(F0); const Ptrs P = load_ptrs(); bf16_t* XB = (bf16_t*)(P.ws + WS_XB); float* SSQ = (float*)(P.ws + WS_SSQ); float* SSQM = (float*)(P.ws + WS_SSQM); \
    bf16_t* WM = (bf16_t*)(P.ws + WS_WMIX); bf16_t* WA = (bf16_t*)(P.ws + WS_WATT); bf16_t* WUP = (bf16_t*)(P.ws + WS_WUP); bf16_t* WDN = (bf16_t*)(P.ws + WS_WDOWN); \
    (void)XB; (void)SSQ; (void)SSQM; (void)WM; (void)WA; (void)WUP; (void)WDN

    if (PM(0) && IN(0)) { PHASE_PTRS; if (DB(0)) { cvt_att_mix(F, P, 0, 1); cvt_rec_mix(F, P, 0, 0); cvt_up(F, P, 0); cvt_down(F, P, 0); p0_rows(F, P); __syncthreads(); } cvt_att_mix(F, P, 0, 1, 0); cvt_att_mix(F, P, 1, 3, 1024); cvt_rec_mix(F, P, 0, 0); cvt_up(F, P, 0); cvt_down(F, P, 0); p0_rows(F, P); }
    SEAM(0);

    for (int L = 0; L < DEPTH; ++L) {
        const int pb = 1 + 7 * ((L + 1) >> 1) + 6 * (L >> 1), j = L >> 1, mo = (L & 1) ? 0 : 1;
        if ((L & 1) == 0) {
            if (PM(1) && IN(pb)) { PHASE_PTRS;
                { const Frame& F1 = F; (void)F1;
                pg8::Gemm g{XB, WM, D, D, D, -1}; pg8::StaticOrder S; S.init(M, 2048, F.G, F.bid);
                pg8::EpiScale<1> E{(bf16_t*)(P.ws + WS_GX), 2048, SSQ};
                if (DB(1)) pg8::gemm_phase(F.lds, F.tid, g, S, E);
                pg8::gemm_phase(F.lds, F.tid, g, S, E); } }
            SEAM(pb);
            if (PM(2) && IN(pb + 1)) { PHASE_PTRS;
                for (int rep = 0; rep < (DB(2) ? 2 : 1); ++rep) for (int p = F.vcu; p < 256; p += F.G) conv_tile(F, P, j, p >> 2, p & 3);
                if (L > 0) cvt_down(F, P, L);
                asm volatile("s_waitcnt vmcnt(0)" ::: "memory"); __syncthreads();
                pg8::Gemm g{(const bf16_t*)(P.ws + WS_XC), WM + WM_REC_GATE, D, D, 256, 3}; pg8::GateOrder S{F.G, F.vcu};
                pg8::EpiGate E{(bf16_t*)(P.ws + WS_RB), (bf16_t*)(P.ws + WS_IB), P.in[8] + (size_t)j * D, P.in[10] + (size_t)j * D};
                pg8::gemm_phase(F.lds, F.tid, g, S, E); }
            SEAM(pb + 2);
            if (PM(3) && IN(pb + 3)) { PHASE_PTRS; if (DB(3)) { scan_phase(F, P, j, true); __syncthreads(); } if (L > 0) { cvt_up(F, P, L); __syncthreads(); } scan_phase(F, P, j); }
            SEAM(pb + 3);
            if (PM(4) && IN(pb + 4)) { PHASE_PTRS;
                pg8::Gemm g{(const bf16_t*)(P.ws + WS_GX), WM + WM_REC_OUT, 2048, D, D, -1}; pg8::StaticOrder S; S.init(M, D, F.G, F.bid);
                pg8::EpiRes<false> E{XB, SSQM, nullptr};
                pg8::gemm_phase(F.lds, F.tid, g, S, E); }
            SEAM(pb + 4);
        } else {
            if (PM(5) && IN(pb)) { PHASE_PTRS;
                { const Frame& F1 = F; (void)F1;
                pg8::Gemm g{XB, WA + (size_t)j * 5 * MiB, D, D, D, -1}; pg8::StaticOrder S; S.init(M, NATT, F.G, F.bid);
                pg8::EpiScale<0> E{(bf16_t*)(P.ws + WS_QC), NATT, SSQ};
                pg8::gemm_phase(F.lds, F.tid, g, S, E); } }
            SEAM(pb);
            if (PM(6) && IN(pb + 1)) { PHASE_PTRS; cvt_down(F, P, L); if (L + 1 < DEPTH) cvt_rec_mix(F, P, (L + 1) >> 1, L + 1); __syncthreads(); if (DB(6)) { index_phase(F, P, j); __syncthreads(); } if (NAIVE_IDX) naive_index_phase(F, P, j); else index_phase(F, P, j); }
            SEAM(pb + 1);
            if (PM(7) && IN(pb + 2)) { PHASE_PTRS; cvt_up(F, P, L); __syncthreads(); if (DB(7)) { attn_phase(F, P, true); __syncthreads(); } if (NAIVE_ATT) naive_attn_phase(F, P); else attn_phase(F, P); }
            SEAM(pb + 2);
            if (PM(8) && IN(pb + 3)) { PHASE_PTRS;
                pg8::Gemm g{(const bf16_t*)(P.ws + WS_QC), WA + (size_t)j * 5 * MiB + WM_ATT_COMB, NATT, 2048, 2048, -1}; pg8::StaticOrder S; S.init(M, D, F.G, F.bid);
                pg8::EpiRes<false> E{XB, SSQM, nullptr};
                pg8::gemm_phase(F.lds, F.tid, g, S, E); }
            SEAM(pb + 3);
        }
        if (PM(9) && IN(pb + 4 + mo)) { PHASE_PTRS;
            { const Frame& F1 = F; (void)F1;
            pg8::Gemm g{XB, WUP, D, D, D, -1}; pg8::StaticOrder S; S.init(M, FF, F.G, F.bid);
            pg8::EpiScale<2> E{(bf16_t*)(P.ws + WS_H), FF, nullptr};
            if (DB(9)) pg8::gemm_phase(F.lds, F.tid, g, S, E);
            pg8::gemm_phase(F.lds, F.tid, g, S, E); } }
        SEAM(pb + 4 + mo);
        if (PM(10) && IN(pb + 5 + mo)) { PHASE_PTRS;
            { const Frame& F1 = F; (void)F1;
            pg8::Gemm g{(const bf16_t*)(P.ws + WS_H), WDN, FF, FF, FF, -1}; pg8::StaticOrder S; S.init(M, D, F.G, F.bid);
            pg8::EpiRes<true> E{XB, SSQ, SSQM};
            pg8::gemm_phase(F.lds, F.tid, g, S, E); } }
        SEAM(pb + 5 + mo);
    }
    if (PM(11) && IN(27)) { PHASE_PTRS; if (DB(11)) final_norm(F, P, true); final_norm(F, P); }
#undef IN
#undef SEAM
}

extern "C" void kernel_launch(void* const* d_in, const int* in_sizes, int n_in, void* d_out, int out_size, void* d_ws, size_t ws_size, hipStream_t stream) {
    static int grid = 0;
    if (grid == 0) {
        if (n_in != 21 || in_sizes[0] != M * D || out_size != M * D || ws_size < WS_END) { fprintf(stderr, "kernel_launch: unexpected shapes (n_in %d, in0 %d, out %d, ws %zu)\n", n_in, n_in > 0 ? in_sizes[0] : -1, out_size, ws_size); grid = -1; return; }
        int dev = 0, cus = 0, per_cu = 0;
        if (hipGetDevice(&dev) != hipSuccess || hipDeviceGetAttribute(&cus, hipDeviceAttributeMultiprocessorCount, dev) != hipSuccess) { grid = -1; return; }
        if (hipFuncSetAttribute((const void*)trunk_fwd, hipFuncAttributeMaxDynamicSharedMemorySize, LDS_BYTES) != hipSuccess) { fprintf(stderr, "kernel_launch: hipFuncSetAttribute failed\n"); grid = -1; return; }
        if (hipOccupancyMaxActiveBlocksPerMultiprocessor(&per_cu, (const void*)trunk_fwd, NTHREADS, LDS_BYTES) != hipSuccess || per_cu < 1) fprintf(stderr, "kernel_launch: occupancy query reports %d\n", per_cu);
        (void)hipGetLastError();
        grid = cus;
    }
    if (grid < 0) return;
    (void)hipMemsetAsync((char*)d_ws + WS_CTL, 0, CTL_ZERO_BYTES, stream);
    Args a{};
    for (int i = 0; i < 21; ++i) a.in[i] = (const float*)d_in[i];
    a.out = (float*)d_out; a.ws = (unsigned char*)d_ws;
#if MK_PER_PHASE
#if MK_DETCHECK
    unsigned char* wsb = (unsigned char*)d_ws; unsigned* ck = (unsigned*)(wsb + WS_CKS);
    cks_zero<<<1, 128, 0, stream>>>(ck);
    (void)hipFuncSetAttribute((const void*)lds_poison, hipFuncAttributeMaxDynamicSharedMemorySize, LDS_BYTES);
    for (int pass = 0; pass < 2; ++pass)
    for (int ph = 0; ph < N_PHASES; ++ph) {
        if (ph == 0) { (void)hipMemsetAsync(wsb + 65536, pass ? 0x55 : 0xAA, 224 * MiB - 65536, stream); (void)hipMemsetAsync(d_out, pass ? 0x55 : 0xAA, (size_t)M * D * 4, stream);
            hipLaunchKernelGGL(lds_poison, dim3(grid), dim3(NTHREADS), LDS_BYTES, stream, pass ? 0x55555555u : 0xAAAAAAAAu); }
        a.ph_lo = ph; a.ph_hi = ph + 1; hipLaunchKernelGGL(trunk_fwd, dim3(grid), dim3(NTHREADS), LDS_BYTES, stream, a);
        int L = -1, k = -1; { const int pbs[5] = {1, 8, 14, 21, 27}; for (int l = 0; l < 4; ++l) if (ph >= pbs[l] && ph < pbs[l + 1]) { L = l; k = ph - pbs[l]; } }
        const bool rec = (L & 1) == 0; unsigned* dst = ck + pass * 64 + ph;
        auto CK = [&](size_t off, size_t bytes) { cks_kernel<<<1024, 256, 0, stream>>>((const unsigned*)(wsb + off), bytes / 4, dst); };
        auto CKO = [&]() { cks_kernel<<<1024, 256, 0, stream>>>((const unsigned*)d_out, (size_t)M * D, dst); CK(WS_XB, 32 * MiB); CK(WS_SSQ, 1 * MiB); };
        if (ph == 0) { CK(WS_WMIX, 10 * MiB); CK(WS_WUP, 8 * MiB); CK(WS_WDOWN, 8 * MiB); CK(WS_XB, 32 * MiB); CK(WS_SSQ, 1 * MiB); }
        else if (ph == 27) { cks_kernel<<<1024, 256, 0, stream>>>((const unsigned*)d_out, (size_t)M * D, dst); }
        else if (rec) {
            if (k == 0) { CK(WS_GX, 64 * MiB); CK(WS_WDOWN, 8 * MiB); }
            if (k == 1) CK(WS_XC, 32 * MiB);
            if (k == 2) { CK(WS_RB, 32 * MiB); CK(WS_IB, 32 * MiB); }
            if (k == 3) CK(WS_GX, 64 * MiB);
            if (k == 4) CKO();
            if (k == 5) { CK(WS_H, 128 * MiB); CK(WS_WMIX, 10 * MiB); }
            if (k == 6) { CKO(); CK(WS_WUP, 8 * MiB); }
        } else {
            if (k == 0) { CK(WS_QC, 88 * MiB); CK(WS_WDOWN, 8 * MiB); }
            if (k == 1) { CK(WS_CN, 4 * MiB); CK(WS_IDX, 8 * MiB); }
            if (k == 2) CK(WS_QC, 88 * MiB);
            if (k == 3) CKO();
            if (k == 4) { CK(WS_H, 128 * MiB); CK(WS_WMIX, 10 * MiB); }
            if (k == 5) { CKO(); CK(WS_WUP, 8 * MiB); }
        }
    }
    cks_report<<<1, 64, 0, stream>>>(ck, (float*)d_out);
#else
#if MK_DEBUG_CHECKS
    unsigned char* ws = (unsigned char*)d_ws; const float** in = (const float**)a.in; float* outp = (float*)d_out;
    chk_zero<<<1, 64, 0, stream>>>(ws);
#endif
    for (int ph = 0; ph < N_PHASES; ++ph) {
#if MK_DEBUG_CHECKS
        int L = -1, k = -1; { const int pbs[5] = {1, 8, 14, 21, 27}; for (int l = 0; l < 4; ++l) if (ph >= pbs[l] && ph < pbs[l + 1]) { L = l; k = ph - pbs[l]; } }
        const int j = L >> 1, id0 = 10 * L; const bool rec = (L & 1) == 0;
        if (L >= 0) {
            if ((rec && k == 4 && L > 0) || (!rec && k == 3) || (rec && k == 6) || (!rec && k == 5)) chk_save_rows<<<NS, 256, 0, stream>>>(ws, outp);
            if (rec && k == 3) chk_save_gate<<<128, 256, 0, stream>>>(ws);
        }
#endif
        a.ph_lo = ph; a.ph_hi = ph + 1; hipLaunchKernelGGL(trunk_fwd, dim3(grid), dim3(NTHREADS), LDS_BYTES, stream, a);
#if MK_DEBUG_CHECKS
        if (L >= 0) {
          if (rec) {
            if (k == 0) chk_proj<<<dim3(8, NS), 256, 0, stream>>>(ws, id0 + 1, WS_XB, D, in[4] + (size_t)j * D * 2048, 2048, in[1] + L * D, D, 2048, WS_GX, 2048, 1);
            if (k == 1) chk_conv<<<dim3(4, NS), 256, 0, stream>>>(ws, id0 + 2, in[5] + (size_t)j * 4 * D, in[6] + (size_t)j * D);
            if (k == 2) chk_gates<<<dim3(4, NS), 256, 0, stream>>>(ws, id0 + 3, in[7] + (size_t)j * 4 * 65536, in[8] + (size_t)j * D, in[9] + (size_t)j * 4 * 65536, in[10] + (size_t)j * D);
            if (k == 3) chk_scan<<<2, 64, 0, stream>>>(ws, id0 + 4, in[11] + (size_t)j * D);
            if (k == 4) { chk_res<<<dim3(4, NS), 256, 0, stream>>>(ws, id0 + 5, WS_GX, 2048, in[12] + (size_t)j * D * D, D, outp, L == 0 ? in[0] : nullptr); chk_ssq<<<NS / 64, 64, 0, stream>>>(ws, id0 + 5, outp); }
            if (k == 5) chk_proj<<<dim3(16, NS), 256, 0, stream>>>(ws, id0 + 6, WS_XB, D, in[19] + (size_t)L * D * FF, FF, in[2] + L * D, D, FF, WS_H, FF, 2);
            if (k == 6) { chk_res<<<dim3(4, NS), 256, 0, stream>>>(ws, id0 + 7, WS_H, FF, in[20] + (size_t)L * FF * D, FF, outp, nullptr); chk_ssq<<<NS / 64, 64, 0, stream>>>(ws, id0 + 7, outp); }
          } else {
            if (k == 0) chk_att_in<<<dim3(11, NS), 256, 0, stream>>>(ws, id0 + 1, in[13] + (size_t)j * D * ATT_IN, in[15] + (size_t)j * 16 * 64 * 128, in[1] + L * D);
            if (k == 1) chk_cn<<<NS, 128, 0, stream>>>(ws, id0 + 2, in[14] + (size_t)j * 128);
            if (k == 3) { chk_att_o<<<dim3(4, NS), 256, 0, stream>>>(ws, in[16] + (size_t)j * 16 * 128 * 64); chk_att_out<<<dim3(4, NS), 256, 0, stream>>>(ws, id0 + 5, in[17] + (size_t)j * D * D, outp); chk_ssq<<<NS / 64, 64, 0, stream>>>(ws, id0 + 5, outp); }
            if (k == 4) chk_proj<<<dim3(16, NS), 256, 0, stream>>>(ws, id0 + 6, WS_XB, D, in[19] + (size_t)L * D * FF, FF, in[2] + L * D, D, FF, WS_H, FF, 2);
            if (k == 5) { chk_res<<<dim3(4, NS), 256, 0, stream>>>(ws, id0 + 7, WS_H, FF, in[20] + (size_t)L * FF * D, FF, outp, nullptr); chk_ssq<<<NS / 64, 64, 0, stream>>>(ws, id0 + 7, outp); }
          }
        }
#endif
    }
#if MK_DEBUG_CHECKS
    chk_report<<<1, 64, 0, stream>>>(ws, outp);
#endif
#endif
#else
    a.ph_lo = 0; a.ph_hi = N_PHASES;
    hipLaunchKernelGGL(trunk_fwd, dim3(grid), dim3(NTHREADS), LDS_BYTES, stream, a);
#endif
}
```

```cpp
#include <hip/hip_runtime.h>
#include <cstdio>
#include <cstdint>

#define LAS __attribute__((address_space(3)))
#define GAS __attribute__((address_space(1)))
typedef unsigned short bf16_t;
typedef short bf16x8 __attribute__((ext_vector_type(8)));
typedef short s16x4 __attribute__((ext_vector_type(4)));
typedef float f32x4 __attribute__((ext_vector_type(4)));
typedef float f32x2 __attribute__((ext_vector_type(2)));
typedef float f32x16 __attribute__((ext_vector_type(16)));
typedef unsigned u32x4 __attribute__((ext_vector_type(4)));
typedef unsigned u32x2 __attribute__((ext_vector_type(2)));
typedef unsigned short u16x4 __attribute__((ext_vector_type(4)));

constexpr int BATCH = 8, SEQ = 2048, D = 1024, M = BATCH * SEQ, DEPTH = 4, FF = 4096;
constexpr int H_ATT = 16, D_LAT = 128, H_IDX = 8, D_IDX = 64, TOPK = 256;
constexpr int ATT_IN = 1736;
constexpr int NATT = 2816;
constexpr int QC_C = 2048, QC_QI = 2176, QC_KI = 2688, QC_WI = 2752;
constexpr float EPS = 1e-6f;
constexpr int NWAVES = 8, NTHREADS = 512;

constexpr size_t MiB = 1u << 20;
constexpr size_t WS_CTL = 0, CTL_ZERO_BYTES = 128 * 1024;
constexpr int CW_HAND = 16384;
constexpr size_t WS_SSQ = 1 * MiB;
constexpr size_t WS_WMIX = 2 * MiB;
constexpr size_t WS_WUP = 12 * MiB, WS_WDOWN = 20 * MiB;
constexpr size_t WS_XB = 28 * MiB;
constexpr size_t WS_BIG = 60 * MiB;
constexpr size_t WS_H = WS_BIG;
constexpr size_t WS_GX = WS_BIG;
constexpr size_t WS_XC = WS_BIG + 64 * MiB;
constexpr size_t WS_RB = WS_BIG + 96 * MiB;
constexpr size_t WS_IB = WS_BIG + 128 * MiB;
constexpr size_t WS_QC = WS_BIG;
constexpr size_t WS_CN = WS_BIG + 88 * MiB;
constexpr size_t WS_IDX = WS_BIG + 92 * MiB;
constexpr size_t WS_WATT = WS_BIG + 160 * MiB;
constexpr size_t WS_SSQM = WS_WATT + 20 * MiB;
constexpr size_t WS_END = WS_SSQM + 1 * MiB;
constexpr size_t WM_REC_GATE = (size_t)2048 * 1024, WM_REC_OUT = WM_REC_GATE + (size_t)2048 * 1024;
constexpr size_t WM_ATT_COMB = (size_t)NATT * 1024;

constexpr int RING_BYTES = 131072;
constexpr int LDSCTL_OFF = RING_BYTES;
constexpr int LDS_BYTES = 163840;
constexpr int MISC_OFF = LDS_BYTES - 512;
constexpr int BSL_OFF = 132096;

#ifndef DBLMASK
#define DBLMASK 0u
#endif
#define DB(b) ((DBLMASK >> (b)) & 1u)
typedef __bf16 bf16x2_t __attribute__((ext_vector_type(2)));
__device__ __forceinline__ unsigned cvt_pk_bf16(float lo, float hi) { const f32x2 v = {lo, hi}; return __builtin_bit_cast(unsigned, __builtin_convertvector(v, bf16x2_t)); }
__device__ __forceinline__ float bf2f(unsigned h) { return __uint_as_float(h << 16); }
__device__ __forceinline__ float bflo(unsigned w) { return __uint_as_float(w << 16); }
__device__ __forceinline__ float bfhi(unsigned w) { return __uint_as_float(w & 0xffff0000u); }
__device__ __forceinline__ float wave_sum(float v) {
#pragma unroll
    for (int o = 1; o < 64; o <<= 1) v += __shfl_xor(v, o);
    return v;
}
#ifndef WT_STORES
#define WT_STORES 1
#endif
__device__ __forceinline__ void store16_wt(void* p, u32x4 v) {
#if WT_STORES
    asm volatile("global_store_dwordx4 %0, %1, off sc1\n\ts_nop 1" :: "v"(p), "v"(v) : "memory");
#else
    *(u32x4*)p = v;
#endif
}
#define LDS_WAIT() asm volatile("s_waitcnt lgkmcnt(0)" ::: "memory")
#define VM_WAIT() asm volatile("s_waitcnt vmcnt(0)" ::: "memory")

#define XB_TMO      128
#define XB_XCNT(j)  (256  + 64 * (j))
#define XB_XSUB(j)  (1280 + 64 * (j))
#define XB_XGEN(j)  (2304 + 64 * (j))
#define XB_TOP      3328
#define XB_TOPGEN   3392
#define XCD_BAR_WORDS 3456
#define XB_SPIN_CAP (1u << 22)
constexpr int CW_BAR = 4096;
static_assert((CW_BAR + XCD_BAR_WORDS) * 4 <= (int)CTL_ZERO_BYTES, "barrier words inside the memset region");

__device__ __forceinline__ unsigned xb_ld(unsigned* p)              { return __hip_atomic_load(p, __ATOMIC_RELAXED, __HIP_MEMORY_SCOPE_AGENT); }
__device__ __forceinline__ unsigned xb_add(unsigned* p, unsigned v) { return __hip_atomic_fetch_add(p, v, __ATOMIC_RELAXED, __HIP_MEMORY_SCOPE_AGENT); }
__device__ __forceinline__ unsigned xb_xcc_id() { return (unsigned)__builtin_amdgcn_s_getreg((3 << 11) | 20) & 0xFu; }
#define XB_SPIN(cond, bar) do { unsigned _sp = 0; while (cond) { __builtin_amdgcn_s_sleep(1); \
    if ((++_sp & 255u) == 0u) { if (xb_ld(&(bar)[XB_TMO])) break; if (_sp > XB_SPIN_CAP) { atomicAdd(&(bar)[XB_TMO], 1u); break; } } } } while (0)

struct XcdBarrier { unsigned* bar; unsigned x; volatile LAS unsigned* st; };

__device__ __forceinline__ XcdBarrier xcd_barrier_post(unsigned* bar, volatile LAS unsigned* st) {
    XcdBarrier b; b.bar = bar; b.x = xb_xcc_id(); b.st = st;
    if (threadIdx.x == 0) (void)xb_add(&bar[XB_XCNT(b.x)], 1u);
    return b;
}
__device__ __forceinline__ void xcd_barrier_complete(unsigned* bar, unsigned x, unsigned& nloc, unsigned& nx) {
    const unsigned G = gridDim.x * gridDim.y * gridDim.z;
    unsigned sum, cnt, mine, sp = 0u;
    for (;;) {
        sum = 0u; cnt = 0u; mine = 0u;
#pragma unroll
        for (unsigned j = 0; j < 16; ++j) { const unsigned c = xb_ld(&bar[XB_XCNT(j)]); sum += c; cnt += (c > 0u) ? 1u : 0u; mine = (j == x) ? c : mine; }
        if (sum == G) break;
        __builtin_amdgcn_s_sleep(1);
        if ((++sp & 255u) == 0u) { if (xb_ld(&bar[XB_TMO])) break; if (sp > XB_SPIN_CAP) { atomicAdd(&bar[XB_TMO], 1u); break; } }
    }
    nloc = mine > 0u ? mine : 1u; nx = cnt > 0u ? cnt : 1u;
}
__device__ __forceinline__ void xcd_barrier(const XcdBarrier& b) {
    asm volatile("s_waitcnt vmcnt(0)" ::: "memory");
    __syncthreads();
    if (threadIdx.x == 0) {
        unsigned* bar = b.bar;
        __builtin_amdgcn_s_waitcnt(0);
        unsigned nloc = b.st[0], nx = b.st[1];
        if (nloc == 0u) { xcd_barrier_complete(bar, b.x, nloc, nx); b.st[0] = nloc; b.st[1] = nx; }
        const unsigned old = xb_add(&bar[XB_XSUB(b.x)], 1u);
        const unsigned gen = old / nloc;
        if (old + 1u == (gen + 1u) * nloc) {
            __builtin_amdgcn_fence(__ATOMIC_RELEASE, "agent");
            asm volatile("s_waitcnt vmcnt(0)" ::: "memory");
            const unsigned og = xb_add(&bar[XB_TOP], 1u);
            const unsigned tg = og / nx;
            if (og + 1u == (tg + 1u) * nx) xb_add(&bar[XB_TOPGEN], 1u);
            else XB_SPIN(xb_ld(&bar[XB_TOPGEN]) == tg, bar);
            __builtin_amdgcn_fence(__ATOMIC_ACQUIRE, "agent");
            xb_add(&bar[XB_XGEN(b.x)], 1u);
            asm volatile("s_waitcnt vmcnt(0)" ::: "memory");
        } else {
            XB_SPIN(xb_ld(&bar[XB_XGEN(b.x)]) == gen, bar);
            __builtin_amdgcn_fence(__ATOMIC_ACQUIRE, "agent");
            asm volatile("s_waitcnt vmcnt(0)" ::: "memory");
        }
    }
    __syncthreads();
}

__device__ __forceinline__ unsigned long long ws_base_arg() { int k = 22; asm volatile("" : "+s"(k)); return ((const __attribute__((address_space(4))) unsigned long long*)__builtin_amdgcn_kernarg_segment_ptr())[k]; }
namespace pg8 {
constexpr int BM = 256, BK = 64, HALF = 128, HTB = HALF * BK * 2, NXCD = 8, WGM = 8;
__device__ __forceinline__ int lds_byte(int r, int c) { const int st = (r >> 4) * 2 + (c >> 5), rr = r & 15, cc = c & 31, ob = rr * 64 + cc * 2; return st * 1024 + (ob ^ (((ob >> 9) & 1) << 5)); }
__device__ __forceinline__ void stage_rc(int b, int& R, int& C) { const int st = b / 1024, sb = b % 1024, swz = sb ^ (((sb >> 9) & 1) << 5); R = (st >> 1) * 16 + swz / 64; C = (st & 1) * 32 + (swz % 64) / 2; }
__device__ __forceinline__ int perm32(int rho) { const int n = rho >> 4, i = rho & 15; return 8 * (i >> 2) + 4 * n + (i & 3); }

struct Unit { int pm, pn; };
struct Gemm { const bf16_t* A; const bf16_t* Bt; int lda, ldb, K, a_shift; };

template <bool WAITS, bool PUBLISHES> struct StaticOrderT {
    int nM, nN, nwg, G, c;
    __device__ void init(int Mr, int N, int G_, int c_) { nM = Mr / BM; nN = N / BM; nwg = nM * nN; G = G_; c = c_; }
    __device__ bool next(int i, Unit& u) const {
        const long L = (long)i * G + (c & 0xFFFF); if (L >= nwg) return false;
        int wgid = (int)L; { const int q = nwg / NXCD, r = nwg % NXCD, xcd = wgid % NXCD, off = wgid / NXCD; wgid = (xcd < r ? xcd * (q + 1) : r * (q + 1) + (xcd - r) * q) + off; }
        const int nig = WGM * nN, gid = wgid / nig, fm = gid * WGM, gsz = (nM - fm) < WGM ? (nM - fm) : WGM;
        u.pm = fm + ((wgid % nig) % gsz); u.pn = (wgid % nig) / gsz; return true;
    }
    const unsigned* ready = nullptr;
    __device__ __forceinline__ void a_ready(const Unit& u) const {
        if (!WAITS || ready == nullptr) return;
        if (threadIdx.x < 64) { unsigned sp = 0;
            while ((unsigned)__builtin_amdgcn_readfirstlane((int)__hip_atomic_load(ready + 16 * u.pm, __ATOMIC_RELAXED, __HIP_MEMORY_SCOPE_AGENT)) < 16u) {
                __builtin_amdgcn_s_sleep(1);
                if (++sp > (1u << 22)) break; }
            __builtin_amdgcn_fence(__ATOMIC_ACQUIRE, "agent");
            asm volatile("s_waitcnt vmcnt(0)" ::: "memory"); }
        asm volatile("" ::: "memory"); __builtin_amdgcn_s_barrier(); asm volatile("" ::: "memory");
    }
    __device__ __forceinline__ void publish() const {
        if (!PUBLISHES || (c >> 16) == 0) return;
        Unit u0; if (!next(0, u0)) return;
        if (threadIdx.x == 0) (void)__hip_atomic_fetch_add((unsigned*)(GAS unsigned*)ws_base_arg() + CW_HAND + ((c >> 16) - 1) * 1024 + 16 * u0.pm, (unsigned)((nwg >> 8) * (nN == 4 ? 4 : 1)), __ATOMIC_RELAXED, __HIP_MEMORY_SCOPE_AGENT);
    }
};
typedef StaticOrderT<false, false> StaticOrder;
struct GateOrder {
    int G, c;
    __device__ bool next(int i, Unit& u) const { const int p = c + (i >> 1) * G; if (p >= 256) return false; u.pm = p >> 2; u.pn = 4 * (i & 1) + (p & 3); return true; }
    __device__ __forceinline__ void a_ready(const Unit&) const {}
    __device__ __forceinline__ void publish() const {}
};

template <class Epi, class Sched>
__device__ __forceinline__ void gemm_phase(LAS unsigned char* lds, int tid, const Gemm g, const Sched& S, const Epi& E) {
    const int wid = __builtin_amdgcn_readfirstlane(tid >> 6), lane = tid & 63, wr = wid >> 2, wc = wid & 3, fr = lane & 15, fq = lane >> 4;
    int Kq = g.K; asm volatile("" : "+s"(Kq)); const int nt = Kq / BK;
    unsigned voffA[2], voffB[2];
#pragma unroll
    for (int i = 0; i < 2; ++i) { int R, C; stage_rc(tid * 16 + i * 8192, R, C); const int Rb = Epi::PERM ? ((R & ~31) + perm32(R & 31)) : R;
        voffA[i] = (unsigned)(R * g.lda + C) * 2u; voffB[i] = (unsigned)(Rb * g.ldb + C) * 2u; }
    const size_t kstep = (size_t)(BK * 2);
    const size_t hA = (size_t)HALF * g.lda * 2, hB = (size_t)HALF * g.ldb * 2;
    const size_t tA = 2 * hA, tB = 2 * hB;
    const unsigned ldsw = (unsigned)wid * 1024u;
    const int aoff = lds_byte(wr * 64 + fr, fq * 8), boff = lds_byte(wc * 32 + fr, fq * 8);
#define PG8_SA(b, h) (((b) * 2 + (h)) * HTB)
#define PG8_SB(b, h) ((4 + (b) * 2 + (h)) * HTB)
#define PG8_STAGE(bufoff, gbase, voff) do { _Pragma("unroll") for (int _i = 0; _i < 2; ++_i) \
        __builtin_amdgcn_global_load_lds((const unsigned*)((const char*)(gbase) + (voff)[_i]), (LAS unsigned*)(lds + (bufoff) + ldsw + _i * 8192), 16, 0, 0); } while (0)
#define PG8_LDA(dst, b, h) do { _Pragma("unroll") for (int m = 0; m < 4; ++m) _Pragma("unroll") for (int k = 0; k < 2; ++k) dst[m][k] = *(const LAS bf16x8*)(lds + PG8_SA(b, h) + aoff + m * 2048 + k * 1024); } while (0)
#define PG8_LDB(dst, b, h) do { _Pragma("unroll") for (int n = 0; n < 2; ++n) _Pragma("unroll") for (int k = 0; k < 2; ++k) dst[n][k] = *(const LAS bf16x8*)(lds + PG8_SB(b, h) + boff + n * 2048 + k * 1024); } while (0)
#define PG8_MMA(ai, bj, At, Bt) do { __builtin_amdgcn_s_setprio(1); _Pragma("unroll") for (int m = 0; m < 4; ++m) _Pragma("unroll") for (int n = 0; n < 2; ++n) _Pragma("unroll") for (int k = 0; k < 2; ++k) \
        acc[ai][bj][m][n] = __builtin_amdgcn_mfma_f32_16x16x32_bf16(Bt[n][k], At[m][k], acc[ai][bj][m][n], 0, 0, 0); __builtin_amdgcn_s_setprio(0); } while (0)
#define PG8_WAIT_V(n) asm volatile("s_waitcnt vmcnt(" #n ")" ::: "memory")
#define PG8_WAIT_L(n) asm volatile("s_waitcnt lgkmcnt(" #n ")" ::: "memory")
#define PG8_BAR __builtin_amdgcn_s_barrier()
#define PG8_SCHED __builtin_amdgcn_sched_barrier(0)
#define PG8_ABASE(u) ((const char*)g.A + (size_t)(u).pm * tA + (g.a_shift >= 0 ? (size_t)(((u).pn & g.a_shift) * 512) : (size_t)0))
#define PG8_BBASE(u) ((const char*)g.Bt + (size_t)(u).pn * tB + (g.a_shift >= 0 ? (size_t)(((u).pn & g.a_shift) * 512) : (size_t)0))
    Unit cur, nxt; int ui = 0;
    if (!S.next(0, cur)) return;
    S.a_ready(cur);
    f32x4 acc[2][2][4][2];
#pragma unroll
    for (int a = 0; a < 2; ++a)
#pragma unroll
        for (int b = 0; b < 2; ++b)
#pragma unroll
            for (int m = 0; m < 4; ++m)
#pragma unroll
                for (int n = 0; n < 2; ++n) acc[a][b][m][n] = (f32x4){0.f, 0.f, 0.f, 0.f};
    bf16x8 At[4][2], B0[2][2], B1[2][2];
    float rsv[2][4];
#pragma unroll
    for (int a = 0; a < 2; ++a)
#pragma unroll
        for (int m = 0; m < 4; ++m) rsv[a][m] = 1.0f;
    const char* cA = PG8_ABASE(cur); const char* cB = PG8_BBASE(cur);
    if (Epi::HAS_PRE) { f32x4 part[2][4]; E.pre_load(cur, wr, fr, fq, part);
        PG8_STAGE(PG8_SB(0, 0), cB, voffB); PG8_STAGE(PG8_SB(0, 1), cB + hB, voffB); PG8_STAGE(PG8_SA(0, 0), cA, voffA); PG8_STAGE(PG8_SA(0, 1), cA + hA, voffA);
        if (wr == 1) PG8_BAR;
        PG8_WAIT_V(2); PG8_BAR;
        E.pre_reduce(part, rsv);
    } else {
    PG8_STAGE(PG8_SB(0, 0), cB, voffB); PG8_STAGE(PG8_SB(0, 1), cB + hB, voffB); PG8_STAGE(PG8_SA(0, 0), cA, voffA); PG8_STAGE(PG8_SA(0, 1), cA + hA, voffA);
    if (wr == 1) PG8_BAR;
    PG8_WAIT_V(2); PG8_BAR; }
    PG8_STAGE(PG8_SB(1, 0), cB + kstep, voffB); PG8_STAGE(PG8_SA(1, 0), cA + kstep, voffA); PG8_STAGE(PG8_SB(1, 1), cB + hB + kstep, voffB);
    PG8_WAIT_V(6); PG8_BAR;
    for (;;) {
        const bool has_next = S.next(ui + 1, nxt);
        const char* nA = has_next ? PG8_ABASE(nxt) : cA; const char* nB = has_next ? PG8_BBASE(nxt) : cB;
        for (int t = 0; t < nt; t += 2) {
            const bool last = (t == nt - 2);
            const char* a1 = cA + (size_t)(t + 1) * kstep;
            const char* a2 = last ? nA : cA + (size_t)(t + 2) * kstep; const char* b2 = last ? nB : cB + (size_t)(t + 2) * kstep;
            const char* a3 = a2 + kstep; const char* b3 = b2 + kstep;
            PG8_LDB(B0, 0, 0); PG8_LDB(B1, 0, 1); PG8_SCHED; PG8_LDA(At, 0, 0); PG8_STAGE(PG8_SA(1, 1), a1 + hA, voffA);
            PG8_WAIT_V(8); PG8_WAIT_L(0); PG8_BAR; PG8_MMA(0, 0, At, B0); PG8_MMA(0, 1, At, B1); PG8_BAR; PG8_SCHED;
            PG8_LDA(At, 0, 1); PG8_STAGE(PG8_SB(0, 0), b2, voffB); PG8_STAGE(PG8_SB(0, 1), b2 + hB, voffB); PG8_STAGE(PG8_SA(0, 0), a2, voffA);
            PG8_WAIT_V(8); PG8_WAIT_L(0); PG8_BAR; PG8_MMA(1, 0, At, B0); PG8_MMA(1, 1, At, B1); PG8_BAR; PG8_SCHED;
            PG8_LDB(B0, 1, 0); PG8_LDB(B1, 1, 1); PG8_SCHED; PG8_LDA(At, 1, 0); PG8_STAGE(PG8_SA(0, 1), a2 + hA, voffA);
            PG8_WAIT_V(8); PG8_WAIT_L(0); PG8_BAR; PG8_MMA(0, 0, At, B0); PG8_MMA(0, 1, At, B1); PG8_BAR; PG8_SCHED;
            PG8_LDA(At, 1, 1); PG8_STAGE(PG8_SB(1, 0), b3, voffB); PG8_STAGE(PG8_SB(1, 1), b3 + hB, voffB); PG8_STAGE(PG8_SA(1, 0), a3, voffA);
            PG8_WAIT_V(8); PG8_WAIT_L(0); PG8_BAR; PG8_MMA(1, 0, At, B0); PG8_MMA(1, 1, At, B1); PG8_BAR; PG8_SCHED;
        }
        if (wr == 0) PG8_BAR;
        E(acc, cur, wr, wc, fr, fq, rsv);
        if (!has_next) break;
#pragma unroll
        for (int a = 0; a < 2; ++a)
#pragma unroll
            for (int b = 0; b < 2; ++b)
#pragma unroll
                for (int m = 0; m < 4; ++m)
#pragma unroll
                    for (int n = 0; n < 2; ++n) acc[a][b][m][n] = (f32x4){0.f, 0.f, 0.f, 0.f};
        cur = nxt; cA = nA; cB = nB; ++ui;
        if (Epi::HAS_PRE) { f32x4 part[2][4]; E.pre_load(cur, wr, fr, fq, part); E.pre_reduce(part, rsv); }
        if (wr == 1) PG8_BAR;
    }
    PG8_WAIT_V(0);
    PG8_BAR;
    S.publish();
#undef PG8_SA
#undef PG8_SB
#undef PG8_STAGE
#undef PG8_LDA
#undef PG8_LDB
#undef PG8_MMA
#undef PG8_WAIT_V
#undef PG8_WAIT_L
#undef PG8_BAR
#undef PG8_SCHED
#undef PG8_ABASE
#undef PG8_BBASE
}

__device__ __forceinline__ float row_rs(const float* ssq, int row) {
    const f32x4* p = (const f32x4*)(ssq + (size_t)row * 16); const f32x4 a = p[0], b = p[1], c = p[2], d = p[3];
    const float s = ((a.x + a.y) + (a.z + a.w)) + ((b.x + b.y) + (b.z + b.w)) + ((c.x + c.y) + (c.z + c.w)) + ((d.x + d.y) + (d.z + d.w));
    return rsqrtf(s * (1.0f / 1024.0f) + EPS);
}
__device__ __forceinline__ float gelu_tanh(float v) {
    const float u = 1.5957691216f * (v + 0.044715f * v * v * v);
    return v * __builtin_amdgcn_rcpf(1.0f + __builtin_amdgcn_exp2f(-1.44269504089f * u));
}
__device__ __forceinline__ float sigmoidf_(float z) { return __builtin_amdgcn_rcpf(1.0f + __builtin_amdgcn_exp2f(-1.44269504089f * z)); }

template <int MODE> struct EpiScale {
    static constexpr bool PERM = true;
    static constexpr bool HAS_PRE = (MODE != 2);
    bf16_t* O; int ldc; const float* ssq;
    __device__ __forceinline__ void pre_load(const Unit& u, int wr, int fr, int fq, f32x4 (&part)[2][4]) const {
        const int row0 = u.pm * BM + wr * 64 + fr;
#pragma unroll
        for (int ai = 0; ai < 2; ++ai)
#pragma unroll
            for (int m = 0; m < 4; ++m) part[ai][m] = *(const f32x4*)(ssq + (size_t)(row0 + ai * HALF + m * 16) * 16 + 4 * fq);
    }
    __device__ __forceinline__ void pre_reduce(const f32x4 (&part)[2][4], float (&rsv)[2][4]) const {
#pragma unroll
        for (int ai = 0; ai < 2; ++ai)
#pragma unroll
            for (int m = 0; m < 4; ++m) { float t = (part[ai][m].x + part[ai][m].y) + (part[ai][m].z + part[ai][m].w); t += __shfl_xor(t, 16); t += __shfl_xor(t, 32); rsv[ai][m] = rsqrtf(t * (1.0f / 1024.0f) + EPS); }
    }
    __device__ __forceinline__ void operator()(const f32x4 (&acc)[2][2][4][2], const Unit& u, int wr, int wc, int fr, int fq, const float (&rsv)[2][4]) const {
        const int row0 = u.pm * BM + wr * 64 + fr, col0 = u.pn * BM + wc * 32 + 8 * fq;
        const bool act = (MODE == 1) && (u.pn < 4);
#pragma unroll
        for (int ai = 0; ai < 2; ++ai)
#pragma unroll
            for (int m = 0; m < 4; ++m) { const int row = row0 + ai * HALF + m * 16; const float rs = rsv[ai][m]; bf16_t* rowp = O + (size_t)row * ldc + col0;
#pragma unroll
                for (int bj = 0; bj < 2; ++bj) { f32x4 v0 = acc[ai][bj][m][0], v1 = acc[ai][bj][m][1];
                    if (MODE != 2) { v0 = v0 * rs; v1 = v1 * rs; }
                    if (MODE == 1) { if (act) {
#pragma unroll
                        for (int e = 0; e < 4; ++e) { v0[e] = gelu_tanh(v0[e]); v1[e] = gelu_tanh(v1[e]); } } }
                    if (MODE == 2) {
#pragma unroll
                        for (int e = 0; e < 4; ++e) { const float a = fmaxf(v0[e], 0.f), b = fmaxf(v1[e], 0.f); v0[e] = a * a; v1[e] = b * b; } }
                    u32x4 w; w.x = cvt_pk_bf16(v0[0], v0[1]); w.y = cvt_pk_bf16(v0[2], v0[3]); w.z = cvt_pk_bf16(v1[0], v1[1]); w.w = cvt_pk_bf16(v1[2], v1[3]);
                    store16_wt(rowp + bj * HALF, w); } }
    }
};
struct EpiGate {
    static constexpr bool PERM = true;
    static constexpr bool HAS_PRE = false;
    bf16_t* R; bf16_t* I; const float* ba; const float* bx;
    __device__ __forceinline__ void pre_load(const Unit&, int, int, int, f32x4 (&)[2][4]) const {}
    __device__ __forceinline__ void pre_reduce(const f32x4 (&)[2][4], float (&)[2][4]) const {}
    __device__ __forceinline__ void operator()(const f32x4 (&acc)[2][2][4][2], const Unit& u, int wr, int wc, int fr, int fq, const float (&)[2][4]) const {
        const int which = u.pn >> 2, blk = u.pn & 3;
        bf16_t* O = which ? I : R; const float* bias = which ? bx : ba;
        const int row0 = u.pm * BM + wr * 64 + fr, col0 = blk * BM + wc * 32 + 8 * fq;
#pragma unroll
        for (int bj = 0; bj < 2; ++bj) {
            const f32x4 bv0 = *(const f32x4*)(bias + col0 + bj * HALF), bv1 = *(const f32x4*)(bias + col0 + bj * HALF + 4);
#pragma unroll
            for (int ai = 0; ai < 2; ++ai)
#pragma unroll
                for (int m = 0; m < 4; ++m) { bf16_t* rowp = O + (size_t)(row0 + ai * HALF + m * 16) * D + col0;
                    f32x4 v0 = acc[ai][bj][m][0] + bv0, v1 = acc[ai][bj][m][1] + bv1;
#pragma unroll
                    for (int e = 0; e < 4; ++e) { v0[e] = sigmoidf_(v0[e]); v1[e] = sigmoidf_(v1[e]); }
                    u32x4 w; w.x = cvt_pk_bf16(v0[0], v0[1]); w.y = cvt_pk_bf16(v0[2], v0[3]); w.z = cvt_pk_bf16(v1[0], v1[1]); w.w = cvt_pk_bf16(v1[2], v1[3]);
                    store16_wt(rowp + bj * HALF, w); }
        }
    }
};
template <bool SCALE> struct EpiRes {
    static constexpr bool PERM = true;
    static constexpr bool HAS_PRE = false;
    bf16_t* xb; float* ssq; const float* ssq_in;
    __device__ __forceinline__ void pre_load(const Unit&, int, int, int, f32x4 (&)[2][4]) const {}
    __device__ __forceinline__ void pre_reduce(const f32x4 (&)[2][4], float (&)[2][4]) const {}
    __device__ __forceinline__ void operator()(const f32x4 (&acc)[2][2][4][2], const Unit& u, int wr, int wc, int fr, int fq, const float (&)[2][4]) const {
        const int col0 = u.pn * BM + wc * 32 + 8 * fq;
        u32x4 o[2][4][2];
#define EPIRES_LOAD(ai) do { _Pragma("unroll") for (int m = 0; m < 4; ++m) { const size_t off_ = (size_t)(u.pm * BM + (ai) * HALF + wr * 64 + m * 16 + fr) * D + col0; \
            _Pragma("unroll") for (int bj = 0; bj < 2; ++bj) o[ai][m][bj] = *(const u32x4*)(xb + off_ + bj * HALF); } } while (0)
        if (!SCALE) { EPIRES_LOAD(0); EPIRES_LOAD(1); }
#pragma unroll
        for (int ai = 0; ai < 2; ++ai) {
            f32x4 part_[4];
            if (SCALE) {
#pragma unroll
                for (int m = 0; m < 4; ++m) part_[m] = *(const f32x4*)(ssq_in + (size_t)(u.pm * BM + ai * HALF + wr * 64 + m * 16 + fr) * 16 + 4 * fq);
                if (ai == 0) EPIRES_LOAD(0); else EPIRES_LOAD(1); }
#pragma unroll
            for (int m = 0; m < 4; ++m) { const int row = u.pm * BM + ai * HALF + wr * 64 + m * 16 + fr; const size_t off = (size_t)row * D + col0; float part = 0.f;
                float rs2 = 1.0f;
                if (SCALE) { float t = (part_[m].x + part_[m].y) + (part_[m].z + part_[m].w); t += __shfl_xor(t, 16); t += __shfl_xor(t, 32); rs2 = __builtin_amdgcn_rcpf(t * (1.0f / 1024.0f) + EPS); }
#pragma unroll
                for (int bj = 0; bj < 2; ++bj) { const u32x4 xo = o[ai][m][bj]; f32x4 a0 = acc[ai][bj][m][0], a1 = acc[ai][bj][m][1];
                    if (SCALE) { a0 = a0 * rs2; a1 = a1 * rs2; }
                    const float v0 = bflo(xo.x) + a0[0], v1 = bfhi(xo.x) + a0[1], v2 = bflo(xo.y) + a0[2], v3 = bfhi(xo.y) + a0[3];
                    const float v4 = bflo(xo.z) + a1[0], v5 = bfhi(xo.z) + a1[1], v6 = bflo(xo.w) + a1[2], v7 = bfhi(xo.w) + a1[3];
                    u32x4 w; w.x = cvt_pk_bf16(v0, v1); w.y = cvt_pk_bf16(v2, v3); w.z = cvt_pk_bf16(v4, v5); w.w = cvt_pk_bf16(v6, v7); store16_wt(xb + off + bj * HALF, w);
                    part += ((v0 * v0 + v1 * v1) + (v2 * v2 + v3 * v3)) + ((v4 * v4 + v5 * v5) + (v6 * v6 + v7 * v7)); }
                part += __shfl_xor(part, 16); part += __shfl_xor(part, 32);
                if (fq == 0) __hip_atomic_store((GAS unsigned*)(ssq + (size_t)row * 16 + u.pn * 4 + wc), __float_as_uint(part), __ATOMIC_RELAXED, __HIP_MEMORY_SCOPE_AGENT); }
            asm volatile("" ::: "memory");
        }
#undef EPIRES_LOAD
    }
};
}

struct Args { const float* in[21]; float* out; unsigned char* ws; int ph_lo, ph_hi; };
static_assert(sizeof(Args) == 21 * 8 + 8 + 8 + 8, "Args has no padding");

struct Frame {
    LAS unsigned char* lds;
    int tid, lane, wave, G, vcu, bid;
};
__device__ __forceinline__ Frame launder(const Frame& F0) {
    Frame F = F0; int t = F0.tid, w = F0.wave, g = F0.G, v = F0.vcu, b = F0.bid;
    asm volatile("" : "+v"(t)); asm volatile("" : "+s"(w)); asm volatile("" : "+s"(g)); asm volatile("" : "+s"(v)); asm volatile("" : "+s"(b));
    F.tid = t; F.lane = t & 63; F.wave = w; F.G = g; F.vcu = v; F.bid = b; return F;
}

__device__ __forceinline__ void cvt_item(const float* W, int ldw, const float* gamma, float scale, bf16_t* Bt, int ldb, int nblk, int nvalid, LAS float* scr, int item, int lane) {
    const int kb = item / nblk, nb = item % nblk, k0 = 64 * kb, n0 = 32 * nb;
    const int nn = lane & 31; const bool ok = (n0 + nn) < nvalid;
    if (n0 + 32 <= nvalid && ((((size_t)W) | ((size_t)ldw * 4u)) & 15u) == 0) {
        const int c4 = (lane & 7) * 4, r8 = lane >> 3; f32x4 v[8];
#pragma unroll
        for (int i = 0; i < 8; ++i) v[i] = __builtin_nontemporal_load((const f32x4*)(W + (size_t)(k0 + 8 * i + r8) * ldw + n0 + c4));
#pragma unroll
        for (int i = 0; i < 8; ++i) { const int kk = 8 * i + r8; const float gs = (gamma ? gamma[k0 + kk] : 1.0f) * scale; LAS float* d = scr + kk * 33 + c4;
            d[0] = v[i].x * gs; d[1] = v[i].y * gs; d[2] = v[i].z * gs; d[3] = v[i].w * gs; }
    } else
#pragma unroll 8
    for (int i = 0; i < 32; ++i) { const int kk = 2 * i + (lane >> 5); float v = ok ? __builtin_nontemporal_load(W + (size_t)(k0 + kk) * ldw + n0 + nn) : 0.f;     v *= (gamma ? gamma[k0 + kk] : 1.0f) * scale; scr[kk * 33 + nn] = v; }
    LDS_WAIT(); asm volatile("" ::: "memory");
    const int c = lane & 7;
#pragma unroll
    for (int j = 0; j < 4; ++j) { const int n = (lane >> 3) + 8 * j; const LAS float* s = scr + (8 * c) * 33 + n;
        u32x4 o; o.x = cvt_pk_bf16(s[0 * 33], s[1 * 33]); o.y = cvt_pk_bf16(s[2 * 33], s[3 * 33]); o.z = cvt_pk_bf16(s[4 * 33], s[5 * 33]); o.w = cvt_pk_bf16(s[6 * 33], s[7 * 33]);
        store16_wt(Bt + (size_t)(n0 + n) * ldb + k0 + 8 * c, o); }
    LDS_WAIT(); asm volatile("" ::: "memory");
}
__device__ __forceinline__ bf16x8 pack8(const f32x4 a, const f32x4 b) { const u32x4 w = {cvt_pk_bf16(a.x, a.y), cvt_pk_bf16(a.z, a.w), cvt_pk_bf16(b.x, b.y), cvt_pk_bf16(b.z, b.w)}; return __builtin_bit_cast(bf16x8, w); }
__device__ __forceinline__ void qlat_item(const float* Win, const float* wuk, const float* gamma, float scale, bf16_t* Bt, int item, int chalf, int lane) {
    const int h = item >> 4, k0 = (item & 15) << 6, cb = 64 * chalf, fr = lane & 15, fq = lane >> 4;
    bf16x8 X[4][2], Y[4][2];
    { f32x4 xa[4][2], xb[4][2]; float gs[4];
#pragma unroll
      for (int kt = 0; kt < 4; ++kt) { const int k = k0 + 16 * kt + fr; gs[kt] = gamma[k] * scale; const f32x4* p = (const f32x4*)(Win + (size_t)k * ATT_IN + h * 64 + 8 * fq);
#pragma unroll
          for (int s_ = 0; s_ < 2; ++s_) { xa[kt][s_] = p[8 * s_]; xb[kt][s_] = p[8 * s_ + 1]; } }
#pragma unroll
      for (int kt = 0; kt < 4; ++kt)
#pragma unroll
          for (int s_ = 0; s_ < 2; ++s_) X[kt][s_] = pack8(xa[kt][s_] * gs[kt], xb[kt][s_] * gs[kt]); }
#pragma unroll
    for (int ct = 0; ct < 4; ++ct)
#pragma unroll
        for (int s_ = 0; s_ < 2; ++s_) { const float* p = wuk + (size_t)h * 64 * 128 + (size_t)(32 * s_ + 8 * fq) * 128 + cb + 16 * ct + fr;
            const f32x4 ya = {p[0], p[128], p[256], p[384]}, yb = {p[512], p[640], p[768], p[896]}; Y[ct][s_] = pack8(ya, yb); }
#pragma unroll
    for (int ct = 0; ct < 4; ++ct)
#pragma unroll
        for (int kt = 0; kt < 4; ++kt) { f32x4 acc = {0.f, 0.f, 0.f, 0.f};
#pragma unroll
            for (int s_ = 0; s_ < 2; ++s_) acc = __builtin_amdgcn_mfma_f32_16x16x32_bf16(X[kt][s_], Y[ct][s_], acc, 0, 0, 0);
            u32x2 o; o.x = cvt_pk_bf16(acc[0], acc[1]); o.y = cvt_pk_bf16(acc[2], acc[3]);
            *(u32x2*)(Bt + (size_t)(h * 128 + cb + 16 * ct + fr) * D + k0 + 16 * kt + 4 * fq) = o; }
}
__device__ __forceinline__ void comb_item(const float* wuv, const float* wo, bf16_t* Bt, int item, int chalf, int lane) {
    const int h = item >> 4, n0 = (item & 15) << 6, cb = 64 * chalf, fr = lane & 15, fq = lane >> 4;
    bf16x8 X[4][2], Y[4][2];
#pragma unroll
    for (int ct = 0; ct < 4; ++ct) { const f32x4* p = (const f32x4*)(wuv + (size_t)h * 128 * 64 + (size_t)(cb + 16 * ct + fr) * 64 + 8 * fq);
#pragma unroll
        for (int s_ = 0; s_ < 2; ++s_) X[ct][s_] = pack8(p[8 * s_], p[8 * s_ + 1]); }
#pragma unroll
    for (int nt = 0; nt < 4; ++nt)
#pragma unroll
        for (int s_ = 0; s_ < 2; ++s_) { const float* p = wo + (size_t)(h * 64 + 32 * s_ + 8 * fq) * D + n0 + 16 * nt + fr;
            const f32x4 ya = {p[0], p[D], p[2 * D], p[3 * D]}, yb = {p[4 * D], p[5 * D], p[6 * D], p[7 * D]}; Y[nt][s_] = pack8(ya, yb); }
#pragma unroll
    for (int nt = 0; nt < 4; ++nt)
#pragma unroll
        for (int ct = 0; ct < 4; ++ct) { f32x4 acc = {0.f, 0.f, 0.f, 0.f};
#pragma unroll
            for (int s_ = 0; s_ < 2; ++s_) acc = __builtin_amdgcn_mfma_f32_16x16x32_bf16(X[ct][s_], Y[nt][s_], acc, 0, 0, 0);
            u32x2 o; o.x = cvt_pk_bf16(acc[0], acc[1]); o.y = cvt_pk_bf16(acc[2], acc[3]);
            *(u32x2*)(Bt + (size_t)(n0 + 16 * nt + fr) * 2048 + h * 128 + cb + 16 * ct + 4 * fq) = o; }
}

struct Ptrs {
    const float* in[21]; float* out; unsigned char* ws;
};
__device__ __forceinline__ unsigned long long argq(int k) {
    asm volatile("" : "+s"(k));
    return ((const __attribute__((address_space(4))) unsigned long long*)__builtin_amdgcn_kernarg_segment_ptr())[k];
}
__device__ __forceinline__ Ptrs load_ptrs() {
    Ptrs P;
#pragma unroll
    for (int i = 0; i < 21; ++i) P.in[i] = (const float*)(GAS const float*)argq(i);
    P.out = (float*)(GAS float*)argq(21); P.ws = (unsigned char*)(GAS unsigned char*)argq(22);
    return P;
}

__device__ __forceinline__ void cvt_rec_mix(const Frame& F, const Ptrs& P, int j, int L) {
    LAS float* scr = (LAS float*)(F.lds + F.wave * 16384);
    bf16_t* WM = (bf16_t*)(P.ws + WS_WMIX);
    const int gw = F.vcu * NWAVES + F.wave, NGW = F.G * NWAVES;
    constexpr int I_IN = 16 * 64, I_G = 4 * 8, I_OUT = 16 * 32, I_Z = 8 * 3 * 8;
    constexpr int NITEMS = I_IN + 8 * I_G + I_OUT + I_Z;
    for (int it = gw; it < NITEMS; it += NGW) {
        int r = it;
        if (r < I_IN) { cvt_item(P.in[4] + (size_t)j * D * 2048, 2048, P.in[1] + L * D, 1.f, WM, D, 64, 2048, scr, r, F.lane); continue; } r -= I_IN;
        if (r < 8 * I_G) { const int blk = r / (2 * I_G), which = (r / I_G) & 1, ri = r % I_G;
            cvt_item(P.in[which ? 9 : 7] + (size_t)(j * 4 + blk) * 65536, 256, nullptr, 1.f, WM + WM_REC_GATE + (size_t)(which * 1024 + blk * 256) * D + blk * 256, D, 8, 256, scr, ri, F.lane); continue; } r -= 8 * I_G;
        if (r < I_OUT) { cvt_item(P.in[12] + (size_t)j * D * D, D, nullptr, 1.f, WM + WM_REC_OUT, D, 32, D, scr, r, F.lane); continue; } r -= I_OUT;
        {
            const int rb = r / 24, cbi = (r / 8) % 3, piece = r & 7, blk = rb & 3, cb = cbi + (cbi >= blk ? 1 : 0);
            bf16_t* z = WM + WM_REC_GATE + (size_t)(rb * 256 + piece * 32) * D + cb * 256;
#pragma unroll
            for (int q = 0; q < 16; ++q) { const int e = q * 64 + F.lane, rr = e >> 5, cc = (e & 31) * 8; *(u32x4*)(z + (size_t)rr * D + cc) = (u32x4){0u, 0u, 0u, 0u}; }
        }
    }
}
__device__ __forceinline__ void cvt_att_mix(const Frame& F, const Ptrs& P, int j, int L, int rot = 0) {
    LAS float* scr = (LAS float*)(F.lds + F.wave * 16384);
    bf16_t* WM = (bf16_t*)(P.ws + WS_WATT + (size_t)j * 10 * MiB);
    const int NGW = F.G * NWAVES, gw = (F.vcu * NWAVES + F.wave + NGW - rot) % NGW;
    const float* Win = P.in[13] + (size_t)j * D * ATT_IN; const float* gam = P.in[1] + L * D;
    constexpr int I_H = 512, I_C = 16 * 22, I_W = 16 * 2;
    constexpr int NITEMS = 2 * I_H + I_C + I_W;
    for (int it = gw; it < NITEMS; it += NGW) {
        int r = it;
        if (r < I_H) { qlat_item(Win, P.in[15] + (size_t)j * 16 * 64 * 128, gam, 0.125f, WM, r >> 1, r & 1, F.lane); continue; } r -= I_H;
        if (r < I_H) { comb_item(P.in[16] + (size_t)j * 16 * 128 * 64, P.in[17] + (size_t)j * D * D, WM + WM_ATT_COMB, r >> 1, r & 1, F.lane); continue; } r -= I_H;
        if (r < I_C) { cvt_item(Win + 1024, ATT_IN, gam, 1.f, WM + (size_t)2048 * D, D, 22, 704, scr, r, F.lane); continue; } r -= I_C;
        cvt_item(Win + 1728, ATT_IN, gam, 0.044194173824159216f, WM + (size_t)2752 * D, D, 2, 8, scr, r, F.lane);
    }
}
__device__ __forceinline__ void cvt_up(const Frame& F, const Ptrs& P, int L) {
    LAS float* scr = (LAS float*)(F.lds + F.wave * 16384);
    const int gw = F.vcu * NWAVES + F.wave, NGW = F.G * NWAVES;
    for (int it = gw; it < 16 * 128; it += NGW) cvt_item(P.in[19] + (size_t)L * D * FF, FF, P.in[2] + L * D, 1.f, (bf16_t*)(P.ws + WS_WUP), D, 128, FF, scr, it, F.lane);
}
__device__ __forceinline__ void cvt_down(const Frame& F, const Ptrs& P, int L) {
    LAS float* scr = (LAS float*)(F.lds + F.wave * 16384);
    const int gw = F.vcu * NWAVES + F.wave, NGW = F.G * NWAVES;
    for (int it = gw; it < 64 * 32; it += NGW) cvt_item(P.in[20] + (size_t)L * FF * D, D, nullptr, 1.f, (bf16_t*)(P.ws + WS_WDOWN), FF, 32, D, scr, it, F.lane);
}

__device__ __forceinline__ void p0_rows(const Frame& F, const Ptrs& P) {
    const int gw = F.vcu * NWAVES + F.wave, NGW = F.G * NWAVES;
    bf16_t* XB = (bf16_t*)(P.ws + WS_XB); float* SSQ = (float*)(P.ws + WS_SSQ);
    for (int m = gw; m < M; m += NGW) {
        const f32x4* xr = (const f32x4*)(P.in[0] + (size_t)m * D) + F.lane; float s = 0.f; f32x4 v[4];
#pragma unroll
        for (int jj = 0; jj < 4; ++jj) { v[jj] = __builtin_nontemporal_load(xr + 64 * jj); s += (v[jj].x * v[jj].x + v[jj].y * v[jj].y) + (v[jj].z * v[jj].z + v[jj].w * v[jj].w); }
        s = wave_sum(s);
        u32x2* o = (u32x2*)(XB + (size_t)m * D) + F.lane;
#pragma unroll
        for (int jj = 0; jj < 4; ++jj) { u32x2 w; w.x = cvt_pk_bf16(v[jj].x, v[jj].y); w.y = cvt_pk_bf16(v[jj].z, v[jj].w); o[64 * jj] = w; }
        if (F.lane < 16) SSQ[(size_t)m * 16 + F.lane] = (F.lane == 0) ? s : 0.f;
    }
}
__device__ __forceinline__ void final_norm(const Frame& F, const Ptrs& P, bool dry = false) {
    const int gw = F.vcu * NWAVES + F.wave, NGW = F.G * NWAVES;
    const float* SSQ = (const float*)(P.ws + WS_SSQ); const f32x4* g = (const f32x4*)P.in[3] + F.lane; const bf16_t* XB = (const bf16_t*)(P.ws + WS_XB);
    for (int m = gw; m < M; m += NGW) {
        f32x4* xr = (f32x4*)(P.out + (size_t)m * D) + F.lane; const u32x2* xi = (const u32x2*)(XB + (size_t)m * D) + F.lane; const float rs = pg8::row_rs(SSQ, m);
#pragma unroll
        for (int jj = 0; jj < 4; ++jj) { const u32x2 xv = xi[64 * jj]; const f32x4 v = {bflo(xv.x), bfhi(xv.x), bflo(xv.y), bfhi(xv.y)}; const f32x4 gg = g[64 * jj]; const f32x4 w = v * rs * gg; __builtin_nontemporal_store(dry ? v : w, xr + 64 * jj); }
    }
}
__device__ __forceinline__ void conv_tile(const Frame& F, const Ptrs& P, int j, int pm, int blk) {
    const bf16_t* GX = (const bf16_t*)(P.ws + WS_GX); bf16_t* XC = (bf16_t*)(P.ws + WS_XC);
    const int cp = F.tid & 127, rq = F.tid >> 7, ch = blk * 256 + 2 * cp, r0 = pm * 256 + rq * 64;
    const float* cw = P.in[5] + (size_t)j * 4 * D + ch; const float* cb = P.in[6] + (size_t)j * D + ch;
    const f32x2 w0 = *(const f32x2*)(cw), w1 = *(const f32x2*)(cw + D), w2 = *(const f32x2*)(cw + 2 * D), w3 = *(const f32x2*)(cw + 3 * D), bb = *(const f32x2*)cb;
    const unsigned* xr = (const unsigned*)(GX + (size_t)r0 * 2048 + 1024 + ch);
    unsigned x0 = 0u, x1 = 0u, x2 = 0u;
    if ((r0 & (SEQ - 1)) != 0) { x0 = xr[-3 * 1024]; x1 = xr[-2 * 1024]; x2 = xr[-1 * 1024]; }
    unsigned* xo = (unsigned*)(XC + (size_t)r0 * D + ch);
    for (int tb = 0; tb < 64; tb += 16) {
        unsigned xin[16];
#pragma unroll
        for (int q = 0; q < 16; ++q) xin[q] = xr[(size_t)(tb + q) * 1024];
#pragma unroll
        for (int q = 0; q < 16; ++q) {
            const unsigned x3 = xin[q];
            const float a = bb.x + w0.x * bflo(x0) + w1.x * bflo(x1) + w2.x * bflo(x2) + w3.x * bflo(x3);
            const float b = bb.y + w0.y * bfhi(x0) + w1.y * bfhi(x1) + w2.y * bfhi(x2) + w3.y * bfhi(x3);
            xo[(size_t)(tb + q) * 512] = cvt_pk_bf16(a, b);
            x0 = x1; x1 = x2; x2 = x3;
        }
    }
}

__device__ __forceinline__ void scan_phase(const Frame& F, const Ptrs& P, int j, bool dry = false) {
    LAS float* sA = (LAS float*)F.lds; LAS float* sH = sA + 32 * 32; LAS unsigned* sU = (LAS unsigned*)(F.lds + 16384);
    bf16_t* GX = (bf16_t*)(P.ws + WS_GX); const bf16_t* XC = (const bf16_t*)(P.ws + WS_XC);
    const bf16_t* RB = (const bf16_t*)(P.ws + WS_RB); const bf16_t* IB = (const bf16_t*)(P.ws + WS_IB);
    const int c2 = F.tid & 15, chunk = F.tid >> 4;
    for (int u = F.vcu; u < BATCH * 32; u += F.G) {
        const int b = u >> 5, cg = u & 31, ch = cg * 32 + 2 * c2; const size_t row0 = (size_t)b * SEQ + chunk * 64;
        const f32x2 lam = *(const f32x2*)(P.in[11] + (size_t)j * D + ch);
        const float sp0 = -8.0f * log1pf(expf(-lam.x)), sp1 = -8.0f * log1pf(expf(-lam.y));
        const unsigned* rp = (const unsigned*)(RB + row0 * D + ch); const unsigned* ip = (const unsigned*)(IB + row0 * D + ch); const unsigned* xp = (const unsigned*)(XC + row0 * D + ch);
        float A0 = 1.f, A1 = 1.f, h0 = 0.f, h1 = 0.f;
        constexpr int SB = 16;
        unsigned rn[SB], in_[SB], xn[SB];
#pragma unroll
        for (int q = 0; q < SB; ++q) { rn[q] = rp[(size_t)q * 512]; in_[q] = ip[(size_t)q * 512]; xn[q] = xp[(size_t)q * 512]; }
        for (int tb = 0; tb < 64; tb += SB) {
            unsigned rr[SB], ii[SB], xx[SB];
#pragma unroll
            for (int q = 0; q < SB; ++q) { rr[q] = rn[q]; ii[q] = in_[q]; xx[q] = xn[q]; }
            if (tb + SB < 64) {
#pragma unroll
                for (int q = 0; q < SB; ++q) { rn[q] = rp[(size_t)(tb + SB + q) * 512]; in_[q] = ip[(size_t)(tb + SB + q) * 512]; xn[q] = xp[(size_t)(tb + SB + q) * 512]; } }
#pragma unroll
            for (int q = 0; q < SB; ++q) { const unsigned r = rr[q], i = ii[q], x = xx[q];
                const float a0 = __expf(sp0 * bflo(r)), a1 = __expf(sp1 * bfhi(r));
                const float u0 = sqrtf(fmaxf(fmaf(-a0, a0, 1.0f), 0.f)) * (bflo(i) * bflo(x)), u1 = sqrtf(fmaxf(fmaf(-a1, a1, 1.0f), 0.f)) * (bfhi(i) * bfhi(x));
                A0 *= a0; A1 *= a1; h0 = fmaf(a0, h0, u0); h1 = fmaf(a1, h1, u1);
                sU[(tb + q) * 512 + F.tid] = cvt_pk_bf16(u0, u1); }
        }
        unsigned* gp = (unsigned*)(GX + row0 * 2048 + ch);
        unsigned gn[SB];
#pragma unroll
        for (int q = 0; q < SB; ++q) { rn[q] = rp[(size_t)q * 512]; gn[q] = gp[(size_t)q * 1024]; }
        sA[chunk * 32 + 2 * c2] = A0; sA[chunk * 32 + 2 * c2 + 1] = A1; sH[chunk * 32 + 2 * c2] = h0; sH[chunk * 32 + 2 * c2 + 1] = h1;
        __syncthreads();
        h0 = 0.f; h1 = 0.f;
        for (int k = 0; k < chunk; ++k) { h0 = fmaf(sA[k * 32 + 2 * c2], h0, sH[k * 32 + 2 * c2]); h1 = fmaf(sA[k * 32 + 2 * c2 + 1], h1, sH[k * 32 + 2 * c2 + 1]); }
        for (int tb = 0; tb < 64; tb += SB) {
            unsigned rr[SB], gg[SB];
#pragma unroll
            for (int q = 0; q < SB; ++q) { rr[q] = rn[q]; gg[q] = gn[q]; }
            if (tb + SB < 64) {
#pragma unroll
                for (int q = 0; q < SB; ++q) { rn[q] = rp[(size_t)(tb + SB + q) * 512]; gn[q] = gp[(size_t)(tb + SB + q) * 1024]; } }
#pragma unroll
            for (int q = 0; q < SB; ++q) { const unsigned r = rr[q], gt = gg[q], uu = sU[(tb + q) * 512 + F.tid];
                const float a0 = __expf(sp0 * bflo(r)), a1 = __expf(sp1 * bfhi(r));
                const float u0 = bflo(uu), u1 = bfhi(uu);
                h0 = fmaf(a0, h0, u0); h1 = fmaf(a1, h1, u1);
                gp[(size_t)(tb + q) * 1024] = dry ? gt : cvt_pk_bf16(h0 * bflo(gt), h1 * bfhi(gt)); }
        }
        __syncthreads();
    }
}

__device__ __forceinline__ unsigned f2key(float f) { const unsigned u = __float_as_uint(f + 0.0f); return u ^ ((unsigned)((int)u >> 31) | 0x80000000u); }
__device__ __forceinline__ int wave_sum_dpp(int x) {
    x += __builtin_amdgcn_update_dpp(0, x, 0x111, 0xF, 0xF, false);
    x += __builtin_amdgcn_update_dpp(0, x, 0x112, 0xF, 0xF, false);
    x += __builtin_amdgcn_update_dpp(0, x, 0x114, 0xF, 0xF, false);
    x += __builtin_amdgcn_update_dpp(0, x, 0x118, 0xF, 0xF, false);
    x += __builtin_amdgcn_update_dpp(0, x, 0x142, 0xA, 0xF, false);
    x += __builtin_amdgcn_update_dpp(0, x, 0x143, 0xC, 0xF, false);
    return __builtin_amdgcn_readlane(x, 63);
}
__device__ __forceinline__ float wave_sum_f32_dpp(float v) {
#define WSF_STEP(ctrl, rmask) v += __int_as_float(__builtin_amdgcn_update_dpp(0, __float_as_int(v), ctrl, rmask, 0xF, false))
    WSF_STEP(0x111, 0xF); WSF_STEP(0x112, 0xF); WSF_STEP(0x114, 0xF); WSF_STEP(0x118, 0xF); WSF_STEP(0x142, 0xA); WSF_STEP(0x143, 0xC);
#undef WSF_STEP
    return __int_as_float(__builtin_amdgcn_readlane(__float_as_int(v), 63));
}
__device__ __forceinline__ int wave_scan_dpp(int x) {
    x += __builtin_amdgcn_update_dpp(0, x, 0x111, 0xF, 0xF, false);
    x += __builtin_amdgcn_update_dpp(0, x, 0x112, 0xF, 0xF, false);
    x += __builtin_amdgcn_update_dpp(0, x, 0x114, 0xF, 0xF, false);
    x += __builtin_amdgcn_update_dpp(0, x, 0x118, 0xF, 0xF, false);
    x += __builtin_amdgcn_update_dpp(0, x, 0x142, 0xA, 0xF, false);
    x += __builtin_amdgcn_update_dpp(0, x, 0x143, 0xC, 0xF, false);
    return x;
}
template <int NR>
__device__ __forceinline__ void idx_select(const LAS float* scq, int pos, int lane, const LAS unsigned char* bkL, unsigned short* out) {
    unsigned keys[NR];
#pragma unroll
    for (int jj = 0; jj < NR; ++jj) { const int idx = lane + 64 * jj; const float v = scq[idx]; keys[jj] = (idx <= pos) ? f2key(v) : 0u; }
    unsigned T = 0u; bool exact = false; int cl_last = 0;
    for (int bit = 31; bit >= 0; --bit) {
        const unsigned cand = (unsigned)__builtin_amdgcn_readfirstlane((int)(T | (1u << bit)));
        unsigned c0 = 0, c1 = 0, c2 = 0, c3 = 0;
#define IDX_CMP4(a_, b_, c_, d_) "v_cmp_ge_u32_e64 %4, %" #a_ ", %[cd]\n\tv_cmp_ge_u32_e64 %5, %" #b_ ", %[cd]\n\tv_cmp_ge_u32_e64 %6, %" #c_ ", %[cd]\n\tv_cmp_ge_u32_e64 %7, %" #d_ ", %[cd]\n\t" \
                                 "v_addc_co_u32_e64 %0, %4, 0, %0, %4\n\tv_addc_co_u32_e64 %1, %5, 0, %1, %5\n\tv_addc_co_u32_e64 %2, %6, 0, %2, %6\n\tv_addc_co_u32_e64 %3, %7, 0, %3, %7\n\t"
#pragma unroll
        for (int jj = 0; jj < NR; jj += 8) { unsigned long long m0, m1, m2, m3;
            asm volatile(IDX_CMP4(8, 9, 10, 11) IDX_CMP4(12, 13, 14, 15)
                         : "+v"(c0), "+v"(c1), "+v"(c2), "+v"(c3), "=&s"(m0), "=&s"(m1), "=&s"(m2), "=&s"(m3)
                         : "v"(keys[jj]), "v"(keys[jj + 1]), "v"(keys[jj + 2]), "v"(keys[jj + 3]), "v"(keys[jj + 4]), "v"(keys[jj + 5]), "v"(keys[jj + 6]), "v"(keys[jj + 7]), [cd] "s"(cand)); }
#undef IDX_CMP4
        cl_last = (int)((c0 + c1) + (c2 + c3));
        const int cnt = wave_sum_dpp(cl_last);
        if (cnt >= TOPK) T = cand;
        if (cnt == TOPK) { exact = true; break; }
    }
    if (exact) {
        int k = wave_scan_dpp(cl_last) - cl_last;
#pragma unroll
        for (int jj = 0; jj < NR; ++jj) {
            const bool sel = keys[jj] >= T;
            if (sel) { const int idx = lane + 64 * jj; const int dist = pos - idx; const unsigned bk = dist >= 128 ? 31u : (unsigned)bkL[dist]; out[k] = (unsigned short)(idx | (bk << 11)); }
            k += sel ? 1 : 0;
        }
        return;
    }
    int cgt = 0;
#pragma unroll
    for (int jj = 0; jj < NR; ++jj) cgt += __builtin_popcountll(__builtin_amdgcn_ballot_w64(keys[jj] > T));
    const int need = TOPK - cgt; int obase = 0, ebase = 0;
#pragma unroll
    for (int jj = 0; jj < NR; ++jj) {
        const bool gt = keys[jj] > T, eq = keys[jj] == T;
        const unsigned long long em = __builtin_amdgcn_ballot_w64(eq);
        const int erank = ebase + (int)__builtin_amdgcn_mbcnt_hi((unsigned)(em >> 32), __builtin_amdgcn_mbcnt_lo((unsigned)em, 0u));
        const bool sel = gt || (eq && erank < need);
        const unsigned long long sm = __builtin_amdgcn_ballot_w64(sel);
        const int opos = obase + (int)__builtin_amdgcn_mbcnt_hi((unsigned)(sm >> 32), __builtin_amdgcn_mbcnt_lo((unsigned)sm, 0u));
        if (sel) { const int idx = lane + 64 * jj; const int dist = pos - idx; const unsigned bk = dist >= 128 ? 31u : (unsigned)bkL[dist]; out[opos] = (unsigned short)(idx | (bk << 11)); }
        obase += __builtin_popcountll(sm); ebase += __builtin_popcountll(em);
    }
}
__device__ __forceinline__ void index_phase(const Frame& F, const Ptrs& P, int j) {
    LAS float* scb = (LAS float*)F.lds;
    LAS float* wiB = (LAS float*)(F.lds + 131072);
    LAS unsigned char* bkL = (LAS unsigned char*)(F.lds + 131072 + 4096);
    const bf16_t* QC = (const bf16_t*)(P.ws + WS_QC); bf16_t* CN = (bf16_t*)(P.ws + WS_CN); unsigned short* IDX = (unsigned short*)(P.ws + WS_IDX);
    const int lane = F.lane, w = F.wave, half = lane >> 5;
    if (F.tid < 128) { const int n = F.tid; int bk = n; if (n >= 16) { bk = 16 + (int)(logf((float)n / 16.0f) / 2.0794415416798357f * 16.0f); bk = bk > 31 ? 31 : bk; } bkL[n] = (unsigned char)bk; }
    __syncthreads();
    const int nunits = M / 8;
    const int ar = lane & 31, ahalf_r = (ar >> 2) & 1, areg_r = (ar & 3) + 4 * (ar >> 3), aq = 2 * ahalf_r + (areg_r >> 3), ah = areg_r & 7;
#define IDX_UNIT(i_) (((i_) * F.G < nunits) ? ((i_) * F.G + (((i_) & 1) ? (F.G - 1 - F.vcu) : F.vcu)) : -1)
#define IDX_OK(u_) ((u_) >= 0 && (u_) < nunits)
#define IDX_FETCH(u_, A_, cw_, wi_) do { const int T0_ = (u_) * 8; \
        cw_ = *(const unsigned*)(QC + ((size_t)T0_ + w) * NATT + QC_C + 2 * lane); \
        wi_ = QC[(size_t)(T0_ + (lane >> 3)) * NATT + QC_WI + (lane & 7)]; \
        _Pragma("unroll") for (int g = 0; g < 2; ++g) { const bf16_t* p_ = QC + (size_t)(T0_ + 4 * g + aq) * NATT + QC_QI + ah * 64 + 32 * half; \
            _Pragma("unroll") for (int s = 0; s < 4; ++s) A_[g][s] = *(const bf16x8*)(p_ + 8 * s); } } while (0)
#define IDX_SCORE(u_, par_, unext_) do { const int T0 = (u_) * 8, b = T0 >> 11, p0 = T0 & (SEQ - 1); \
        LAS float* sc = scb + (par_) * 16384; LAS float* wiL = wiB + ((par_) * 8 + w) * 64; \
        bf16x8 Af[2][4]; \
        _Pragma("unroll") for (int g = 0; g < 2; ++g) _Pragma("unroll") for (int s = 0; s < 4; ++s) Af[g][s] = An[g][s]; \
        const unsigned cw = cwn; wiL[lane] = bf2f(win); \
        if (IDX_OK(unext_)) IDX_FETCH(unext_, An, cwn, win); \
        { const size_t tok = (size_t)T0 + w; const float c0 = bflo(cw), c1 = bfhi(cw); \
          const float ss = wave_sum_f32_dpp(c0 * c0 + c1 * c1); const float rs = rsqrtf(ss * (1.0f / 128.0f) + EPS); const f32x2 gg = gg_lat; \
          *(unsigned*)(CN + tok * 128 + 2 * lane) = cvt_pk_bf16(c0 * rs * gg.x, c1 * rs * gg.y); } \
        LDS_WAIT(); asm volatile("" ::: "memory"); \
        const int nkt = (p0 + 8 + 31) >> 5; \
        for (int kt0 = w; kt0 < nkt; kt0 += 16) { \
            bf16x8 Bf[2][4]; \
            _Pragma("unroll") for (int bi = 0; bi < 2; ++bi) { const int kt = kt0 + 8 * bi; if (kt < nkt) { const bf16_t* kp = QC + ((size_t)b * SEQ + 32 * kt + (lane & 31)) * NATT + QC_KI + 32 * half; \
                _Pragma("unroll") for (int s4 = 0; s4 < 4; ++s4) Bf[bi][s4] = *(const bf16x8*)(kp + 8 * s4); } } \
            _Pragma("unroll") for (int bi = 0; bi < 2; ++bi) { const int kt = kt0 + 8 * bi; if (kt < nkt) { const int key = 32 * kt + (lane & 31); \
                _Pragma("unroll") for (int g = 0; g < 2; ++g) { \
                    f32x16 acc; \
                    _Pragma("unroll") for (int e = 0; e < 16; ++e) acc[e] = 0.f; \
                    _Pragma("unroll") for (int s4 = 0; s4 < 4; ++s4) acc = __builtin_amdgcn_mfma_f32_32x32x16_bf16(Af[g][s4], Bf[bi][s4], acc, 0, 0, 0); \
                    _Pragma("unroll") for (int e = 0; e < 2; ++e) { float sv = 0.f; const f32x4 wlo = *(const LAS f32x4*)(wiL + (4 * g + 2 * half + e) * 8), whi = *(const LAS f32x4*)(wiL + (4 * g + 2 * half + e) * 8 + 4); \
                        _Pragma("unroll") for (int h = 0; h < 4; ++h) { sv = fmaf(wlo[h], fmaxf(acc[8 * e + h], 0.f), sv); sv = fmaf(whi[h], fmaxf(acc[8 * e + 4 + h], 0.f), sv); } \
                        const int qi = 4 * g + 2 * half + e; \
                        sc[qi * 2048 + key] = (key <= p0 + qi) ? sv : -INFINITY; } \
                } } } \
        } } while (0)
    const f32x2 gg_lat = *(const f32x2*)(P.in[14] + (size_t)j * 128 + 2 * lane);
    bf16x8 An[2][4]; unsigned cwn = 0u; unsigned short win = 0;
    { const int u0 = IDX_UNIT(0); if (IDX_OK(u0)) { IDX_FETCH(u0, An, cwn, win); const int u1 = IDX_UNIT(1); IDX_SCORE(u0, 0, u1); } }
    __syncthreads();
    for (int i = 0;; ++i) {
        const int u = IDX_UNIT(i); if (u < 0) break;
        if (IDX_OK(u)) {
            const int T0 = u * 8, p0 = T0 & (SEQ - 1); const LAS float* sc = scb + (i & 1) * 16384;
            const int pos = p0 + w, n = pos + 1; unsigned short* out = IDX + (size_t)(T0 + w) * 256;
            if (n <= TOPK) {
#pragma unroll
                for (int jj = 0; jj < 4; ++jj) { const int s = lane + 64 * jj; const int dist = pos - s; const unsigned bk = (dist >= 0) ? (dist >= 128 ? 31u : (unsigned)bkL[dist]) : 0u;
                    out[s] = (s < n) ? (unsigned short)(s | (bk << 11)) : (unsigned short)0; }
            } else {
                const LAS float* scq = sc + w * 2048;
                if (n <= 512) idx_select<8>(scq, pos, lane, bkL, out); else if (n <= 1024) idx_select<16>(scq, pos, lane, bkL, out);
                else if (n <= 1536) idx_select<24>(scq, pos, lane, bkL, out); else idx_select<32>(scq, pos, lane, bkL, out);
            }
        }
        { const int un = IDX_UNIT(i + 1); if (IDX_OK(un)) { const int un2 = IDX_UNIT(i + 2); IDX_SCORE(un, (i + 1) & 1, un2); } }
        __syncthreads();
    }
#undef IDX_UNIT
#undef IDX_OK
#undef IDX_FETCH
#undef IDX_SCORE
}

__device__ __forceinline__ s16x4 tr_read(const LAS unsigned char* p) {
    typedef short v4i16_t __attribute__((ext_vector_type(4)));
    return __builtin_bit_cast(s16x4, __builtin_amdgcn_ds_read_tr16_b64_v4i16((LAS v4i16_t*)p));
}
struct AttState { float mrun, lrun; f32x4 O[8]; };
__device__ __forceinline__ float xmax16(float v) { const auto r = __builtin_amdgcn_permlane16_swap(__float_as_uint(v), __float_as_uint(v), false, false); return fmaxf(__uint_as_float(r[0]), __uint_as_float(r[1])); }
__device__ __forceinline__ float xmax32(float v) { const auto r = __builtin_amdgcn_permlane32_swap(__float_as_uint(v), __float_as_uint(v), false, false); return fmaxf(__uint_as_float(r[0]), __uint_as_float(r[1])); }
__device__ __forceinline__ float xsum16(float v) { const auto r = __builtin_amdgcn_permlane16_swap(__float_as_uint(v), __float_as_uint(v), false, false); return __uint_as_float(r[0]) + __uint_as_float(r[1]); }
__device__ __forceinline__ float xsum32(float v) { const auto r = __builtin_amdgcn_permlane32_swap(__float_as_uint(v), __float_as_uint(v), false, false); return __uint_as_float(r[0]) + __uint_as_float(r[1]); }
__device__ __forceinline__ void att_stage(const bf16x8 (&cf)[16], LAS unsigned char* V, int lane) {
    constexpr int VROW = 288;
#pragma unroll
    for (int i = 0; i < 16; ++i) *(LAS bf16x8*)(V + (16 * (lane >> 4) + i) * VROW + (lane & 15) * 16) = cf[i];
    asm volatile("" ::: "memory");
}
__device__ __forceinline__ void att_qk(const bf16x8 (&qf)[4], f32x4 (&S)[4], const LAS unsigned char* V, int lane, int g) {
    constexpr int VROW = 288;
    const LAS unsigned char* ab = V + (lane & 15) * VROW + 16 * g;
#pragma unroll
    for (int t = 0; t < 4; ++t) { S[t] = (f32x4){0.f, 0.f, 0.f, 0.f};
#pragma unroll
        for (int ks = 0; ks < 4; ++ks) { const bf16x8 af = *(const LAS bf16x8*)(ab + 16 * t * VROW + 64 * ks); S[t] = __builtin_amdgcn_mfma_f32_16x16x32_bf16(af, qf[ks], S[t], 0, 0, 0); } }
}
template <bool MASKED>
__device__ __forceinline__ void att_sm_pv(const f32x4 (&S)[4], int s, int cnt, AttState& st, const LAS unsigned short* listL, const LAS float* biasL, const LAS unsigned char* trbase, int head, int g) {
    constexpr int VROW = 288; constexpr float L2E = 1.44269504089f;
    float val[4][4]; float cmax = -INFINITY;
#pragma unroll
    for (int t = 0; t < 4; ++t) { const u16x4 pk4 = *(const LAS u16x4*)(listL + 64 * s + 16 * t + 4 * g);
#pragma unroll
        for (int r = 0; r < 4; ++r) { const float bias = *(const LAS float*)((const LAS unsigned char*)biasL + ((pk4[r] >> 5) & 0x7C0u) + head * 4);
            float v = S[t][r] + bias; if (MASKED) v = (64 * s + 16 * t + 4 * g + r < cnt) ? v : -INFINITY; val[t][r] = v; cmax = fmaxf(cmax, v); } }
    cmax = xmax32(xmax16(cmax));
    const float mnew = fmaxf(st.mrun, cmax), mneg = -mnew * L2E;
    const float alpha = __builtin_amdgcn_exp2f(fmaf(st.mrun, L2E, mneg));
    float p[4][4]; float psum = 0.f;
#pragma unroll
    for (int t = 0; t < 4; ++t)
#pragma unroll
        for (int r = 0; r < 4; ++r) { p[t][r] = __builtin_amdgcn_exp2f(fmaf(val[t][r], L2E, mneg)); psum += p[t][r]; }
    psum = xsum32(xsum16(psum));
    const bool moved = __builtin_amdgcn_ballot_w64(mnew > st.mrun) != 0ull;
    st.lrun = st.lrun * alpha + psum; st.mrun = mnew;
    if (moved) {
#pragma unroll
        for (int dt = 0; dt < 8; ++dt) st.O[dt] = st.O[dt] * alpha; }
    union { bf16x8 v; unsigned u[4]; } pf[2];
#pragma unroll
    for (int hh = 0; hh < 2; ++hh) { pf[hh].u[0] = cvt_pk_bf16(p[2 * hh][0], p[2 * hh][1]); pf[hh].u[1] = cvt_pk_bf16(p[2 * hh][2], p[2 * hh][3]); pf[hh].u[2] = cvt_pk_bf16(p[2 * hh + 1][0], p[2 * hh + 1][1]); pf[hh].u[3] = cvt_pk_bf16(p[2 * hh + 1][2], p[2 * hh + 1][3]); }
#pragma unroll
    for (int dt = 0; dt < 8; ++dt)
#pragma unroll
        for (int hh = 0; hh < 2; ++hh) {
            union { bf16x8 v; s16x4 h[2]; } vf;
            vf.h[0] = tr_read(trbase + hh * 32 * VROW + dt * 32); vf.h[1] = tr_read(trbase + (hh * 32 + 16) * VROW + dt * 32);
            st.O[dt] = __builtin_amdgcn_mfma_f32_16x16x32_bf16(vf.v, pf[hh].v, st.O[dt], 0, 0, 0);
        }
    asm volatile("" ::: "memory");
}
__device__ __forceinline__ void attn_phase(const Frame& F, const Ptrs& P, bool dry = false) {
    constexpr int VROW = 288, VBYTES = 64 * VROW;
    LAS unsigned char* V = F.lds + F.wave * VBYTES;
    LAS unsigned short* listB = (LAS unsigned short*)(F.lds + 8 * VBYTES + F.wave * 1024);
    LAS float* biasL = (LAS float*)(F.lds + 8 * VBYTES + 8 * 1024);
    static_assert(8 * VBYTES + 8 * 1024 + 2048 <= MISC_OFF, "attention LDS map");
    bf16_t* QC = (bf16_t*)(P.ws + WS_QC); const bf16_t* CN = (const bf16_t*)(P.ws + WS_CN); const unsigned short* IDX = (const unsigned short*)(P.ws + WS_IDX);
    const int lane = F.lane, head = lane & 15, g = lane >> 4;
    if (F.tid < 512) biasL[F.tid] = P.in[18][F.tid];
    __syncthreads();
    const int gw = F.vcu * NWAVES + F.wave, NGW = F.G * NWAVES;
    const int trq = (lane & 15) >> 2, trp = lane & 3;
    const LAS unsigned char* trbase = V + (4 * g + trq) * VROW + 8 * trp;
#define ATT_LOAD(buf, ss, listL, cnb) do { const u32x4 l0_ = *(const LAS u32x4*)(listL + 64 * (ss) + 16 * (lane >> 4)), l1_ = *(const LAS u32x4*)(listL + 64 * (ss) + 16 * (lane >> 4) + 8); \
        _Pragma("unroll") for (int i = 0; i < 16; ++i) { const unsigned w_ = (i < 8) ? l0_[(i & 7) >> 1] : l1_[(i & 7) >> 1]; const unsigned pk = (i & 1) ? (w_ >> 16) : (w_ & 0xffffu); \
            buf[i] = *(const bf16x8*)(cnb + (((pk & 2047u) << 8) + (unsigned)(lane & 15) * 16u)); } } while (0)
#define ATT_TOKEN(k_) ((k_) * NGW + ((gw + 256 * (k_)) % NGW))
    unsigned long long lstn = 0ull; bf16x8 qfn[4]; bf16x8 cf[16];
    if (ATT_TOKEN(0) < M) { const int t0_ = ATT_TOKEN(0); lstn = *(const unsigned long long*)(IDX + (size_t)t0_ * 256 + 4 * lane); const bf16_t* qp = QC + (size_t)t0_ * NATT + head * 128 + 8 * g;
#pragma unroll
        for (int ks = 0; ks < 4; ++ks) qfn[ks] = *(const bf16x8*)(qp + 32 * ks);
        asm volatile("" ::: "memory");
        *(LAS unsigned long long*)(listB + 4 * lane) = lstn;
        asm volatile("" ::: "memory");
        const char* cnb0 = (const char*)(CN + (size_t)__builtin_amdgcn_readfirstlane(t0_ >> 11) * SEQ * 128);
        ATT_LOAD(cf, 0, listB, cnb0); }
    for (int kr = 0; kr * NGW < M; ++kr) {
        const int token = ATT_TOKEN(kr); if (token >= M) break;
        const int b = token >> 11, pos = token & (SEQ - 1), cnt = pos + 1 < TOPK ? pos + 1 : TOPK, nstep = (cnt + 63) >> 6;
        LAS unsigned short* listL = listB + (kr & 1) * 256;
        bf16x8 qf[4];
#pragma unroll
        for (int ks = 0; ks < 4; ++ks) qf[ks] = qfn[ks];
        const char* cnb = (const char*)(CN + (size_t)__builtin_amdgcn_readfirstlane(b) * SEQ * 128);
        const int nt_ = ((kr + 1) * NGW < M) ? ATT_TOKEN(kr + 1) : M;
        if (nt_ < M) { lstn = *(const unsigned long long*)(IDX + (size_t)nt_ * 256 + 4 * lane); const bf16_t* qp = QC + (size_t)nt_ * NATT + head * 128 + 8 * g;
#pragma unroll
            for (int ks = 0; ks < 4; ++ks) qfn[ks] = *(const bf16x8*)(qp + 32 * ks); }
        AttState st; st.mrun = -INFINITY; st.lrun = 0.f;
#pragma unroll
        for (int dt = 0; dt < 8; ++dt) st.O[dt] = (f32x4){0.f, 0.f, 0.f, 0.f};
        for (int s = 0; s < nstep; ++s) {
            f32x4 S[4];
            att_stage(cf, V, lane);
            if (s + 1 < nstep) ATT_LOAD(cf, s + 1, listL, cnb);
            else if (nt_ < M) {
                LAS unsigned short* ln = listB + ((kr + 1) & 1) * 256;
                asm volatile("" ::: "memory");
                *(LAS unsigned long long*)(ln + 4 * lane) = lstn;
                asm volatile("" ::: "memory");
                const char* cnbn = (const char*)(CN + (size_t)__builtin_amdgcn_readfirstlane(nt_ >> 11) * SEQ * 128);
                ATT_LOAD(cf, 0, ln, cnbn); }
            att_qk(qf, S, V, lane, g);
            if (64 * (s + 1) > cnt) att_sm_pv<true>(S, s, cnt, st, listL, biasL, trbase, head, g); else att_sm_pv<false>(S, s, cnt, st, listL, biasL, trbase, head, g);
        }
        const float inv = 1.0f / st.lrun;
        bf16_t* op = QC + (size_t)token * NATT + head * 128 + 4 * g;
        if (dry) { asm volatile("" :: "v"(st.O[0]), "v"(st.O[7]), "v"(inv)); bf16_t* qp = QC + (size_t)token * NATT + head * 128 + 8 * g;
#pragma unroll
            for (int ks = 0; ks < 4; ++ks) *(bf16x8*)(qp + 32 * ks) = qf[ks]; continue; }
#pragma unroll
        for (int dt = 0; dt < 8; ++dt) { u32x2 wv; wv.x = cvt_pk_bf16(st.O[dt][0] * inv, st.O[dt][1] * inv); wv.y = cvt_pk_bf16(st.O[dt][2] * inv, st.O[dt][3] * inv); *(u32x2*)(op + 16 * dt) = wv; }
    }
#undef ATT_LOAD
#undef ATT_TOKEN
}


#ifndef NAIVE_IDX
#define NAIVE_IDX 0
#endif
#ifndef NAIVE_ATT
#define NAIVE_ATT 0
#endif
__device__ __forceinline__ void naive_index_phase(const Frame& F, const Ptrs& P, int j) {
    LAS float* sc = (LAS float*)F.lds;
    LAS float* qiL = sc + 2048;
    LAS float* wL = qiL + 512;
    LAS int* cntL = (LAS int*)(wL + 8);
    LAS unsigned char* bkL = (LAS unsigned char*)(cntL + 520);
    const bf16_t* QC = (const bf16_t*)(P.ws + WS_QC); bf16_t* CN = (bf16_t*)(P.ws + WS_CN); unsigned short* IDX = (unsigned short*)(P.ws + WS_IDX);
    const int tid = F.tid;
    if (tid < 128) { const int n = tid; int bk = n; if (n >= 16) { bk = 16 + (int)(logf((float)n / 16.0f) / 2.0794415416798357f * 16.0f); bk = bk > 31 ? 31 : bk; } bkL[n] = (unsigned char)bk; }
    __syncthreads();
    for (int tok = F.vcu; tok < M; tok += F.G) {
        const int b = tok >> 11, pos = tok & (SEQ - 1), n = pos + 1;
        if (tid < 64) {
            const unsigned cw = *(const unsigned*)(QC + (size_t)tok * NATT + QC_C + 2 * tid); const float c0 = bflo(cw), c1 = bfhi(cw);
            const float ss = wave_sum(c0 * c0 + c1 * c1); const float rs = rsqrtf(ss * (1.0f / 128.0f) + EPS); const float* g = P.in[14] + (size_t)j * 128 + 2 * tid;
            *(unsigned*)(CN + (size_t)tok * 128 + 2 * tid) = cvt_pk_bf16(c0 * rs * g[0], c1 * rs * g[1]);
        }
        qiL[tid] = bf2f(QC[(size_t)tok * NATT + QC_QI + tid]);
        if (tid < 8) wL[tid] = bf2f(QC[(size_t)tok * NATT + QC_WI + tid]);
        __syncthreads();
        for (int key = tid; key < SEQ; key += NTHREADS) {
            float s = -INFINITY;
            if (key <= pos) { const bf16_t* kp = QC + ((size_t)b * SEQ + key) * NATT + QC_KI; s = 0.f;
                for (int h = 0; h < 8; ++h) { float d = 0.f; for (int e = 0; e < 64; ++e) d = fmaf(qiL[h * 64 + e], bf2f(kp[e]), d); s = fmaf(wL[h], fmaxf(d, 0.f), s); }
                s = s + 0.0f; }
            sc[key] = s;
        }
        __syncthreads();
        unsigned short* out = IDX + (size_t)tok * 256;
        if (n <= TOPK) { if (tid < 256) { const int dist = pos - tid; const unsigned bk = (dist >= 0) ? (dist >= 128 ? 31u : (unsigned)bkL[dist]) : 0u; out[tid] = (tid < n) ? (unsigned short)(tid | (bk << 11)) : (unsigned short)0; } }
        else {
            bool sel[4]; int mycnt = 0;
            for (int e = 0; e < 4; ++e) { const int i = tid * 4 + e; sel[e] = false;
                if (i <= pos) { const float si = sc[i]; int rank = 0; for (int jx = 0; jx <= pos; ++jx) { const float sj = sc[jx]; rank += (sj > si || (sj == si && jx < i)) ? 1 : 0; } sel[e] = rank < TOPK; }
                mycnt += sel[e] ? 1 : 0; }
            cntL[tid] = mycnt;
            __syncthreads();
            int basep = 0; for (int t2 = 0; t2 < tid; ++t2) basep += cntL[t2];
            for (int e = 0; e < 4; ++e) if (sel[e]) { const int i = tid * 4 + e; const int dist = pos - i; const unsigned bk = dist >= 128 ? 31u : (unsigned)bkL[dist]; out[basep++] = (unsigned short)(i | (bk << 11)); }
        }
        __syncthreads();
    }
}
__device__ __forceinline__ void naive_attn_phase(const Frame& F, const Ptrs& P) {
    bf16_t* QC = (bf16_t*)(P.ws + WS_QC); const bf16_t* CN = (const bf16_t*)(P.ws + WS_CN); const unsigned short* IDX = (const unsigned short*)(P.ws + WS_IDX);
    LAS float* pL = (LAS float*)(F.lds + F.wave * 4096);
    LAS int* kL = (LAS int*)(pL + 256);
    LAS float* oL = (LAS float*)(kL + 256);
    const int lane = F.lane, gw = F.vcu * NWAVES + F.wave, NGW = F.G * NWAVES;
    for (int token = gw; token < M; token += NGW) {
        const int b = token >> 11, pos = token & (SEQ - 1), cnt = pos + 1 < TOPK ? pos + 1 : TOPK;
        float qv[16][2];
#pragma unroll
        for (int h = 0; h < 16; ++h) { qv[h][0] = bf2f(QC[(size_t)token * NATT + h * 128 + lane]); qv[h][1] = bf2f(QC[(size_t)token * NATT + h * 128 + 64 + lane]); }
        for (int s = lane; s < 256; s += 64) kL[s] = IDX[(size_t)token * 256 + s];
        LDS_WAIT(); asm volatile("" ::: "memory");
#pragma unroll
        for (int h = 0; h < 16; ++h) {
            float mx = -INFINITY;
            for (int s = 0; s < cnt; ++s) { const int pk = kL[s]; const bf16_t* cp = CN + ((size_t)b * SEQ + (pk & 2047)) * 128;
                float d = qv[h][0] * bf2f(cp[lane]) + qv[h][1] * bf2f(cp[64 + lane]); d = wave_sum(d);
                d += P.in[18][(pk >> 11) * 16 + h]; if (lane == 0) pL[s] = d; mx = fmaxf(mx, d); }
            LDS_WAIT(); asm volatile("" ::: "memory");
            float sum = 0.f; for (int s = 0; s < cnt; ++s) sum += __expf(pL[s] - mx);
            float o0 = 0.f, o1 = 0.f;
            for (int s = 0; s < cnt; ++s) { const int pk = kL[s]; const bf16_t* cp = CN + ((size_t)b * SEQ + (pk & 2047)) * 128; const float p = __expf(pL[s] - mx) / sum;
                o0 = fmaf(p, bf2f(cp[lane]), o0); o1 = fmaf(p, bf2f(cp[64 + lane]), o1); }
            QC[(size_t)token * NATT + h * 128 + lane] = (bf16_t)(cvt_pk_bf16(o0, 0.f) & 0xffffu); QC[(size_t)token * NATT + h * 128 + 64 + lane] = (bf16_t)(cvt_pk_bf16(o1, 0.f) & 0xffffu);
            asm volatile("" ::: "memory");
        }
    }
}


#ifndef MK_DEBUG_CHECKS
#define MK_DEBUG_CHECKS 0
#endif
#if MK_DEBUG_CHECKS
constexpr size_t WS_DIAG = 224 * MiB, WS_SAVE = 225 * MiB, WS_SAVEG = 226 * MiB, WS_TMPO = 227 * MiB;
constexpr int NS = 256;
__device__ __forceinline__ int srow(int s) { return ((s & 63) << 8) | ((s * 37 + 11) & 255); }
__device__ __forceinline__ float diag_err(float mine, float ref) { float e = fabsf(mine - ref) / (fabsf(ref) + 0.25f); if (!(e == e)) e = 1e9f; return e; }
__device__ __forceinline__ void diag_max(unsigned char* ws, int id, float e) {
    for (int o = 1; o < 64; o <<= 1) e = fmaxf(e, __shfl_xor(e, o));
    if ((threadIdx.x & 63) == 0) atomicMax((unsigned*)(ws + WS_DIAG) + id, __float_as_uint(e));
}
__device__ __forceinline__ void diag_put(unsigned char* ws, int id, float mine, float ref) { diag_max(ws, id, diag_err(mine, ref)); }
__device__ __forceinline__ float d_rs(const unsigned char* ws, int row) { const float* p = (const float*)(ws + WS_SSQ) + (size_t)row * 16; float s = 0.f; for (int i = 0; i < 16; ++i) s += p[i]; return rsqrtf(s / 1024.f + EPS); }
__device__ __forceinline__ float d_bf(const unsigned char* ws, size_t off, size_t idx) { return bf2f(((const bf16_t*)(ws + off))[idx]); }
__global__ void chk_zero(unsigned char* ws) { if (threadIdx.x < 64) ((unsigned*)(ws + WS_DIAG))[threadIdx.x] = 0u; }
__global__ void chk_save_rows(unsigned char* ws, const float* src) { const int s = blockIdx.x; float* d = (float*)(ws + WS_SAVE) + s * 1024; for (int c = threadIdx.x; c < 1024; c += blockDim.x) d[c] = src[(size_t)srow(s) * D + c]; }
__global__ void chk_proj(unsigned char* ws, int id, size_t off_a, int lda, const float* W, int ldw, const float* gam, int K, int N, size_t off_o, int ldo, int mode) {
    const int s = blockIdx.y, row = srow(s), col = blockIdx.x * blockDim.x + threadIdx.x;
    float acc = 0.f; for (int k = 0; k < K; ++k) acc = fmaf(d_bf(ws, off_a, (size_t)row * lda + k) * (gam ? gam[k] : 1.f), W[(size_t)k * ldw + col], acc);
    acc *= d_rs(ws, row);
    if (mode == 1 && col < 1024) acc = 0.5f * acc * (1.f + tanhf(0.7978845608f * (acc + 0.044715f * acc * acc * acc)));
    if (mode == 2) { acc = fmaxf(acc, 0.f); acc *= acc; }
    diag_put(ws, id, d_bf(ws, off_o, (size_t)row * ldo + col), acc);
}
__global__ void chk_res(unsigned char* ws, int id, size_t off_a, int lda, const float* W, int K, const float* outp, const float* xold_full) {
    const int s = blockIdx.y, row = srow(s), col = blockIdx.x * blockDim.x + threadIdx.x;
    float acc = 0.f; for (int k = 0; k < K; ++k) acc = fmaf(d_bf(ws, off_a, (size_t)row * lda + k), W[(size_t)k * D + col], acc);
    const float xo = xold_full ? xold_full[(size_t)row * D + col] : ((const float*)(ws + WS_SAVE))[s * 1024 + col];
    diag_put(ws, id, outp[(size_t)row * D + col], xo + acc);
    diag_put(ws, id, d_bf(ws, WS_XB, (size_t)row * D + col), xo + acc);
}
__global__ void chk_ssq(unsigned char* ws, int id, const float* outp) {
    const int s = blockIdx.x * blockDim.x + threadIdx.x; const int row = srow(s); float q = 0.f; for (int c = 0; c < D; ++c) { const float v = outp[(size_t)row * D + c]; q += v * v; }
    const float* p = (const float*)(ws + WS_SSQ) + (size_t)row * 16; float t = 0.f; for (int i = 0; i < 16; ++i) t += p[i]; diag_put(ws, id, t, q);
}
__global__ void chk_conv(unsigned char* ws, int id, const float* cw, const float* cb) {
    const int s = blockIdx.y, row = srow(s) & ~3 | (s & 3) * 0, ch = blockIdx.x * blockDim.x + threadIdx.x;
    const int rr = (s < 16) ? ((s >> 1) * SEQ + (s & 1) * 256 * 3 + (s & 3)) : srow(s); const int pos = rr & (SEQ - 1);
    float acc = cb[ch]; for (int k = 0; k < 4; ++k) { const int p = pos - 3 + k; if (p >= 0) acc += cw[k * D + ch] * d_bf(ws, WS_GX, (size_t)(rr - 3 + k) * 2048 + 1024 + ch); }
    diag_put(ws, id, d_bf(ws, WS_XC, (size_t)rr * D + ch), acc);
}
__global__ void chk_gates(unsigned char* ws, int id, const float* wa, const float* ba, const float* wx, const float* bx) {
    const int s = blockIdx.y, row = srow(s), ch = blockIdx.x * blockDim.x + threadIdx.x, blk = ch >> 8, i = ch & 255;
    float a = ba[ch], x = bx[ch]; for (int jx = 0; jx < 256; ++jx) { const float v = d_bf(ws, WS_XC, (size_t)row * D + blk * 256 + jx); a = fmaf(v, wa[(size_t)blk * 65536 + jx * 256 + i], a); x = fmaf(v, wx[(size_t)blk * 65536 + jx * 256 + i], x); }
    diag_put(ws, id, d_bf(ws, WS_RB, (size_t)row * D + ch), 1.f / (1.f + expf(-a))); diag_put(ws, id, d_bf(ws, WS_IB, (size_t)row * D + ch), 1.f / (1.f + expf(-x)));
}
__global__ void chk_save_gate(unsigned char* ws) {
    const int p = blockIdx.x, b = p & 7, ch = (p * 61 + 5) & 1023; bf16_t* d = (bf16_t*)(ws + WS_SAVEG) + p * 2048;
    for (int t = threadIdx.x; t < SEQ; t += blockDim.x) d[t] = ((const bf16_t*)(ws + WS_GX))[((size_t)b * SEQ + t) * 2048 + ch];
}
__global__ void chk_scan(unsigned char* ws, int id, const float* lam) {
    const int p = blockIdx.x * blockDim.x + threadIdx.x; const int b = p & 7, ch = (p * 61 + 5) & 1023;
    const float sp = -8.f * log1pf(expf(-lam[ch])); float h = 0.f, em = 0.f;
    for (int t = 0; t < SEQ; ++t) { const size_t r = (size_t)b * SEQ + t; const float rr = d_bf(ws, WS_RB, r * D + ch), ii = d_bf(ws, WS_IB, r * D + ch), xc = d_bf(ws, WS_XC, r * D + ch);
        const float la = sp * rr, a = expf(la), u = sqrtf(-expm1f(2.f * la)) * (ii * xc); h = a * h + u;
        const float g = bf2f(((const bf16_t*)(ws + WS_SAVEG))[p * 2048 + t]); em = fmaxf(em, diag_err(d_bf(ws, WS_GX, r * 2048 + ch), h * g)); }
    diag_max(ws, id, em);
}
__global__ void chk_att_in(unsigned char* ws, int id, const float* Win, const float* wuk, const float* gam) {
    const int s = blockIdx.y, row = srow(s), col = blockIdx.x * blockDim.x + threadIdx.x;
    const float rs = d_rs(ws, row); float ref = 0.f;
    if (col < 2048) { const int h = col >> 7, c = col & 127;
        for (int d = 0; d < 64; ++d) { float q = 0.f; for (int k = 0; k < D; ++k) q = fmaf(d_bf(ws, WS_XB, (size_t)row * D + k) * gam[k], Win[(size_t)k * ATT_IN + h * 64 + d], q); ref = fmaf(q, wuk[((size_t)h * 64 + d) * 128 + c], ref); }
        ref *= rs * 0.125f; }
    else if (col < 2760) { const int wc = 1024 + (col - 2048); for (int k = 0; k < D; ++k) ref = fmaf(d_bf(ws, WS_XB, (size_t)row * D + k) * gam[k], Win[(size_t)k * ATT_IN + wc], ref); ref *= rs * (col >= 2752 ? 0.044194173824159216f : 1.f); }
    diag_put(ws, id, d_bf(ws, WS_QC, (size_t)row * NATT + col), ref);
}
__global__ void chk_cn(unsigned char* ws, int id, const float* g) {
    const int s = blockIdx.x, row = srow(s), c = threadIdx.x; float ss = 0.f; for (int e = 0; e < 128; ++e) { const float v = d_bf(ws, WS_QC, (size_t)row * NATT + QC_C + e); ss += v * v; }
    diag_put(ws, id, d_bf(ws, WS_CN, (size_t)row * 128 + c), d_bf(ws, WS_QC, (size_t)row * NATT + QC_C + c) * rsqrtf(ss / 128.f + EPS) * g[c]);
}
__global__ void chk_att_o(unsigned char* ws, const float* wuv) {
    const int s = blockIdx.y, row = srow(s), n = blockIdx.x * blockDim.x + threadIdx.x, h = n >> 6, v = n & 63; float a = 0.f;
    for (int c = 0; c < 128; ++c) a = fmaf(d_bf(ws, WS_QC, (size_t)row * NATT + h * 128 + c), wuv[((size_t)h * 128 + c) * 64 + v], a);
    ((float*)(ws + WS_TMPO))[s * 1024 + n] = a;
}
__global__ void chk_att_out(unsigned char* ws, int id, const float* wo, const float* outp) {
    const int s = blockIdx.y, row = srow(s), col = blockIdx.x * blockDim.x + threadIdx.x; float a = 0.f;
    for (int k = 0; k < 1024; ++k) a = fmaf(((const float*)(ws + WS_TMPO))[s * 1024 + k], wo[(size_t)k * D + col], a);
    diag_put(ws, id, outp[(size_t)row * D + col], ((const float*)(ws + WS_SAVE))[s * 1024 + col] + a);
}
__global__ void chk_report(unsigned char* ws, float* outp) {
    if (threadIdx.x == 0) { const unsigned* dg = (const unsigned*)(ws + WS_DIAG); for (int id = 1; id < 40; ++id) { const float e = __uint_as_float(dg[id]); if (e > 0.1f) { outp[0] = 100.f * id + 10.f; break; } } }
}
#endif


#ifndef MK_DETCHECK
#define MK_DETCHECK 0
#endif
#if MK_DETCHECK
constexpr size_t WS_CKS = 230 * MiB;
__global__ void cks_zero(unsigned* d) { d[threadIdx.x] = 0u; }
__global__ void lds_poison(unsigned pat) { extern __shared__ unsigned lp[]; for (int i = threadIdx.x; i < LDS_BYTES / 4; i += blockDim.x) lp[i] = pat; __syncthreads(); if (lp[threadIdx.x] != pat) asm volatile("s_nop 0"); }
__global__ void cks_kernel(const unsigned* p, size_t nwords, unsigned* dst) {
    unsigned a = 0u; for (size_t i = (size_t)blockIdx.x * blockDim.x + threadIdx.x; i < nwords; i += (size_t)gridDim.x * blockDim.x) a += p[i] * 2654435761u + (unsigned)i;
    for (int o = 1; o < 64; o <<= 1) a += __shfl_xor(a, o);
    if ((threadIdx.x & 63) == 0) atomicAdd(dst, a);
}
__global__ void cks_report(const unsigned* d, float* outp) { if (threadIdx.x == 0) for (int ph = 0; ph < 64; ++ph) if (d[ph] != d[64 + ph]) { outp[0] = 100.f * (ph + 1) + 10.f; break; } }
#endif

constexpr int N_PHASES = 28;
#ifndef MK_PER_PHASE
#define MK_PER_PHASE 0
#endif

__global__ void __launch_bounds__(NTHREADS, 2) trunk_fwd(Args args) {
    extern __shared__ __attribute__((aligned(16))) unsigned char lds_raw[];
    Frame F0;
    F0.lds = (LAS unsigned char*)lds_raw;
    F0.tid = threadIdx.x; F0.lane = F0.tid & 63; F0.wave = __builtin_amdgcn_readfirstlane(F0.tid >> 6);
    F0.G = gridDim.x; F0.bid = blockIdx.x; { const int bx = blockIdx.x; F0.vcu = (F0.G % 8 == 0) ? (bx % 8) * (F0.G / 8) + bx / 8 : bx; }
    volatile LAS unsigned* MISC = (volatile LAS unsigned*)(F0.lds + MISC_OFF);
    for (int u = F0.tid; u < (LDS_BYTES - LDSCTL_OFF) / 4; u += NTHREADS) ((LAS unsigned*)(F0.lds + LDSCTL_OFF))[u] = 0u;
    __syncthreads();
    unsigned* barw = (unsigned*)(args.ws + WS_CTL) + CW_BAR;
    XcdBarrier bar; bar.bar = barw; bar.x = 0; bar.st = nullptr;
    if (!MK_PER_PHASE) bar = xcd_barrier_post(barw, MISC + 8);
    const int lo = args.ph_lo, hi = args.ph_hi;
#ifndef PHMASK
#define PHMASK 0xFFFFu
#endif
#define PM(b) ((PHMASK >> (b)) & 1u)

#define IN(k) (lo <= (k) && (k) < hi)
#define SEAM(k) do { if (IN(k) && IN((k) + 1)) xcd_barrier(bar); } while (0)
    const bool gated = (F0.G == 256) && !MK_PER_PHASE;
#define HANDW(sidx) (CW_HAND + (sidx) * 64 * 16)
#define HAND(sidx) ((unsigned*)(P.ws + WS_CTL) + HANDW(sidx))
#define SEAM_H(k) do { if (!gated) SEAM(k); } while (0)
#define HAND_PREP(S_, sidx, per_unit) do { if (gated) (S_).c |= ((sidx) + 1) << 16; } while (0)
#define HAND_PUBLISH() do { } while (0)

#define PHASE_PTRS const Frame F = launder(F0); const Ptrs P = load_ptrs(); bf16_t* XB = (bf16_t*)(P.ws + WS_XB); float* SSQ = (float*)(P.ws + WS_SSQ); float* SSQM = (float*)(P.ws + WS_SSQM); \
    bf16_t* WM = (bf16_t*)(P.ws + WS_WMIX); bf16_t* WA = (bf16_t*)(P.ws + WS_WATT); bf16_t* WUP = (bf16_t*)(P.ws + WS_WUP); bf16_t* WDN = (bf16_t*)(P.ws + WS_WDOWN); \
    (void)XB; (void)SSQ; (void)SSQM; (void)WM; (void)WA; (void)WUP; (void)WDN

    if (PM(0) && IN(0)) { PHASE_PTRS; if (DB(0)) { cvt_att_mix(F, P, 0, 1); cvt_rec_mix(F, P, 0, 0); cvt_up(F, P, 0); cvt_down(F, P, 0); p0_rows(F, P); __syncthreads(); } cvt_att_mix(F, P, 0, 1, 0); cvt_att_mix(F, P, 1, 3, 1024); cvt_rec_mix(F, P, 0, 0); cvt_up(F, P, 0); cvt_down(F, P, 0); p0_rows(F, P); }
    SEAM(0);

    for (int L = 0; L < DEPTH; ++L) {
        const int pb = 1 + 7 * ((L + 1) >> 1) + 6 * (L >> 1), j = L >> 1, mo = (L & 1) ? 0 : 1;
        if ((L & 1) == 0) {
            if (PM(1) && IN(pb)) { PHASE_PTRS;
                { const Frame& F1 = F; (void)F1;
                pg8::Gemm g{XB, WM, D, D, D, -1}; pg8::StaticOrderT<true, false> S; S.init(M, 2048, F.G, F.bid);
                if (gated && L > 0) { S.ready = HAND(8 + L - 1); }
                pg8::EpiScale<1> E{(bf16_t*)(P.ws + WS_GX), 2048, SSQ};
                if (DB(1)) pg8::gemm_phase(F.lds, F.tid, g, S, E);
                pg8::gemm_phase(F.lds, F.tid, g, S, E); } }
            SEAM(pb);
            if (PM(2) && IN(pb + 1)) { PHASE_PTRS;
                for (int rep = 0; rep < (DB(2) ? 2 : 1); ++rep) for (int p = F.vcu; p < 256; p += F.G) conv_tile(F, P, j, p >> 2, p & 3);
                if (L > 0) cvt_down(F, P, L);
                asm volatile("s_waitcnt vmcnt(0)" ::: "memory"); __syncthreads();
                pg8::Gemm g{(const bf16_t*)(P.ws + WS_XC), WM + WM_REC_GATE, D, D, 256, 3}; pg8::GateOrder S{F.G, F.vcu};
                pg8::EpiGate E{(bf16_t*)(P.ws + WS_RB), (bf16_t*)(P.ws + WS_IB), P.in[8] + (size_t)j * D, P.in[10] + (size_t)j * D};
                pg8::gemm_phase(F.lds, F.tid, g, S, E); }
            SEAM(pb + 2);
            if (PM(3) && IN(pb + 3)) { PHASE_PTRS; if (DB(3)) { scan_phase(F, P, j, true); __syncthreads(); } if (L > 0) { cvt_up(F, P, L); __syncthreads(); } scan_phase(F, P, j); }
            SEAM(pb + 3);
            if (PM(4) && IN(pb + 4)) { PHASE_PTRS;
                pg8::Gemm g{(const bf16_t*)(P.ws + WS_GX), WM + WM_REC_OUT, 2048, D, D, -1}; pg8::StaticOrderT<false, true> S; S.init(M, D, F.G, F.bid);
                                pg8::EpiRes<false> E{XB, SSQM, nullptr}; HAND_PREP(S, L, 4);
                pg8::gemm_phase(F.lds, F.tid, g, S, E); HAND_PUBLISH(); }
            SEAM_H(pb + 4);
        } else {
            if (PM(5) && IN(pb)) { PHASE_PTRS;
                { const Frame& F1 = F; (void)F1;
                pg8::Gemm g{XB, WA + (size_t)j * 5 * MiB, D, D, D, -1}; pg8::StaticOrderT<true, false> S; S.init(M, NATT, F.G, F.bid);
                if (gated && L > 0) { S.ready = HAND(8 + L - 1); }
                pg8::EpiScale<0> E{(bf16_t*)(P.ws + WS_QC), NATT, SSQ};
                pg8::gemm_phase(F.lds, F.tid, g, S, E); } }
            SEAM(pb);
            if (PM(6) && IN(pb + 1)) { PHASE_PTRS; cvt_down(F, P, L); if (L + 1 < DEPTH) cvt_rec_mix(F, P, (L + 1) >> 1, L + 1); __syncthreads(); if (DB(6)) { index_phase(F, P, j); __syncthreads(); } if (NAIVE_IDX) naive_index_phase(F, P, j); else index_phase(F, P, j); }
            SEAM(pb + 1);
            if (PM(7) && IN(pb + 2)) { PHASE_PTRS; cvt_up(F, P, L); __syncthreads(); if (DB(7)) { attn_phase(F, P, true); __syncthreads(); } if (NAIVE_ATT) naive_attn_phase(F, P); else attn_phase(F, P); }
            SEAM(pb + 2);
            if (PM(8) && IN(pb + 3)) { PHASE_PTRS;
                pg8::Gemm g{(const bf16_t*)(P.ws + WS_QC), WA + (size_t)j * 5 * MiB + WM_ATT_COMB, NATT, 2048, 2048, -1}; pg8::StaticOrderT<false, true> S; S.init(M, D, F.G, F.bid);
                                pg8::EpiRes<false> E{XB, SSQM, nullptr}; HAND_PREP(S, L, 4);
                pg8::gemm_phase(F.lds, F.tid, g, S, E); HAND_PUBLISH(); }
            SEAM_H(pb + 3);
        }
        if (PM(9) && IN(pb + 4 + mo)) { PHASE_PTRS;
            { const Frame& F1 = F; (void)F1;
            pg8::Gemm g{XB, WUP, D, D, D, -1}; pg8::StaticOrderT<true, true> S; S.init(M, FF, F.G, F.bid);
            if (gated) { S.ready = HAND(L); }
            pg8::EpiScale<2> E{(bf16_t*)(P.ws + WS_H), FF, nullptr};
            HAND_PREP(S, 4 + L, 1);
            pg8::gemm_phase(F.lds, F.tid, g, S, E); HAND_PUBLISH(); } }
        SEAM_H(pb + 4 + mo);
        if (PM(10) && IN(pb + 5 + mo)) { PHASE_PTRS;
            { const Frame& F1 = F; (void)F1;
            pg8::Gemm g{(const bf16_t*)(P.ws + WS_H), WDN, FF, FF, FF, -1}; pg8::StaticOrderT<true, true> S; S.init(M, D, F.G, F.bid);
            if (gated) { S.ready = HAND(4 + L); }
            pg8::EpiRes<true> E{XB, SSQ, SSQM};
            if (L + 1 < DEPTH) HAND_PREP(S, 8 + L, 4);
            pg8::gemm_phase(F.lds, F.tid, g, S, E); } }
        if (L + 1 < DEPTH) SEAM_H(pb + 5 + mo); else SEAM(pb + 5 + mo);
    }
    if (PM(11) && IN(27)) { PHASE_PTRS; if (DB(11)) final_norm(F, P, true); final_norm(F, P); }
#undef IN
#undef SEAM
}

extern "C" void kernel_launch(void* const* d_in, const int* in_sizes, int n_in, void* d_out, int out_size, void* d_ws, size_t ws_size, hipStream_t stream) {
    static int grid = 0;
    if (grid == 0) {
        if (n_in != 21 || in_sizes[0] != M * D || out_size != M * D || ws_size < WS_END) { fprintf(stderr, "kernel_launch: unexpected shapes (n_in %d, in0 %d, out %d, ws %zu)\n", n_in, n_in > 0 ? in_sizes[0] : -1, out_size, ws_size); grid = -1; return; }
        int dev = 0, cus = 0, per_cu = 0;
        if (hipGetDevice(&dev) != hipSuccess || hipDeviceGetAttribute(&cus, hipDeviceAttributeMultiprocessorCount, dev) != hipSuccess) { grid = -1; return; }
        if (hipFuncSetAttribute((const void*)trunk_fwd, hipFuncAttributeMaxDynamicSharedMemorySize, LDS_BYTES) != hipSuccess) { fprintf(stderr, "kernel_launch: hipFuncSetAttribute failed\n"); grid = -1; return; }
        if (hipOccupancyMaxActiveBlocksPerMultiprocessor(&per_cu, (const void*)trunk_fwd, NTHREADS, LDS_BYTES) != hipSuccess || per_cu < 1) fprintf(stderr, "kernel_launch: occupancy query reports %d\n", per_cu);
        (void)hipGetLastError();
        grid = cus;
    }
    if (grid < 0) return;
    (void)hipMemsetAsync((char*)d_ws + WS_CTL, 0, CTL_ZERO_BYTES, stream);
    Args a{};
    for (int i = 0; i < 21; ++i) a.in[i] = (const float*)d_in[i];
    a.out = (float*)d_out; a.ws = (unsigned char*)d_ws;
#if MK_PER_PHASE
#if MK_DETCHECK
    unsigned char* wsb = (unsigned char*)d_ws; unsigned* ck = (unsigned*)(wsb + WS_CKS);
    cks_zero<<<1, 128, 0, stream>>>(ck);
    (void)hipFuncSetAttribute((const void*)lds_poison, hipFuncAttributeMaxDynamicSharedMemorySize, LDS_BYTES);
    for (int pass = 0; pass < 2; ++pass)
    for (int ph = 0; ph < N_PHASES; ++ph) {
        if (ph == 0) { (void)hipMemsetAsync(wsb + 65536, pass ? 0x55 : 0xAA, 224 * MiB - 65536, stream); (void)hipMemsetAsync(d_out, pass ? 0x55 : 0xAA, (size_t)M * D * 4, stream);
            hipLaunchKernelGGL(lds_poison, dim3(grid), dim3(NTHREADS), LDS_BYTES, stream, pass ? 0x55555555u : 0xAAAAAAAAu); }
        a.ph_lo = ph; a.ph_hi = ph + 1; hipLaunchKernelGGL(trunk_fwd, dim3(grid), dim3(NTHREADS), LDS_BYTES, stream, a);
        int L = -1, k = -1; { const int pbs[5] = {1, 8, 14, 21, 27}; for (int l = 0; l < 4; ++l) if (ph >= pbs[l] && ph < pbs[l + 1]) { L = l; k = ph - pbs[l]; } }
        const bool rec = (L & 1) == 0; unsigned* dst = ck + pass * 64 + ph;
        auto CK = [&](size_t off, size_t bytes) { cks_kernel<<<1024, 256, 0, stream>>>((const unsigned*)(wsb + off), bytes / 4, dst); };
        auto CKO = [&]() { cks_kernel<<<1024, 256, 0, stream>>>((const unsigned*)d_out, (size_t)M * D, dst); CK(WS_XB, 32 * MiB); CK(WS_SSQ, 1 * MiB); };
        if (ph == 0) { CK(WS_WMIX, 10 * MiB); CK(WS_WUP, 8 * MiB); CK(WS_WDOWN, 8 * MiB); CK(WS_XB, 32 * MiB); CK(WS_SSQ, 1 * MiB); }
        else if (ph == 27) { cks_kernel<<<1024, 256, 0, stream>>>((const unsigned*)d_out, (size_t)M * D, dst); }
        else if (rec) {
            if (k == 0) { CK(WS_GX, 64 * MiB); CK(WS_WDOWN, 8 * MiB); }
            if (k == 1) CK(WS_XC, 32 * MiB);
            if (k == 2) { CK(WS_RB, 32 * MiB); CK(WS_IB, 32 * MiB); }
            if (k == 3) CK(WS_GX, 64 * MiB);
            if (k == 4) CKO();
            if (k == 5) { CK(WS_H, 128 * MiB); CK(WS_WMIX, 10 * MiB); }
            if (k == 6) { CKO(); CK(WS_WUP, 8 * MiB); }
        } else {
            if (k == 0) { CK(WS_QC, 88 * MiB); CK(WS_WDOWN, 8 * MiB); }
            if (k == 1) { CK(WS_CN, 4 * MiB); CK(WS_IDX, 8 * MiB); }
            if (k == 2) CK(WS_QC, 88 * MiB);
            if (k == 3) CKO();
            if (k == 4) { CK(WS_H, 128 * MiB); CK(WS_WMIX, 10 * MiB); }
            if (k == 5) { CKO(); CK(WS_WUP, 8 * MiB); }
        }
    }
    cks_report<<<1, 64, 0, stream>>>(ck, (float*)d_out);
#else
#if MK_DEBUG_CHECKS
    unsigned char* ws = (unsigned char*)d_ws; const float** in = (const float**)a.in; float* outp = (float*)d_out;
    chk_zero<<<1, 64, 0, stream>>>(ws);
#endif
    for (int ph = 0; ph < N_PHASES; ++ph) {
#if MK_DEBUG_CHECKS
        int L = -1, k = -1; { const int pbs[5] = {1, 8, 14, 21, 27}; for (int l = 0; l < 4; ++l) if (ph >= pbs[l] && ph < pbs[l + 1]) { L = l; k = ph - pbs[l]; } }
        const int j = L >> 1, id0 = 10 * L; const bool rec = (L & 1) == 0;
        if (L >= 0) {
            if ((rec && k == 4 && L > 0) || (!rec && k == 3) || (rec && k == 6) || (!rec && k == 5)) chk_save_rows<<<NS, 256, 0, stream>>>(ws, outp);
            if (rec && k == 3) chk_save_gate<<<128, 256, 0, stream>>>(ws);
        }
#endif
        a.ph_lo = ph; a.ph_hi = ph + 1; hipLaunchKernelGGL(trunk_fwd, dim3(grid), dim3(NTHREADS), LDS_BYTES, stream, a);
#if MK_DEBUG_CHECKS
        if (L >= 0) {
          if (rec) {
            if (k == 0) chk_proj<<<dim3(8, NS), 256, 0, stream>>>(ws, id0 + 1, WS_XB, D, in[4] + (size_t)j * D * 2048, 2048, in[1] + L * D, D, 2048, WS_GX, 2048, 1);
            if (k == 1) chk_conv<<<dim3(4, NS), 256, 0, stream>>>(ws, id0 + 2, in[5] + (size_t)j * 4 * D, in[6] + (size_t)j * D);
            if (k == 2) chk_gates<<<dim3(4, NS), 256, 0, stream>>>(ws, id0 + 3, in[7] + (size_t)j * 4 * 65536, in[8] + (size_t)j * D, in[9] + (size_t)j * 4 * 65536, in[10] + (size_t)j * D);
            if (k == 3) chk_scan<<<2, 64, 0, stream>>>(ws, id0 + 4, in[11] + (size_t)j * D);
            if (k == 4) { chk_res<<<dim3(4, NS), 256, 0, stream>>>(ws, id0 + 5, WS_GX, 2048, in[12] + (size_t)j * D * D, D, outp, L == 0 ? in[0] : nullptr); chk_ssq<<<NS / 64, 64, 0, stream>>>(ws, id0 + 5, outp); }
            if (k == 5) chk_proj<<<dim3(16, NS), 256, 0, stream>>>(ws, id0 + 6, WS_XB, D, in[19] + (size_t)L * D * FF, FF, in[2] + L * D, D, FF, WS_H, FF, 2);
            if (k == 6) { chk_res<<<dim3(4, NS), 256, 0, stream>>>(ws, id0 + 7, WS_H, FF, in[20] + (size_t)L * FF * D, FF, outp, nullptr); chk_ssq<<<NS / 64, 64, 0, stream>>>(ws, id0 + 7, outp); }
          } else {
            if (k == 0) chk_att_in<<<dim3(11, NS), 256, 0, stream>>>(ws, id0 + 1, in[13] + (size_t)j * D * ATT_IN, in[15] + (size_t)j * 16 * 64 * 128, in[1] + L * D);
            if (k == 1) chk_cn<<<NS, 128, 0, stream>>>(ws, id0 + 2, in[14] + (size_t)j * 128);
            if (k == 3) { chk_att_o<<<dim3(4, NS), 256, 0, stream>>>(ws, in[16] + (size_t)j * 16 * 128 * 64); chk_att_out<<<dim3(4, NS), 256, 0, stream>>>(ws, id0 + 5, in[17] + (size_t)j * D * D, outp); chk_ssq<<<NS / 64, 64, 0, stream>>>(ws, id0 + 5, outp); }
            if (k == 4) chk_proj<<<dim3(16, NS), 256, 0, stream>>>(ws, id0 + 6, WS_XB, D, in[19] + (size_t)L * D * FF, FF, in[2] + L * D, D, FF, WS_H, FF, 2);
            if (k == 5) { chk_res<<<dim3(4, NS), 256, 0, stream>>>(ws, id0 + 7, WS_H, FF, in[20] + (size_t)L * FF * D, FF, outp, nullptr); chk_ssq<<<NS / 64, 64, 0, stream>>>(ws, id0 + 7, outp); }
          }
        }
#endif
    }
#if MK_DEBUG_CHECKS
    chk_report<<<1, 64, 0, stream>>>(ws, outp);
#endif
#endif
#else
    a.ph_lo = 0; a.ph_hi = N_PHASES;
    hipLaunchKernelGGL(trunk_fwd, dim3(grid), dim3(NTHREADS), LDS_BYTES, stream, a);
#endif
}
```

```cpp
#include <hip/hip_runtime.h>
#include <cstdio>
#include <cstdint>

#define LAS __attribute__((address_space(3)))
#define GAS __attribute__((address_space(1)))
typedef unsigned short bf16_t;
typedef short bf16x8 __attribute__((ext_vector_type(8)));
typedef short s16x4 __attribute__((ext_vector_type(4)));
typedef float f32x4 __attribute__((ext_vector_type(4)));
typedef float f32x2 __attribute__((ext_vector_type(2)));
typedef float f32x16 __attribute__((ext_vector_type(16)));
typedef unsigned u32x4 __attribute__((ext_vector_type(4)));
typedef unsigned u32x2 __attribute__((ext_vector_type(2)));
typedef unsigned short u16x4 __attribute__((ext_vector_type(4)));

constexpr int BATCH = 8, SEQ = 2048, D = 1024, M = BATCH * SEQ, DEPTH = 4, FF = 4096;
constexpr int H_ATT = 16, D_LAT = 128, H_IDX = 8, D_IDX = 64, TOPK = 256;
constexpr int ATT_IN = 1736;
constexpr int NATT = 2816;
constexpr int QC_C = 2048, QC_QI = 2176, QC_KI = 2688, QC_WI = 2752;
constexpr float EPS = 1e-6f;
constexpr int NWAVES = 8, NTHREADS = 512;

constexpr size_t MiB = 1u << 20;
constexpr size_t WS_CTL = 0, CTL_ZERO_BYTES = 128 * 1024;
constexpr int CW_HAND = 16384;
constexpr size_t WS_SSQ = 1 * MiB;
constexpr size_t WS_WMIX = 2 * MiB;
constexpr size_t WS_WUP = 12 * MiB, WS_WDOWN = 20 * MiB;
constexpr size_t WS_XB = 28 * MiB;
constexpr size_t WS_BIG = 60 * MiB;
constexpr size_t WS_H = WS_BIG;
constexpr size_t WS_GX = WS_BIG;
constexpr size_t WS_XC = WS_BIG + 64 * MiB;
constexpr size_t WS_RB = WS_BIG + 96 * MiB;
constexpr size_t WS_IB = WS_BIG + 128 * MiB;
constexpr size_t WS_QC = WS_BIG;
constexpr size_t WS_CN = WS_BIG + 88 * MiB;
constexpr size_t WS_IDX = WS_BIG + 92 * MiB;
constexpr size_t WS_WATT = WS_BIG + 160 * MiB;
constexpr size_t WS_SSQM = WS_WATT + 20 * MiB;
constexpr size_t WS_END = WS_SSQM + 1 * MiB;
constexpr size_t WM_REC_GATE = (size_t)2048 * 1024, WM_REC_OUT = WM_REC_GATE + (size_t)2048 * 1024;
constexpr size_t WM_ATT_COMB = (size_t)NATT * 1024;

constexpr int RING_BYTES = 131072;
constexpr int LDSCTL_OFF = RING_BYTES;
constexpr int LDS_BYTES = 163840;
constexpr int MISC_OFF = LDS_BYTES - 512;
constexpr int BSL_OFF = 132096;

#ifndef DBLMASK
#define DBLMASK 0u
#endif
#define DB(b) ((DBLMASK >> (b)) & 1u)
typedef __bf16 bf16x2_t __attribute__((ext_vector_type(2)));
__device__ __forceinline__ unsigned cvt_pk_bf16(float lo, float hi) { const f32x2 v = {lo, hi}; return __builtin_bit_cast(unsigned, __builtin_convertvector(v, bf16x2_t)); }
__device__ __forceinline__ float bf2f(unsigned h) { return __uint_as_float(h << 16); }
__device__ __forceinline__ float bflo(unsigned w) { return __uint_as_float(w << 16); }
__device__ __forceinline__ float bfhi(unsigned w) { return __uint_as_float(w & 0xffff0000u); }
__device__ __forceinline__ float wave_sum(float v) {
#pragma unroll
    for (int o = 1; o < 64; o <<= 1) v += __shfl_xor(v, o);
    return v;
}
#ifndef WT_STORES
#define WT_STORES 1
#endif
__device__ __forceinline__ void store16_wt(void* p, u32x4 v) {
#if WT_STORES
    asm volatile("global_store_dwordx4 %0, %1, off sc1\n\ts_nop 1" :: "v"(p), "v"(v) : "memory");
#else
    *(u32x4*)p = v;
#endif
}
#define LDS_WAIT() asm volatile("s_waitcnt lgkmcnt(0)" ::: "memory")
#define VM_WAIT() asm volatile("s_waitcnt vmcnt(0)" ::: "memory")

#define XB_TMO      128
#define XB_XCNT(j)  (256  + 64 * (j))
#define XB_XSUB(j)  (1280 + 64 * (j))
#define XB_XGEN(j)  (2304 + 64 * (j))
#define XB_TOP      3328
#define XB_TOPGEN   3392
#define XCD_BAR_WORDS 3456
#define XB_SPIN_CAP (1u << 22)
constexpr int CW_BAR = 4096;
static_assert((CW_BAR + XCD_BAR_WORDS) * 4 <= (int)CTL_ZERO_BYTES, "barrier words inside the memset region");

__device__ __forceinline__ unsigned xb_ld(unsigned* p)              { return __hip_atomic_load(p, __ATOMIC_RELAXED, __HIP_MEMORY_SCOPE_AGENT); }
__device__ __forceinline__ unsigned xb_add(unsigned* p, unsigned v) { return __hip_atomic_fetch_add(p, v, __ATOMIC_RELAXED, __HIP_MEMORY_SCOPE_AGENT); }
__device__ __forceinline__ unsigned xb_xcc_id() { return (unsigned)__builtin_amdgcn_s_getreg((3 << 11) | 20) & 0xFu; }
#define XB_SPIN(cond, bar) do { unsigned _sp = 0; while (cond) { __builtin_amdgcn_s_sleep(1); \
    if ((++_sp & 255u) == 0u) { if (xb_ld(&(bar)[XB_TMO])) break; if (_sp > XB_SPIN_CAP) { atomicAdd(&(bar)[XB_TMO], 1u); break; } } } } while (0)

struct XcdBarrier { unsigned* bar; unsigned x; volatile LAS unsigned* st; };

__device__ __forceinline__ XcdBarrier xcd_barrier_post(unsigned* bar, volatile LAS unsigned* st) {
    XcdBarrier b; b.bar = bar; b.x = xb_xcc_id(); b.st = st;
    if (threadIdx.x == 0) (void)xb_add(&bar[XB_XCNT(b.x)], 1u);
    return b;
}
__device__ __forceinline__ void xcd_barrier_complete(unsigned* bar, unsigned x, unsigned& nloc, unsigned& nx) {
    const unsigned G = gridDim.x * gridDim.y * gridDim.z;
    unsigned sum, cnt, mine, sp = 0u;
    for (;;) {
        sum = 0u; cnt = 0u; mine = 0u;
#pragma unroll
        for (unsigned j = 0; j < 16; ++j) { const unsigned c = xb_ld(&bar[XB_XCNT(j)]); sum += c; cnt += (c > 0u) ? 1u : 0u; mine = (j == x) ? c : mine; }
        if (sum == G) break;
        __builtin_amdgcn_s_sleep(1);
        if ((++sp & 255u) == 0u) { if (xb_ld(&bar[XB_TMO])) break; if (sp > XB_SPIN_CAP) { atomicAdd(&bar[XB_TMO], 1u); break; } }
    }
    nloc = mine > 0u ? mine : 1u; nx = cnt > 0u ? cnt : 1u;
}
__device__ __forceinline__ void xcd_barrier(const XcdBarrier& b) {
    asm volatile("s_waitcnt vmcnt(0)" ::: "memory");
    __syncthreads();
    if (threadIdx.x == 0) {
        unsigned* bar = b.bar;
        __builtin_amdgcn_s_waitcnt(0);
        unsigned nloc = b.st[0], nx = b.st[1];
        if (nloc == 0u) { xcd_barrier_complete(bar, b.x, nloc, nx); b.st[0] = nloc; b.st[1] = nx; }
        const unsigned old = xb_add(&bar[XB_XSUB(b.x)], 1u);
        const unsigned gen = old / nloc;
        if (old + 1u == (gen + 1u) * nloc) {
            __builtin_amdgcn_fence(__ATOMIC_RELEASE, "agent");
            asm volatile("s_waitcnt vmcnt(0)" ::: "memory");
            const unsigned og = xb_add(&bar[XB_TOP], 1u);
            const unsigned tg = og / nx;
            if (og + 1u == (tg + 1u) * nx) xb_add(&bar[XB_TOPGEN], 1u);
            else XB_SPIN(xb_ld(&bar[XB_TOPGEN]) == tg, bar);
            __builtin_amdgcn_fence(__ATOMIC_ACQUIRE, "agent");
            xb_add(&bar[XB_XGEN(b.x)], 1u);
            asm volatile("s_waitcnt vmcnt(0)" ::: "memory");
        } else {
            XB_SPIN(xb_ld(&bar[XB_XGEN(b.x)]) == gen, bar);
            __builtin_amdgcn_fence(__ATOMIC_ACQUIRE, "agent");
            asm volatile("s_waitcnt vmcnt(0)" ::: "memory");
        }
    }
    __syncthreads();
}

__device__ __forceinline__ unsigned long long ws_base_arg() { int k = 22; asm volatile("" : "+s"(k)); return ((const __attribute__((address_space(4))) unsigned long long*)__builtin_amdgcn_kernarg_segment_ptr())[k]; }
namespace pg8 {
constexpr int BM = 256, BK = 64, HALF = 128, HTB = HALF * BK * 2, NXCD = 8, WGM = 8;
__device__ __forceinline__ int lds_byte(int r, int c) { const int st = (r >> 4) * 2 + (c >> 5), rr = r & 15, cc = c & 31, ob = rr * 64 + cc * 2; return st * 1024 + (ob ^ (((ob >> 9) & 1) << 5)); }
__device__ __forceinline__ void stage_rc(int b, int& R, int& C) { const int st = b / 1024, sb = b % 1024, swz = sb ^ (((sb >> 9) & 1) << 5); R = (st >> 1) * 16 + swz / 64; C = (st & 1) * 32 + (swz % 64) / 2; }
__device__ __forceinline__ int perm32(int rho) { const int n = rho >> 4, i = rho & 15; return 8 * (i >> 2) + 4 * n + (i & 3); }

struct Unit { int pm, pn; };
struct Gemm { const bf16_t* A; const bf16_t* Bt; int lda, ldb, K, a_shift; };

template <bool WAITS, bool PUBLISHES> struct StaticOrderT {
    int nM, nN, nwg, G, c;
    __device__ void init(int Mr, int N, int G_, int c_) { nM = Mr / BM; nN = N / BM; nwg = nM * nN; G = G_; c = c_; }
    __device__ bool next(int i, Unit& u) const {
        const long L = (long)i * G + (c & 0xFFFF); if (L >= nwg) return false;
        int wgid = (int)L; { const int q = nwg / NXCD, r = nwg % NXCD, xcd = wgid % NXCD, off = wgid / NXCD; wgid = (xcd < r ? xcd * (q + 1) : r * (q + 1) + (xcd - r) * q) + off; }
        const int nig = WGM * nN, gid = wgid / nig, fm = gid * WGM, gsz = (nM - fm) < WGM ? (nM - fm) : WGM;
        u.pm = fm + ((wgid % nig) % gsz); u.pn = (wgid % nig) / gsz; return true;
    }
    const unsigned* ready = nullptr;
    __device__ __forceinline__ void a_ready(const Unit& u) const {
        if (!WAITS || ready == nullptr) return;
        if (threadIdx.x < 64) { unsigned sp = 0;
            while ((unsigned)__builtin_amdgcn_readfirstlane((int)__hip_atomic_load(ready + 16 * u.pm, __ATOMIC_RELAXED, __HIP_MEMORY_SCOPE_AGENT)) < 16u) {
                __builtin_amdgcn_s_sleep(1);
                if (++sp > (1u << 22)) break; }
            __builtin_amdgcn_fence(__ATOMIC_ACQUIRE, "agent");
            asm volatile("s_waitcnt vmcnt(0)" ::: "memory"); }
        asm volatile("" ::: "memory"); __builtin_amdgcn_s_barrier(); asm volatile("" ::: "memory");
    }
    __device__ __forceinline__ void publish() const {
        if (!PUBLISHES || (c >> 16) == 0) return;
        Unit u0; if (!next(0, u0)) return;
        if (threadIdx.x == 0) (void)__hip_atomic_fetch_add((unsigned*)(GAS unsigned*)ws_base_arg() + CW_HAND + ((c >> 16) - 1) * 1024 + 16 * u0.pm, (unsigned)((nwg >> 8) * (nN == 4 ? 4 : 1)), __ATOMIC_RELAXED, __HIP_MEMORY_SCOPE_AGENT);
    }
};
typedef StaticOrderT<false, false> StaticOrder;
struct GateOrder {
    int G, c;
    __device__ bool next(int i, Unit& u) const { const int p = c + (i >> 1) * G; if (p >= 256) return false; u.pm = p >> 2; u.pn = 4 * (i & 1) + (p & 3); return true; }
    __device__ __forceinline__ void a_ready(const Unit&) const {}
    __device__ __forceinline__ void publish() const {}
};

template <class Epi, class Sched>
__device__ __forceinline__ void gemm_phase(LAS unsigned char* lds, int tid, const Gemm g, const Sched& S, const Epi& E) {
    const int wid = __builtin_amdgcn_readfirstlane(tid >> 6), lane = tid & 63, wr = wid >> 2, wc = wid & 3, fr = lane & 15, fq = lane >> 4;
    int Kq = g.K; asm volatile("" : "+s"(Kq)); const int nt = Kq / BK;
    unsigned voffA[2], voffB[2];
#pragma unroll
    for (int i = 0; i < 2; ++i) { int R, C; stage_rc(tid * 16 + i * 8192, R, C); const int Rb = Epi::PERM ? ((R & ~31) + perm32(R & 31)) : R;
        voffA[i] = (unsigned)(R * g.lda + C) * 2u; voffB[i] = (unsigned)(Rb * g.ldb + C) * 2u; }
    const size_t kstep = (size_t)(BK * 2);
    const size_t hA = (size_t)HALF * g.lda * 2, hB = (size_t)HALF * g.ldb * 2;
    const size_t tA = 2 * hA, tB = 2 * hB;
    const unsigned ldsw = (unsigned)wid * 1024u;
    const int aoff = lds_byte(wr * 64 + fr, fq * 8), boff = lds_byte(wc * 32 + fr, fq * 8);
#define PG8_SA(b, h) (((b) * 2 + (h)) * HTB)
#define PG8_SB(b, h) ((4 + (b) * 2 + (h)) * HTB)
#define PG8_STAGE(bufoff, gbase, voff) do { _Pragma("unroll") for (int _i = 0; _i < 2; ++_i) \
        __builtin_amdgcn_global_load_lds((const unsigned*)((const char*)(gbase) + (voff)[_i]), (LAS unsigned*)(lds + (bufoff) + ldsw + _i * 8192), 16, 0, 0); } while (0)
#define PG8_LDA(dst, b, h) do { _Pragma("unroll") for (int m = 0; m < 4; ++m) _Pragma("unroll") for (int k = 0; k < 2; ++k) dst[m][k] = *(const LAS bf16x8*)(lds + PG8_SA(b, h) + aoff + m * 2048 + k * 1024); } while (0)
#define PG8_LDB(dst, b, h) do { _Pragma("unroll") for (int n = 0; n < 2; ++n) _Pragma("unroll") for (int k = 0; k < 2; ++k) dst[n][k] = *(const LAS bf16x8*)(lds + PG8_SB(b, h) + boff + n * 2048 + k * 1024); } while (0)
#define PG8_MMA(ai, bj, At, Bt) do { __builtin_amdgcn_s_setprio(1); _Pragma("unroll") for (int m = 0; m < 4; ++m) _Pragma("unroll") for (int n = 0; n < 2; ++n) _Pragma("unroll") for (int k = 0; k < 2; ++k) \
        acc[ai][bj][m][n] = __builtin_amdgcn_mfma_f32_16x16x32_bf16(Bt[n][k], At[m][k], acc[ai][bj][m][n], 0, 0, 0); __builtin_amdgcn_s_setprio(0); } while (0)
#define PG8_WAIT_V(n) asm volatile("s_waitcnt vmcnt(" #n ")" ::: "memory")
#define PG8_WAIT_L(n) asm volatile("s_waitcnt lgkmcnt(" #n ")" ::: "memory")
#define PG8_BAR __builtin_amdgcn_s_barrier()
#define PG8_SCHED __builtin_amdgcn_sched_barrier(0)
#define PG8_ABASE(u) ((const char*)g.A + (size_t)(u).pm * tA + (g.a_shift >= 0 ? (size_t)(((u).pn & g.a_shift) * 512) : (size_t)0))
#define PG8_BBASE(u) ((const char*)g.Bt + (size_t)(u).pn * tB + (g.a_shift >= 0 ? (size_t)(((u).pn & g.a_shift) * 512) : (size_t)0))
    Unit cur, nxt; int ui = 0;
    if (!S.next(0, cur)) return;
    S.a_ready(cur);
    f32x4 acc[2][2][4][2];
#pragma unroll
    for (int a = 0; a < 2; ++a)
#pragma unroll
        for (int b = 0; b < 2; ++b)
#pragma unroll
            for (int m = 0; m < 4; ++m)
#pragma unroll
                for (int n = 0; n < 2; ++n) acc[a][b][m][n] = (f32x4){0.f, 0.f, 0.f, 0.f};
    bf16x8 At[4][2], B0[2][2], B1[2][2];
    float rsv[2][4];
#pragma unroll
    for (int a = 0; a < 2; ++a)
#pragma unroll
        for (int m = 0; m < 4; ++m) rsv[a][m] = 1.0f;
    const char* cA = PG8_ABASE(cur); const char* cB = PG8_BBASE(cur);
    if (Epi::HAS_PRE) { f32x4 part[2][4]; E.pre_load(cur, wr, fr, fq, part);
        PG8_STAGE(PG8_SB(0, 0), cB, voffB); PG8_STAGE(PG8_SB(0, 1), cB + hB, voffB); PG8_STAGE(PG8_SA(0, 0), cA, voffA); PG8_STAGE(PG8_SA(0, 1), cA + hA, voffA);
        if (wr == 1) PG8_BAR;
        PG8_WAIT_V(2); PG8_BAR;
        E.pre_reduce(part, rsv);
    } else {
    PG8_STAGE(PG8_SB(0, 0), cB, voffB); PG8_STAGE(PG8_SB(0, 1), cB + hB, voffB); PG8_STAGE(PG8_SA(0, 0), cA, voffA); PG8_STAGE(PG8_SA(0, 1), cA + hA, voffA);
    if (wr == 1) PG8_BAR;
    PG8_WAIT_V(2); PG8_BAR; }
    PG8_STAGE(PG8_SB(1, 0), cB + kstep, voffB); PG8_STAGE(PG8_SA(1, 0), cA + kstep, voffA); PG8_STAGE(PG8_SB(1, 1), cB + hB + kstep, voffB);
    PG8_WAIT_V(6); PG8_BAR;
    for (;;) {
        const bool has_next = S.next(ui + 1, nxt);
        const char* nA = has_next ? PG8_ABASE(nxt) : cA; const char* nB = has_next ? PG8_BBASE(nxt) : cB;
        for (int t = 0; t < nt; t += 2) {
            const bool last = (t == nt - 2);
            const char* a1 = cA + (size_t)(t + 1) * kstep;
            const char* a2 = last ? nA : cA + (size_t)(t + 2) * kstep; const char* b2 = last ? nB : cB + (size_t)(t + 2) * kstep;
            const char* a3 = a2 + kstep; const char* b3 = b2 + kstep;
            PG8_LDB(B0, 0, 0); PG8_LDB(B1, 0, 1); PG8_SCHED; PG8_LDA(At, 0, 0); PG8_STAGE(PG8_SA(1, 1), a1 + hA, voffA);
            PG8_WAIT_V(8); PG8_WAIT_L(0); PG8_BAR; PG8_MMA(0, 0, At, B0); PG8_MMA(0, 1, At, B1); PG8_BAR; PG8_SCHED;
            PG8_LDA(At, 0, 1); PG8_STAGE(PG8_SB(0, 0), b2, voffB); PG8_STAGE(PG8_SB(0, 1), b2 + hB, voffB); PG8_STAGE(PG8_SA(0, 0), a2, voffA);
            PG8_WAIT_V(8); PG8_WAIT_L(0); PG8_BAR; PG8_MMA(1, 0, At, B0); PG8_MMA(1, 1, At, B1); PG8_BAR; PG8_SCHED;
            PG8_LDB(B0, 1, 0); PG8_LDB(B1, 1, 1); PG8_SCHED; PG8_LDA(At, 1, 0); PG8_STAGE(PG8_SA(0, 1), a2 + hA, voffA);
            PG8_WAIT_V(8); PG8_WAIT_L(0); PG8_BAR; PG8_MMA(0, 0, At, B0); PG8_MMA(0, 1, At, B1); PG8_BAR; PG8_SCHED;
            PG8_LDA(At, 1, 1); PG8_STAGE(PG8_SB(1, 0), b3, voffB); PG8_STAGE(PG8_SB(1, 1), b3 + hB, voffB); PG8_STAGE(PG8_SA(1, 0), a3, voffA);
            PG8_WAIT_V(8); PG8_WAIT_L(0); PG8_BAR; PG8_MMA(1, 0, At, B0); PG8_MMA(1, 1, At, B1); PG8_BAR; PG8_SCHED;
        }
        if (wr == 0) PG8_BAR;
        E(acc, cur, wr, wc, fr, fq, rsv);
        if (!has_next) break;
#pragma unroll
        for (int a = 0; a < 2; ++a)
#pragma unroll
            for (int b = 0; b < 2; ++b)
#pragma unroll
                for (int m = 0; m < 4; ++m)
#pragma unroll
                    for (int n = 0; n < 2; ++n) acc[a][b][m][n] = (f32x4){0.f, 0.f, 0.f, 0.f};
        cur = nxt; cA = nA; cB = nB; ++ui;
        if (Epi::HAS_PRE) { f32x4 part[2][4]; E.pre_load(cur, wr, fr, fq, part); E.pre_reduce(part, rsv); }
        if (wr == 1) PG8_BAR;
    }
    PG8_WAIT_V(0);
    PG8_BAR;
    S.publish();
#undef PG8_SA
#undef PG8_SB
#undef PG8_STAGE
#undef PG8_LDA
#undef PG8_LDB
#undef PG8_MMA
#undef PG8_WAIT_V
#undef PG8_WAIT_L
#undef PG8_BAR
#undef PG8_SCHED
#undef PG8_ABASE
#undef PG8_BBASE
}

__device__ __forceinline__ float row_rs(const float* ssq, int row) {
    const f32x4* p = (const f32x4*)(ssq + (size_t)row * 16); const f32x4 a = p[0], b = p[1], c = p[2], d = p[3];
    const float s = ((a.x + a.y) + (a.z + a.w)) + ((b.x + b.y) + (b.z + b.w)) + ((c.x + c.y) + (c.z + c.w)) + ((d.x + d.y) + (d.z + d.w));
    return rsqrtf(s * (1.0f / 1024.0f) + EPS);
}
__device__ __forceinline__ float gelu_tanh(float v) {
    const float u = 1.5957691216f * (v + 0.044715f * v * v * v);
    return v * __builtin_amdgcn_rcpf(1.0f + __builtin_amdgcn_exp2f(-1.44269504089f * u));
}
__device__ __forceinline__ float sigmoidf_(float z) { return __builtin_amdgcn_rcpf(1.0f + __builtin_amdgcn_exp2f(-1.44269504089f * z)); }

template <int MODE> struct EpiScale {
    static constexpr bool PERM = true;
    static constexpr bool HAS_PRE = (MODE != 2);
    bf16_t* O; int ldc; const float* ssq;
    __device__ __forceinline__ void pre_load(const Unit& u, int wr, int fr, int fq, f32x4 (&part)[2][4]) const {
        const int row0 = u.pm * BM + wr * 64 + fr;
#pragma unroll
        for (int ai = 0; ai < 2; ++ai)
#pragma unroll
            for (int m = 0; m < 4; ++m) part[ai][m] = *(const f32x4*)(ssq + (size_t)(row0 + ai * HALF + m * 16) * 16 + 4 * fq);
    }
    __device__ __forceinline__ void pre_reduce(const f32x4 (&part)[2][4], float (&rsv)[2][4]) const {
#pragma unroll
        for (int ai = 0; ai < 2; ++ai)
#pragma unroll
            for (int m = 0; m < 4; ++m) { float t = (part[ai][m].x + part[ai][m].y) + (part[ai][m].z + part[ai][m].w); t += __shfl_xor(t, 16); t += __shfl_xor(t, 32); rsv[ai][m] = rsqrtf(t * (1.0f / 1024.0f) + EPS); }
    }
    __device__ __forceinline__ void operator()(const f32x4 (&acc)[2][2][4][2], const Unit& u, int wr, int wc, int fr, int fq, const float (&rsv)[2][4]) const {
        const int row0 = u.pm * BM + wr * 64 + fr, col0 = u.pn * BM + wc * 32 + 8 * fq;
        const bool act = (MODE == 1) && (u.pn < 4);
#pragma unroll
        for (int ai = 0; ai < 2; ++ai)
#pragma unroll
            for (int m = 0; m < 4; ++m) { const int row = row0 + ai * HALF + m * 16; const float rs = rsv[ai][m]; bf16_t* rowp = O + (size_t)row * ldc + col0;
#pragma unroll
                for (int bj = 0; bj < 2; ++bj) { f32x4 v0 = acc[ai][bj][m][0], v1 = acc[ai][bj][m][1];
                    if (MODE != 2) { v0 = v0 * rs; v1 = v1 * rs; }
                    if (MODE == 1) { if (act) {
#pragma unroll
                        for (int e = 0; e < 4; ++e) { v0[e] = gelu_tanh(v0[e]); v1[e] = gelu_tanh(v1[e]); } } }
                    if (MODE == 2) {
#pragma unroll
                        for (int e = 0; e < 4; ++e) { const float a = fmaxf(v0[e], 0.f), b = fmaxf(v1[e], 0.f); v0[e] = a * a; v1[e] = b * b; } }
                    u32x4 w; w.x = cvt_pk_bf16(v0[0], v0[1]); w.y = cvt_pk_bf16(v0[2], v0[3]); w.z = cvt_pk_bf16(v1[0], v1[1]); w.w = cvt_pk_bf16(v1[2], v1[3]);
                    store16_wt(rowp + bj * HALF, w); } }
    }
};
struct EpiGate {
    static constexpr bool PERM = true;
    static constexpr bool HAS_PRE = false;
    bf16_t* R; bf16_t* I; const float* ba; const float* bx;
    __device__ __forceinline__ void pre_load(const Unit&, int, int, int, f32x4 (&)[2][4]) const {}
    __device__ __forceinline__ void pre_reduce(const f32x4 (&)[2][4], float (&)[2][4]) const {}
    __device__ __forceinline__ void operator()(const f32x4 (&acc)[2][2][4][2], const Unit& u, int wr, int wc, int fr, int fq, const float (&)[2][4]) const {
        const int which = u.pn >> 2, blk = u.pn & 3;
        bf16_t* O = which ? I : R; const float* bias = which ? bx : ba;
        const int row0 = u.pm * BM + wr * 64 + fr, col0 = blk * BM + wc * 32 + 8 * fq;
#pragma unroll
        for (int bj = 0; bj < 2; ++bj) {
            const f32x4 bv0 = *(const f32x4*)(bias + col0 + bj * HALF), bv1 = *(const f32x4*)(bias + col0 + bj * HALF + 4);
#pragma unroll
            for (int ai = 0; ai < 2; ++ai)
#pragma unroll
                for (int m = 0; m < 4; ++m) { bf16_t* rowp = O + (size_t)(row0 + ai * HALF + m * 16) * D + col0;
                    f32x4 v0 = acc[ai][bj][m][0] + bv0, v1 = acc[ai][bj][m][1] + bv1;
#pragma unroll
                    for (int e = 0; e < 4; ++e) { v0[e] = sigmoidf_(v0[e]); v1[e] = sigmoidf_(v1[e]); }
                    u32x4 w; w.x = cvt_pk_bf16(v0[0], v0[1]); w.y = cvt_pk_bf16(v0[2], v0[3]); w.z = cvt_pk_bf16(v1[0], v1[1]); w.w = cvt_pk_bf16(v1[2], v1[3]);
                    store16_wt(rowp + bj * HALF, w); }
        }
    }
};
template <bool SCALE> struct EpiRes {
    static constexpr bool PERM = true;
    static constexpr bool HAS_PRE = false;
    bf16_t* xb; float* ssq; const float* ssq_in;
    __device__ __forceinline__ void pre_load(const Unit&, int, int, int, f32x4 (&)[2][4]) const {}
    __device__ __forceinline__ void pre_reduce(const f32x4 (&)[2][4], float (&)[2][4]) const {}
    __device__ __forceinline__ void operator()(const f32x4 (&acc)[2][2][4][2], const Unit& u, int wr, int wc, int fr, int fq, const float (&)[2][4]) const {
        const int col0 = u.pn * BM + wc * 32 + 8 * fq;
        u32x4 o[2][4][2];
#define EPIRES_LOAD(ai) do { _Pragma("unroll") for (int m = 0; m < 4; ++m) { const size_t off_ = (size_t)(u.pm * BM + (ai) * HALF + wr * 64 + m * 16 + fr) * D + col0; \
            _Pragma("unroll") for (int bj = 0; bj < 2; ++bj) o[ai][m][bj] = *(const u32x4*)(xb + off_ + bj * HALF); } } while (0)
        if (!SCALE) { EPIRES_LOAD(0); EPIRES_LOAD(1); }
#pragma unroll
        for (int ai = 0; ai < 2; ++ai) {
            f32x4 part_[4];
            if (SCALE) {
#pragma unroll
                for (int m = 0; m < 4; ++m) part_[m] = *(const f32x4*)(ssq_in + (size_t)(u.pm * BM + ai * HALF + wr * 64 + m * 16 + fr) * 16 + 4 * fq);
                if (ai == 0) EPIRES_LOAD(0); else EPIRES_LOAD(1); }
#pragma unroll
            for (int m = 0; m < 4; ++m) { const int row = u.pm * BM + ai * HALF + wr * 64 + m * 16 + fr; const size_t off = (size_t)row * D + col0; float part = 0.f;
                float rs2 = 1.0f;
                if (SCALE) { float t = (part_[m].x + part_[m].y) + (part_[m].z + part_[m].w); t += __shfl_xor(t, 16); t += __shfl_xor(t, 32); rs2 = __builtin_amdgcn_rcpf(t * (1.0f / 1024.0f) + EPS); }
#pragma unroll
                for (int bj = 0; bj < 2; ++bj) { const u32x4 xo = o[ai][m][bj]; f32x4 a0 = acc[ai][bj][m][0], a1 = acc[ai][bj][m][1];
                    if (SCALE) { a0 = a0 * rs2; a1 = a1 * rs2; }
                    const float v0 = bflo(xo.x) + a0[0], v1 = bfhi(xo.x) + a0[1], v2 = bflo(xo.y) + a0[2], v3 = bfhi(xo.y) + a0[3];
                    const float v4 = bflo(xo.z) + a1[0], v5 = bfhi(xo.z) + a1[1], v6 = bflo(xo.w) + a1[2], v7 = bfhi(xo.w) + a1[3];
                    u32x4 w; w.x = cvt_pk_bf16(v0, v1); w.y = cvt_pk_bf16(v2, v3); w.z = cvt_pk_bf16(v4, v5); w.w = cvt_pk_bf16(v6, v7); store16_wt(xb + off + bj * HALF, w);
                    part += ((v0 * v0 + v1 * v1) + (v2 * v2 + v3 * v3)) + ((v4 * v4 + v5 * v5) + (v6 * v6 + v7 * v7)); }
                part += __shfl_xor(part, 16); part += __shfl_xor(part, 32);
                if (fq == 0) __hip_atomic_store((GAS unsigned*)(ssq + (size_t)row * 16 + u.pn * 4 + wc), __float_as_uint(part), __ATOMIC_RELAXED, __HIP_MEMORY_SCOPE_AGENT); }
            asm volatile("" ::: "memory");
        }
#undef EPIRES_LOAD
    }
};
}

struct Args { const float* in[21]; float* out; unsigned char* ws; int ph_lo, ph_hi; };
static_assert(sizeof(Args) == 21 * 8 + 8 + 8 + 8, "Args has no padding");

struct Frame {
    LAS unsigned char* lds;
    int tid, lane, wave, G, vcu, bid;
};
__device__ __forceinline__ Frame launder(const Frame& F0) {
    Frame F = F0; int t = F0.tid, w = F0.wave, g = F0.G, v = F0.vcu, b = F0.bid;
    asm volatile("" : "+v"(t)); asm volatile("" : "+s"(w)); asm volatile("" : "+s"(g)); asm volatile("" : "+s"(v)); asm volatile("" : "+s"(b));
    F.tid = t; F.lane = t & 63; F.wave = w; F.G = g; F.vcu = v; F.bid = b; return F;
}

__device__ __forceinline__ void cvt_item(const float* W, int ldw, const float* gamma, float scale, bf16_t* Bt, int ldb, int nblk, int nvalid, LAS float* scr, int item, int lane) {
    const int kb = item / nblk, nb = item % nblk, k0 = 64 * kb, n0 = 32 * nb;
    const int nn = lane & 31; const bool ok = (n0 + nn) < nvalid;
    if (n0 + 32 <= nvalid && ((((size_t)W) | ((size_t)ldw * 4u)) & 15u) == 0) {
        const int c4 = (lane & 7) * 4, r8 = lane >> 3; f32x4 v[8];
#pragma unroll
        for (int i = 0; i < 8; ++i) v[i] = __builtin_nontemporal_load((const f32x4*)(W + (size_t)(k0 + 8 * i + r8) * ldw + n0 + c4));
#pragma unroll
        for (int i = 0; i < 8; ++i) { const int kk = 8 * i + r8; const float gs = (gamma ? gamma[k0 + kk] : 1.0f) * scale; LAS float* d = scr + kk * 33 + c4;
            d[0] = v[i].x * gs; d[1] = v[i].y * gs; d[2] = v[i].z * gs; d[3] = v[i].w * gs; }
    } else
#pragma unroll 8
    for (int i = 0; i < 32; ++i) { const int kk = 2 * i + (lane >> 5); float v = ok ? __builtin_nontemporal_load(W + (size_t)(k0 + kk) * ldw + n0 + nn) : 0.f;     v *= (gamma ? gamma[k0 + kk] : 1.0f) * scale; scr[kk * 33 + nn] = v; }
    LDS_WAIT(); asm volatile("" ::: "memory");
    const int c = lane & 7;
#pragma unroll
    for (int j = 0; j < 4; ++j) { const int n = (lane >> 3) + 8 * j; const LAS float* s = scr + (8 * c) * 33 + n;
        u32x4 o; o.x = cvt_pk_bf16(s[0 * 33], s[1 * 33]); o.y = cvt_pk_bf16(s[2 * 33], s[3 * 33]); o.z = cvt_pk_bf16(s[4 * 33], s[5 * 33]); o.w = cvt_pk_bf16(s[6 * 33], s[7 * 33]);
        store16_wt(Bt + (size_t)(n0 + n) * ldb + k0 + 8 * c, o); }
    LDS_WAIT(); asm volatile("" ::: "memory");
}
__device__ __forceinline__ bf16x8 pack8(const f32x4 a, const f32x4 b) { const u32x4 w = {cvt_pk_bf16(a.x, a.y), cvt_pk_bf16(a.z, a.w), cvt_pk_bf16(b.x, b.y), cvt_pk_bf16(b.z, b.w)}; return __builtin_bit_cast(bf16x8, w); }
__device__ __forceinline__ void qlat_item(const float* Win, const float* wuk, const float* gamma, float scale, bf16_t* Bt, int item, int chalf, int lane) {
    const int h = item >> 4, k0 = (item & 15) << 6, cb = 64 * chalf, fr = lane & 15, fq = lane >> 4;
    bf16x8 X[4][2], Y[4][2];
    { f32x4 xa[4][2], xb[4][2]; float gs[4];
#pragma unroll
      for (int kt = 0; kt < 4; ++kt) { const int k = k0 + 16 * kt + fr; gs[kt] = gamma[k] * scale; const f32x4* p = (const f32x4*)(Win + (size_t)k * ATT_IN + h * 64 + 8 * fq);
#pragma unroll
          for (int s_ = 0; s_ < 2; ++s_) { xa[kt][s_] = p[8 * s_]; xb[kt][s_] = p[8 * s_ + 1]; } }
#pragma unroll
      for (int kt = 0; kt < 4; ++kt)
#pragma unroll
          for (int s_ = 0; s_ < 2; ++s_) X[kt][s_] = pack8(xa[kt][s_] * gs[kt], xb[kt][s_] * gs[kt]); }
#pragma unroll
    for (int ct = 0; ct < 4; ++ct)
#pragma unroll
        for (int s_ = 0; s_ < 2; ++s_) { const float* p = wuk + (size_t)h * 64 * 128 + (size_t)(32 * s_ + 8 * fq) * 128 + cb + 16 * ct + fr;
            const f32x4 ya = {p[0], p[128], p[256], p[384]}, yb = {p[512], p[640], p[768], p[896]}; Y[ct][s_] = pack8(ya, yb); }
#pragma unroll
    for (int ct = 0; ct < 4; ++ct)
#pragma unroll
        for (int kt = 0; kt < 4; ++kt) { f32x4 acc = {0.f, 0.f, 0.f, 0.f};
#pragma unroll
            for (int s_ = 0; s_ < 2; ++s_) acc = __builtin_amdgcn_mfma_f32_16x16x32_bf16(X[kt][s_], Y[ct][s_], acc, 0, 0, 0);
            u32x2 o; o.x = cvt_pk_bf16(acc[0], acc[1]); o.y = cvt_pk_bf16(acc[2], acc[3]);
            *(u32x2*)(Bt + (size_t)(h * 128 + cb + 16 * ct + fr) * D + k0 + 16 * kt + 4 * fq) = o; }
}
__device__ __forceinline__ void comb_item(const float* wuv, const float* wo, bf16_t* Bt, int item, int chalf, int lane) {
    const int h = item >> 4, n0 = (item & 15) << 6, cb = 64 * chalf, fr = lane & 15, fq = lane >> 4;
    bf16x8 X[4][2], Y[4][2];
#pragma unroll
    for (int ct = 0; ct < 4; ++ct) { const f32x4* p = (const f32x4*)(wuv + (size_t)h * 128 * 64 + (size_t)(cb + 16 * ct + fr) * 64 + 8 * fq);
#pragma unroll
        for (int s_ = 0; s_ < 2; ++s_) X[ct][s_] = pack8(p[8 * s_], p[8 * s_ + 1]); }
#pragma unroll
    for (int nt = 0; nt < 4; ++nt)
#pragma unroll
        for (int s_ = 0; s_ < 2; ++s_) { const float* p = wo + (size_t)(h * 64 + 32 * s_ + 8 * fq) * D + n0 + 16 * nt + fr;
            const f32x4 ya = {p[0], p[D], p[2 * D], p[3 * D]}, yb = {p[4 * D], p[5 * D], p[6 * D], p[7 * D]}; Y[nt][s_] = pack8(ya, yb); }
#pragma unroll
    for (int nt = 0; nt < 4; ++nt)
#pragma unroll
        for (int ct = 0; ct < 4; ++ct) { f32x4 acc = {0.f, 0.f, 0.f, 0.f};
#pragma unroll
            for (int s_ = 0; s_ < 2; ++s_) acc = __builtin_amdgcn_mfma_f32_16x16x32_bf16(X[ct][s_], Y[nt][s_], acc, 0, 0, 0);
            u32x2 o; o.x = cvt_pk_bf16(acc[0], acc[1]); o.y = cvt_pk_bf16(acc[2], acc[3]);
            *(u32x2*)(Bt + (size_t)(n0 + 16 * nt + fr) * 2048 + h * 128 + cb + 16 * ct + 4 * fq) = o; }
}

struct Ptrs {
    const float* in[21]; float* out; unsigned char* ws;
};
__device__ __forceinline__ unsigned long long argq(int k) {
    asm volatile("" : "+s"(k));
    return ((const __attribute__((address_space(4))) unsigned long long*)__builtin_amdgcn_kernarg_segment_ptr())[k];
}
__device__ __forceinline__ Ptrs load_ptrs() {
    Ptrs P;
#pragma unroll
    for (int i = 0; i < 21; ++i) P.in[i] = (const float*)(GAS const float*)argq(i);
    P.out = (float*)(GAS float*)argq(21); P.ws = (unsigned char*)(GAS unsigned char*)argq(22);
    return P;
}

__device__ __forceinline__ void cvt_rec_mix(const Frame& F, const Ptrs& P, int j, int L) {
    LAS float* scr = (LAS float*)(F.lds + F.wave * 16384);
    bf16_t* WM = (bf16_t*)(P.ws + WS_WMIX);
    const int gw = F.vcu * NWAVES + F.wave, NGW = F.G * NWAVES;
    constexpr int I_IN = 16 * 64, I_G = 4 * 8, I_OUT = 16 * 32, I_Z = 8 * 3 * 8;
    constexpr int NITEMS = I_IN + 8 * I_G + I_OUT + I_Z;
    for (int it = gw; it < NITEMS; it += NGW) {
        int r = it;
        if (r < I_IN) { cvt_item(P.in[4] + (size_t)j * D * 2048, 2048, P.in[1] + L * D, 1.f, WM, D, 64, 2048, scr, r, F.lane); continue; } r -= I_IN;
        if (r < 8 * I_G) { const int blk = r / (2 * I_G), which = (r / I_G) & 1, ri = r % I_G;
            cvt_item(P.in[which ? 9 : 7] + (size_t)(j * 4 + blk) * 65536, 256, nullptr, 1.f, WM + WM_REC_GATE + (size_t)(which * 1024 + blk * 256) * D + blk * 256, D, 8, 256, scr, ri, F.lane); continue; } r -= 8 * I_G;
        if (r < I_OUT) { cvt_item(P.in[12] + (size_t)j * D * D, D, nullptr, 1.f, WM + WM_REC_OUT, D, 32, D, scr, r, F.lane); continue; } r -= I_OUT;
        {
            const int rb = r / 24, cbi = (r / 8) % 3, piece = r & 7, blk = rb & 3, cb = cbi + (cbi >= blk ? 1 : 0);
            bf16_t* z = WM + WM_REC_GATE + (size_t)(rb * 256 + piece * 32) * D + cb * 256;
#pragma unroll
            for (int q = 0; q < 16; ++q) { const int e = q * 64 + F.lane, rr = e >> 5, cc = (e & 31) * 8; *(u32x4*)(z + (size_t)rr * D + cc) = (u32x4){0u, 0u, 0u, 0u}; }
        }
    }
}
__device__ __forceinline__ void cvt_att_mix(const Frame& F, const Ptrs& P, int j, int L, int rot = 0) {
    LAS float* scr = (LAS float*)(F.lds + F.wave * 16384);
    bf16_t* WM = (bf16_t*)(P.ws + WS_WATT + (size_t)j * 10 * MiB);
    const int NGW = F.G * NWAVES, gw = (F.vcu * NWAVES + F.wave + NGW - rot) % NGW;
    const float* Win = P.in[13] + (size_t)j * D * ATT_IN; const float* gam = P.in[1] + L * D;
    constexpr int I_H = 512, I_C = 16 * 22, I_W = 16 * 2;
    constexpr int NITEMS = 2 * I_H + I_C + I_W;
    for (int it = gw; it < NITEMS; it += NGW) {
        int r = it;
        if (r < I_H) { qlat_item(Win, P.in[15] + (size_t)j * 16 * 64 * 128, gam, 0.125f, WM, r >> 1, r & 1, F.lane); continue; } r -= I_H;
        if (r < I_H) { comb_item(P.in[16] + (size_t)j * 16 * 128 * 64, P.in[17] + (size_t)j * D * D, WM + WM_ATT_COMB, r >> 1, r & 1, F.lane); continue; } r -= I_H;
        if (r < I_C) { cvt_item(Win + 1024, ATT_IN, gam, 1.f, WM + (size_t)2048 * D, D, 22, 704, scr, r, F.lane); continue; } r -= I_C;
        cvt_item(Win + 1728, ATT_IN, gam, 0.044194173824159216f, WM + (size_t)2752 * D, D, 2, 8, scr, r, F.lane);
    }
}
__device__ __forceinline__ void cvt_up(const Frame& F, const Ptrs& P, int L) {
    LAS float* scr = (LAS float*)(F.lds + F.wave * 16384);
    const int gw = F.vcu * NWAVES + F.wave, NGW = F.G * NWAVES;
    for (int it = gw; it < 16 * 128; it += NGW) cvt_item(P.in[19] + (size_t)L * D * FF, FF, P.in[2] + L * D, 1.f, (bf16_t*)(P.ws + WS_WUP), D, 128, FF, scr, it, F.lane);
}
__device__ __forceinline__ void cvt_down(const Frame& F, const Ptrs& P, int L) {
    LAS float* scr = (LAS float*)(F.lds + F.wave * 16384);
    const int gw = F.vcu * NWAVES + F.wave, NGW = F.G * NWAVES;
    for (int it = gw; it < 64 * 32; it += NGW) cvt_item(P.in[20] + (size_t)L * FF * D, D, nullptr, 1.f, (bf16_t*)(P.ws + WS_WDOWN), FF, 32, D, scr, it, F.lane);
}

__device__ __forceinline__ void p0_rows(const Frame& F, const Ptrs& P) {
    const int gw = F.vcu * NWAVES + F.wave, NGW = F.G * NWAVES;
    bf16_t* XB = (bf16_t*)(P.ws + WS_XB); float* SSQ = (float*)(P.ws + WS_SSQ);
    for (int m = gw; m < M; m += NGW) {
        const f32x4* xr = (const f32x4*)(P.in[0] + (size_t)m * D) + F.lane; float s = 0.f; f32x4 v[4];
#pragma unroll
        for (int jj = 0; jj < 4; ++jj) { v[jj] = __builtin_nontemporal_load(xr + 64 * jj); s += (v[jj].x * v[jj].x + v[jj].y * v[jj].y) + (v[jj].z * v[jj].z + v[jj].w * v[jj].w); }
        s = wave_sum(s);
        u32x2* o = (u32x2*)(XB + (size_t)m * D) + F.lane;
#pragma unroll
        for (int jj = 0; jj < 4; ++jj) { u32x2 w; w.x = cvt_pk_bf16(v[jj].x, v[jj].y); w.y = cvt_pk_bf16(v[jj].z, v[jj].w); o[64 * jj] = w; }
        if (F.lane < 16) SSQ[(size_t)m * 16 + F.lane] = (F.lane == 0) ? s : 0.f;
    }
}
__device__ __forceinline__ void final_norm(const Frame& F, const Ptrs& P, bool dry = false) {
    const int gw = F.vcu * NWAVES + F.wave, NGW = F.G * NWAVES;
    const float* SSQ = (const float*)(P.ws + WS_SSQ); const f32x4* g = (const f32x4*)P.in[3] + F.lane; const bf16_t* XB = (const bf16_t*)(P.ws + WS_XB);
    for (int m = gw; m < M; m += NGW) {
        f32x4* xr = (f32x4*)(P.out + (size_t)m * D) + F.lane; const u32x2* xi = (const u32x2*)(XB + (size_t)m * D) + F.lane; const float rs = pg8::row_rs(SSQ, m);
#pragma unroll
        for (int jj = 0; jj < 4; ++jj) { const u32x2 xv = xi[64 * jj]; const f32x4 v = {bflo(xv.x), bfhi(xv.x), bflo(xv.y), bfhi(xv.y)}; const f32x4 gg = g[64 * jj]; const f32x4 w = v * rs * gg; __builtin_nontemporal_store(dry ? v : w, xr + 64 * jj); }
    }
}
__device__ __forceinline__ void conv_tile(const Frame& F, const Ptrs& P, int j, int pm, int blk) {
    const bf16_t* GX = (const bf16_t*)(P.ws + WS_GX); bf16_t* XC = (bf16_t*)(P.ws + WS_XC);
    const int cp = F.tid & 127, rq = F.tid >> 7, ch = blk * 256 + 2 * cp, r0 = pm * 256 + rq * 64;
    const float* cw = P.in[5] + (size_t)j * 4 * D + ch; const float* cb = P.in[6] + (size_t)j * D + ch;
    const f32x2 w0 = *(const f32x2*)(cw), w1 = *(const f32x2*)(cw + D), w2 = *(const f32x2*)(cw + 2 * D), w3 = *(const f32x2*)(cw + 3 * D), bb = *(const f32x2*)cb;
    const unsigned* xr = (const unsigned*)(GX + (size_t)r0 * 2048 + 1024 + ch);
    unsigned x0 = 0u, x1 = 0u, x2 = 0u;
    if ((r0 & (SEQ - 1)) != 0) { x0 = xr[-3 * 1024]; x1 = xr[-2 * 1024]; x2 = xr[-1 * 1024]; }
    unsigned* xo = (unsigned*)(XC + (size_t)r0 * D + ch);
    for (int tb = 0; tb < 64; tb += 16) {
        unsigned xin[16];
#pragma unroll
        for (int q = 0; q < 16; ++q) xin[q] = xr[(size_t)(tb + q) * 1024];
#pragma unroll
        for (int q = 0; q < 16; ++q) {
            const unsigned x3 = xin[q];
            const float a = bb.x + w0.x * bflo(x0) + w1.x * bflo(x1) + w2.x * bflo(x2) + w3.x * bflo(x3);
            const float b = bb.y + w0.y * bfhi(x0) + w1.y * bfhi(x1) + w2.y * bfhi(x2) + w3.y * bfhi(x3);
            xo[(size_t)(tb + q) * 512] = cvt_pk_bf16(a, b);
            x0 = x1; x1 = x2; x2 = x3;
        }
    }
}

__device__ __forceinline__ void scan_phase(const Frame& F, const Ptrs& P, int j, bool dry = false) {
    LAS float* sA = (LAS float*)F.lds; LAS float* sH = sA + 32 * 32; LAS unsigned* sU = (LAS unsigned*)(F.lds + 16384);
    bf16_t* GX = (bf16_t*)(P.ws + WS_GX); const bf16_t* XC = (const bf16_t*)(P.ws + WS_XC);
    const bf16_t* RB = (const bf16_t*)(P.ws + WS_RB); const bf16_t* IB = (const bf16_t*)(P.ws + WS_IB);
    const int c2 = F.tid & 15, chunk = F.tid >> 4;
    for (int u = F.vcu; u < BATCH * 32; u += F.G) {
        const int b = u >> 5, cg = u & 31, ch = cg * 32 + 2 * c2; const size_t row0 = (size_t)b * SEQ + chunk * 64;
        const f32x2 lam = *(const f32x2*)(P.in[11] + (size_t)j * D + ch);
        const float sp0 = -8.0f * log1pf(expf(-lam.x)), sp1 = -8.0f * log1pf(expf(-lam.y));
        const unsigned* rp = (const unsigned*)(RB + row0 * D + ch); const unsigned* ip = (const unsigned*)(IB + row0 * D + ch); const unsigned* xp = (const unsigned*)(XC + row0 * D + ch);
        float A0 = 1.f, A1 = 1.f, h0 = 0.f, h1 = 0.f;
        constexpr int SB = 16;
        unsigned rn[SB], in_[SB], xn[SB];
#pragma unroll
        for (int q = 0; q < SB; ++q) { rn[q] = rp[(size_t)q * 512]; in_[q] = ip[(size_t)q * 512]; xn[q] = xp[(size_t)q * 512]; }
        for (int tb = 0; tb < 64; tb += SB) {
            unsigned rr[SB], ii[SB], xx[SB];
#pragma unroll
            for (int q = 0; q < SB; ++q) { rr[q] = rn[q]; ii[q] = in_[q]; xx[q] = xn[q]; }
            if (tb + SB < 64) {
#pragma unroll
                for (int q = 0; q < SB; ++q) { rn[q] = rp[(size_t)(tb + SB + q) * 512]; in_[q] = ip[(size_t)(tb + SB + q) * 512]; xn[q] = xp[(size_t)(tb + SB + q) * 512]; } }
#pragma unroll
            for (int q = 0; q < SB; ++q) { const unsigned r = rr[q], i = ii[q], x = xx[q];
                const float a0 = __expf(sp0 * bflo(r)), a1 = __expf(sp1 * bfhi(r));
                const float u0 = sqrtf(fmaxf(fmaf(-a0, a0, 1.0f), 0.f)) * (bflo(i) * bflo(x)), u1 = sqrtf(fmaxf(fmaf(-a1, a1, 1.0f), 0.f)) * (bfhi(i) * bfhi(x));
                A0 *= a0; A1 *= a1; h0 = fmaf(a0, h0, u0); h1 = fmaf(a1, h1, u1);
                sU[(tb + q) * 512 + F.tid] = cvt_pk_bf16(u0, u1); }
        }
        unsigned* gp = (unsigned*)(GX + row0 * 2048 + ch);
        unsigned gn[SB];
#pragma unroll
        for (int q = 0; q < SB; ++q) { rn[q] = rp[(size_t)q * 512]; gn[q] = gp[(size_t)q * 1024]; }
        sA[chunk * 32 + 2 * c2] = A0; sA[chunk * 32 + 2 * c2 + 1] = A1; sH[chunk * 32 + 2 * c2] = h0; sH[chunk * 32 + 2 * c2 + 1] = h1;
        __syncthreads();
        h0 = 0.f; h1 = 0.f;
        for (int k = 0; k < chunk; ++k) { h0 = fmaf(sA[k * 32 + 2 * c2], h0, sH[k * 32 + 2 * c2]); h1 = fmaf(sA[k * 32 + 2 * c2 + 1], h1, sH[k * 32 + 2 * c2 + 1]); }
        for (int tb = 0; tb < 64; tb += SB) {
            unsigned rr[SB], gg[SB];
#pragma unroll
            for (int q = 0; q < SB; ++q) { rr[q] = rn[q]; gg[q] = gn[q]; }
            if (tb + SB < 64) {
#pragma unroll
                for (int q = 0; q < SB; ++q) { rn[q] = rp[(size_t)(tb + SB + q) * 512]; gn[q] = gp[(size_t)(tb + SB + q) * 1024]; } }
#pragma unroll
            for (int q = 0; q < SB; ++q) { const unsigned r = rr[q], gt = gg[q], uu = sU[(tb + q) * 512 + F.tid];
                const float a0 = __expf(sp0 * bflo(r)), a1 = __expf(sp1 * bfhi(r));
                const float u0 = bflo(uu), u1 = bfhi(uu);
                h0 = fmaf(a0, h0, u0); h1 = fmaf(a1, h1, u1);
                gp[(size_t)(tb + q) * 1024] = dry ? gt : cvt_pk_bf16(h0 * bflo(gt), h1 * bfhi(gt)); }
        }
        __syncthreads();
    }
}

__device__ __forceinline__ unsigned f2key(float f) { const unsigned u = __float_as_uint(f + 0.0f); return u ^ ((unsigned)((int)u >> 31) | 0x80000000u); }
__device__ __forceinline__ int wave_sum_dpp(int x) {
    x += __builtin_amdgcn_update_dpp(0, x, 0x111, 0xF, 0xF, false);
    x += __builtin_amdgcn_update_dpp(0, x, 0x112, 0xF, 0xF, false);
    x += __builtin_amdgcn_update_dpp(0, x, 0x114, 0xF, 0xF, false);
    x += __builtin_amdgcn_update_dpp(0, x, 0x118, 0xF, 0xF, false);
    x += __builtin_amdgcn_update_dpp(0, x, 0x142, 0xA, 0xF, false);
    x += __builtin_amdgcn_update_dpp(0, x, 0x143, 0xC, 0xF, false);
    return __builtin_amdgcn_readlane(x, 63);
}
__device__ __forceinline__ float wave_sum_f32_dpp(float v) {
#define WSF_STEP(ctrl, rmask) v += __int_as_float(__builtin_amdgcn_update_dpp(0, __float_as_int(v), ctrl, rmask, 0xF, false))
    WSF_STEP(0x111, 0xF); WSF_STEP(0x112, 0xF); WSF_STEP(0x114, 0xF); WSF_STEP(0x118, 0xF); WSF_STEP(0x142, 0xA); WSF_STEP(0x143, 0xC);
#undef WSF_STEP
    return __int_as_float(__builtin_amdgcn_readlane(__float_as_int(v), 63));
}
__device__ __forceinline__ int wave_scan_dpp(int x) {
    x += __builtin_amdgcn_update_dpp(0, x, 0x111, 0xF, 0xF, false);
    x += __builtin_amdgcn_update_dpp(0, x, 0x112, 0xF, 0xF, false);
    x += __builtin_amdgcn_update_dpp(0, x, 0x114, 0xF, 0xF, false);
    x += __builtin_amdgcn_update_dpp(0, x, 0x118, 0xF, 0xF, false);
    x += __builtin_amdgcn_update_dpp(0, x, 0x142, 0xA, 0xF, false);
    x += __builtin_amdgcn_update_dpp(0, x, 0x143, 0xC, 0xF, false);
    return x;
}
template <int NR>
__device__ __forceinline__ void idx_select(const LAS float* scq, int pos, int lane, const LAS unsigned char* bkL, unsigned short* out) {
    unsigned keys[NR];
#pragma unroll
    for (int jj = 0; jj < NR; ++jj) { const int idx = lane + 64 * jj; const float v = scq[idx]; keys[jj] = (idx <= pos) ? f2key(v) : 0u; }
    unsigned T = 0u; bool exact = false; int cl_last = 0;
    for (int bit = 31; bit >= 0; --bit) {
        const unsigned cand = (unsigned)__builtin_amdgcn_readfirstlane((int)(T | (1u << bit)));
        unsigned c0 = 0, c1 = 0, c2 = 0, c3 = 0;
#define IDX_CMP4(a_, b_, c_, d_) "v_cmp_ge_u32_e64 %4, %" #a_ ", %[cd]\n\tv_cmp_ge_u32_e64 %5, %" #b_ ", %[cd]\n\tv_cmp_ge_u32_e64 %6, %" #c_ ", %[cd]\n\tv_cmp_ge_u32_e64 %7, %" #d_ ", %[cd]\n\t" \
                                 "v_addc_co_u32_e64 %0, %4, 0, %0, %4\n\tv_addc_co_u32_e64 %1, %5, 0, %1, %5\n\tv_addc_co_u32_e64 %2, %6, 0, %2, %6\n\tv_addc_co_u32_e64 %3, %7, 0, %3, %7\n\t"
#pragma unroll
        for (int jj = 0; jj < NR; jj += 8) { unsigned long long m0, m1, m2, m3;
            asm volatile(IDX_CMP4(8, 9, 10, 11) IDX_CMP4(12, 13, 14, 15)
                         : "+v"(c0), "+v"(c1), "+v"(c2), "+v"(c3), "=&s"(m0), "=&s"(m1), "=&s"(m2), "=&s"(m3)
                         : "v"(keys[jj]), "v"(keys[jj + 1]), "v"(keys[jj + 2]), "v"(keys[jj + 3]), "v"(keys[jj + 4]), "v"(keys[jj + 5]), "v"(keys[jj + 6]), "v"(keys[jj + 7]), [cd] "s"(cand)); }
#undef IDX_CMP4
        cl_last = (int)((c0 + c1) + (c2 + c3));
        const int cnt = wave_sum_dpp(cl_last);
        if (cnt >= TOPK) T = cand;
        if (cnt == TOPK) { exact = true; break; }
    }
    if (exact) {
        int k = wave_scan_dpp(cl_last) - cl_last;
#pragma unroll
        for (int jj = 0; jj < NR; ++jj) {
            const bool sel = keys[jj] >= T;
            if (sel) { const int idx = lane + 64 * jj; const int dist = pos - idx; const unsigned bk = dist >= 128 ? 31u : (unsigned)bkL[dist]; out[k] = (unsigned short)(idx | (bk << 11)); }
            k += sel ? 1 : 0;
        }
        return;
    }
    int cgt = 0;
#pragma unroll
    for (int jj = 0; jj < NR; ++jj) cgt += __builtin_popcountll(__builtin_amdgcn_ballot_w64(keys[jj] > T));
    const int need = TOPK - cgt; int obase = 0, ebase = 0;
#pragma unroll
    for (int jj = 0; jj < NR; ++jj) {
        const bool gt = keys[jj] > T, eq = keys[jj] == T;
        const unsigned long long em = __builtin_amdgcn_ballot_w64(eq);
        const int erank = ebase + (int)__builtin_amdgcn_mbcnt_hi((unsigned)(em >> 32), __builtin_amdgcn_mbcnt_lo((unsigned)em, 0u));
        const bool sel = gt || (eq && erank < need);
        const unsigned long long sm = __builtin_amdgcn_ballot_w64(sel);
        const int opos = obase + (int)__builtin_amdgcn_mbcnt_hi((unsigned)(sm >> 32), __builtin_amdgcn_mbcnt_lo((unsigned)sm, 0u));
        if (sel) { const int idx = lane + 64 * jj; const int dist = pos - idx; const unsigned bk = dist >= 128 ? 31u : (unsigned)bkL[dist]; out[opos] = (unsigned short)(idx | (bk << 11)); }
        obase += __builtin_popcountll(sm); ebase += __builtin_popcountll(em);
    }
}
__device__ __forceinline__ void index_phase(const Frame& F, const Ptrs& P, int j) {
    LAS float* scb = (LAS float*)F.lds;
    LAS float* wiB = (LAS float*)(F.lds + 131072);
    LAS unsigned char* bkL = (LAS unsigned char*)(F.lds + 131072 + 4096);
    const bf16_t* QC = (const bf16_t*)(P.ws + WS_QC); bf16_t* CN = (bf16_t*)(P.ws + WS_CN); unsigned short* IDX = (unsigned short*)(P.ws + WS_IDX);
    const int lane = F.lane, w = F.wave, half = lane >> 5;
    if (F.tid < 128) { const int n = F.tid; int bk = n; if (n >= 16) { bk = 16 + (int)(logf((float)n / 16.0f) / 2.0794415416798357f * 16.0f); bk = bk > 31 ? 31 : bk; } bkL[n] = (unsigned char)bk; }
    __syncthreads();
    const int nunits = M / 8;
    const int ar = lane & 31, ahalf_r = (ar >> 2) & 1, areg_r = (ar & 3) + 4 * (ar >> 3), aq = 2 * ahalf_r + (areg_r >> 3), ah = areg_r & 7;
#define IDX_UNIT(i_) (((i_) * F.G < nunits) ? ((i_) * F.G + (((i_) & 1) ? (F.G - 1 - F.vcu) : F.vcu)) : -1)
#define IDX_OK(u_) ((u_) >= 0 && (u_) < nunits)
#define IDX_FETCH(u_, A_, cw_, wi_) do { const int T0_ = (u_) * 8; \
        cw_ = *(const unsigned*)(QC + ((size_t)T0_ + w) * NATT + QC_C + 2 * lane); \
        wi_ = QC[(size_t)(T0_ + (lane >> 3)) * NATT + QC_WI + (lane & 7)]; \
        _Pragma("unroll") for (int g = 0; g < 2; ++g) { const bf16_t* p_ = QC + (size_t)(T0_ + 4 * g + aq) * NATT + QC_QI + ah * 64 + 32 * half; \
            _Pragma("unroll") for (int s = 0; s < 4; ++s) A_[g][s] = *(const bf16x8*)(p_ + 8 * s); } } while (0)
#define IDX_SCORE(u_, par_, unext_) do { const int T0 = (u_) * 8, b = T0 >> 11, p0 = T0 & (SEQ - 1); \
        LAS float* sc = scb + (par_) * 16384; LAS float* wiL = wiB + ((par_) * 8 + w) * 64; \
        bf16x8 Af[2][4]; \
        _Pragma("unroll") for (int g = 0; g < 2; ++g) _Pragma("unroll") for (int s = 0; s < 4; ++s) Af[g][s] = An[g][s]; \
        const unsigned cw = cwn; wiL[lane] = bf2f(win); \
        if (IDX_OK(unext_)) IDX_FETCH(unext_, An, cwn, win); \
        { const size_t tok = (size_t)T0 + w; const float c0 = bflo(cw), c1 = bfhi(cw); \
          const float ss = wave_sum_f32_dpp(c0 * c0 + c1 * c1); const float rs = rsqrtf(ss * (1.0f / 128.0f) + EPS); const f32x2 gg = gg_lat; \
          *(unsigned*)(CN + tok * 128 + 2 * lane) = cvt_pk_bf16(c0 * rs * gg.x, c1 * rs * gg.y); } \
        LDS_WAIT(); asm volatile("" ::: "memory"); \
        const int nkt = (p0 + 8 + 31) >> 5; \
        for (int kt0 = w; kt0 < nkt; kt0 += 16) { \
            bf16x8 Bf[2][4]; \
            _Pragma("unroll") for (int bi = 0; bi < 2; ++bi) { const int kt = kt0 + 8 * bi; if (kt < nkt) { const bf16_t* kp = QC + ((size_t)b * SEQ + 32 * kt + (lane & 31)) * NATT + QC_KI + 32 * half; \
                _Pragma("unroll") for (int s4 = 0; s4 < 4; ++s4) Bf[bi][s4] = *(const bf16x8*)(kp + 8 * s4); } } \
            _Pragma("unroll") for (int bi = 0; bi < 2; ++bi) { const int kt = kt0 + 8 * bi; if (kt < nkt) { const int key = 32 * kt + (lane & 31); \
                _Pragma("unroll") for (int g = 0; g < 2; ++g) { \
                    f32x16 acc; \
                    _Pragma("unroll") for (int e = 0; e < 16; ++e) acc[e] = 0.f; \
                    _Pragma("unroll") for (int s4 = 0; s4 < 4; ++s4) acc = __builtin_amdgcn_mfma_f32_32x32x16_bf16(Af[g][s4], Bf[bi][s4], acc, 0, 0, 0); \
                    _Pragma("unroll") for (int e = 0; e < 2; ++e) { float sv = 0.f; const f32x4 wlo = *(const LAS f32x4*)(wiL + (4 * g + 2 * half + e) * 8), whi = *(const LAS f32x4*)(wiL + (4 * g + 2 * half + e) * 8 + 4); \
                        _Pragma("unroll") for (int h = 0; h < 4; ++h) { sv = fmaf(wlo[h], fmaxf(acc[8 * e + h], 0.f), sv); sv = fmaf(whi[h], fmaxf(acc[8 * e + 4 + h], 0.f), sv); } \
                        const int qi = 4 * g + 2 * half + e; \
                        sc[qi * 2048 + key] = (key <= p0 + qi) ? sv : -INFINITY; } \
                } } } \
        } } while (0)
    const f32x2 gg_lat = *(const f32x2*)(P.in[14] + (size_t)j * 128 + 2 * lane);
    bf16x8 An[2][4]; unsigned cwn = 0u; unsigned short win = 0;
    { const int u0 = IDX_UNIT(0); if (IDX_OK(u0)) { IDX_FETCH(u0, An, cwn, win); const int u1 = IDX_UNIT(1); IDX_SCORE(u0, 0, u1); } }
    __syncthreads();
    for (int i = 0;; ++i) {
        const int u = IDX_UNIT(i); if (u < 0) break;
        if (IDX_OK(u)) {
            const int T0 = u * 8, p0 = T0 & (SEQ - 1); const LAS float* sc = scb + (i & 1) * 16384;
            const int pos = p0 + w, n = pos + 1; unsigned short* out = IDX + (size_t)(T0 + w) * 256;
            if (n <= TOPK) {
#pragma unroll
                for (int jj = 0; jj < 4; ++jj) { const int s = lane + 64 * jj; const int dist = pos - s; const unsigned bk = (dist >= 0) ? (dist >= 128 ? 31u : (unsigned)bkL[dist]) : 0u;
                    out[s] = (s < n) ? (unsigned short)(s | (bk << 11)) : (unsigned short)0; }
            } else {
                const LAS float* scq = sc + w * 2048;
                if (n <= 512) idx_select<8>(scq, pos, lane, bkL, out); else if (n <= 1024) idx_select<16>(scq, pos, lane, bkL, out);
                else if (n <= 1536) idx_select<24>(scq, pos, lane, bkL, out); else idx_select<32>(scq, pos, lane, bkL, out);
            }
        }
        { const int un = IDX_UNIT(i + 1); if (IDX_OK(un)) { const int un2 = IDX_UNIT(i + 2); IDX_SCORE(un, (i + 1) & 1, un2); } }
        __syncthreads();
    }
#undef IDX_UNIT
#undef IDX_OK
#undef IDX_FETCH
#undef IDX_SCORE
}

__device__ __forceinline__ s16x4 tr_read(const LAS unsigned char* p) {
    typedef short v4i16_t __attribute__((ext_vector_type(4)));
    return __builtin_bit_cast(s16x4, __builtin_amdgcn_ds_read_tr16_b64_v4i16((LAS v4i16_t*)p));
}
struct AttState { float mrun, lrun; f32x4 O[8]; };
__device__ __forceinline__ float xmax16(float v) { const auto r = __builtin_amdgcn_permlane16_swap(__float_as_uint(v), __float_as_uint(v), false, false); return fmaxf(__uint_as_float(r[0]), __uint_as_float(r[1])); }
__device__ __forceinline__ float xmax32(float v) { const auto r = __builtin_amdgcn_permlane32_swap(__float_as_uint(v), __float_as_uint(v), false, false); return fmaxf(__uint_as_float(r[0]), __uint_as_float(r[1])); }
__device__ __forceinline__ float xsum16(float v) { const auto r = __builtin_amdgcn_permlane16_swap(__float_as_uint(v), __float_as_uint(v), false, false); return __uint_as_float(r[0]) + __uint_as_float(r[1]); }
__device__ __forceinline__ float xsum32(float v) { const auto r = __builtin_amdgcn_permlane32_swap(__float_as_uint(v), __float_as_uint(v), false, false); return __uint_as_float(r[0]) + __uint_as_float(r[1]); }
__device__ __forceinline__ void att_stage(const bf16x8 (&cf)[16], LAS unsigned char* V, int lane) {
    constexpr int VROW = 288;
#pragma unroll
    for (int i = 0; i < 16; ++i) *(LAS bf16x8*)(V + (16 * (lane >> 4) + i) * VROW + (lane & 15) * 16) = cf[i];
    asm volatile("" ::: "memory");
}
__device__ __forceinline__ void att_qk(const bf16x8 (&qf)[4], f32x4 (&S)[4], const LAS unsigned char* V, int lane, int g) {
    constexpr int VROW = 288;
    const LAS unsigned char* ab = V + (lane & 15) * VROW + 16 * g;
#pragma unroll
    for (int t = 0; t < 4; ++t) { S[t] = (f32x4){0.f, 0.f, 0.f, 0.f};
#pragma unroll
        for (int ks = 0; ks < 4; ++ks) { const bf16x8 af = *(const LAS bf16x8*)(ab + 16 * t * VROW + 64 * ks); S[t] = __builtin_amdgcn_mfma_f32_16x16x32_bf16(af, qf[ks], S[t], 0, 0, 0); } }
}
template <bool MASKED>
__device__ __forceinline__ void att_sm_pv(const f32x4 (&S)[4], int s, int cnt, AttState& st, const LAS unsigned short* listL, const LAS float* biasL, const LAS unsigned char* trbase, int head, int g) {
    constexpr int VROW = 288; constexpr float L2E = 1.44269504089f;
    float val[4][4]; float cmax = -INFINITY;
#pragma unroll
    for (int t = 0; t < 4; ++t) { const u16x4 pk4 = *(const LAS u16x4*)(listL + 64 * s + 16 * t + 4 * g);
#pragma unroll
        for (int r = 0; r < 4; ++r) { const float bias = *(const LAS float*)((const LAS unsigned char*)biasL + ((pk4[r] >> 5) & 0x7C0u) + head * 4);
            float v = S[t][r] + bias; if (MASKED) v = (64 * s + 16 * t + 4 * g + r < cnt) ? v : -INFINITY; val[t][r] = v; cmax = fmaxf(cmax, v); } }
    cmax = xmax32(xmax16(cmax));
    const bool moved = __builtin_amdgcn_ballot_w64(cmax - st.mrun > 8.0f) != 0ull;
    const float mnew = moved ? fmaxf(st.mrun, cmax) : st.mrun, mneg = -mnew * L2E;
    const float alpha = moved ? __builtin_amdgcn_exp2f(fmaf(st.mrun, L2E, mneg)) : 1.0f;
    float p[4][4]; float psum = 0.f;
#pragma unroll
    for (int t = 0; t < 4; ++t)
#pragma unroll
        for (int r = 0; r < 4; ++r) { p[t][r] = __builtin_amdgcn_exp2f(fmaf(val[t][r], L2E, mneg)); psum += p[t][r]; }
    psum = xsum32(xsum16(psum));
    st.lrun = st.lrun * alpha + psum; st.mrun = mnew;
    if (moved) {
#pragma unroll
        for (int dt = 0; dt < 8; ++dt) st.O[dt] = st.O[dt] * alpha; }
    union { bf16x8 v; unsigned u[4]; } pf[2];
#pragma unroll
    for (int hh = 0; hh < 2; ++hh) { pf[hh].u[0] = cvt_pk_bf16(p[2 * hh][0], p[2 * hh][1]); pf[hh].u[1] = cvt_pk_bf16(p[2 * hh][2], p[2 * hh][3]); pf[hh].u[2] = cvt_pk_bf16(p[2 * hh + 1][0], p[2 * hh + 1][1]); pf[hh].u[3] = cvt_pk_bf16(p[2 * hh + 1][2], p[2 * hh + 1][3]); }
#pragma unroll
    for (int dt = 0; dt < 8; ++dt)
#pragma unroll
        for (int hh = 0; hh < 2; ++hh) {
            union { bf16x8 v; s16x4 h[2]; } vf;
            vf.h[0] = tr_read(trbase + hh * 32 * VROW + dt * 32); vf.h[1] = tr_read(trbase + (hh * 32 + 16) * VROW + dt * 32);
            st.O[dt] = __builtin_amdgcn_mfma_f32_16x16x32_bf16(vf.v, pf[hh].v, st.O[dt], 0, 0, 0);
        }
    asm volatile("" ::: "memory");
}
__device__ __forceinline__ void attn_phase(const Frame& F, const Ptrs& P, bool dry = false) {
    constexpr int VROW = 288, VBYTES = 64 * VROW;
    LAS unsigned char* V = F.lds + F.wave * VBYTES;
    LAS unsigned short* listB = (LAS unsigned short*)(F.lds + 8 * VBYTES + F.wave * 1024);
    LAS float* biasL = (LAS float*)(F.lds + 8 * VBYTES + 8 * 1024);
    static_assert(8 * VBYTES + 8 * 1024 + 2048 <= MISC_OFF, "attention LDS map");
    bf16_t* QC = (bf16_t*)(P.ws + WS_QC); const bf16_t* CN = (const bf16_t*)(P.ws + WS_CN); const unsigned short* IDX = (const unsigned short*)(P.ws + WS_IDX);
    const int lane = F.lane, head = lane & 15, g = lane >> 4;
    if (F.tid < 512) biasL[F.tid] = P.in[18][F.tid];
    __syncthreads();
    const int gw = F.vcu * NWAVES + F.wave, NGW = F.G * NWAVES;
    const int trq = (lane & 15) >> 2, trp = lane & 3;
    const LAS unsigned char* trbase = V + (4 * g + trq) * VROW + 8 * trp;
#define ATT_LOAD(buf, ss, listL, cnb) do { const u32x4 l0_ = *(const LAS u32x4*)(listL + 64 * (ss) + 16 * (lane >> 4)), l1_ = *(const LAS u32x4*)(listL + 64 * (ss) + 16 * (lane >> 4) + 8); \
        _Pragma("unroll") for (int i = 0; i < 16; ++i) { const unsigned w_ = (i < 8) ? l0_[(i & 7) >> 1] : l1_[(i & 7) >> 1]; const unsigned pk = (i & 1) ? (w_ >> 16) : (w_ & 0xffffu); \
            buf[i] = *(const bf16x8*)(cnb + (((pk & 2047u) << 8) + (unsigned)(lane & 15) * 16u)); } } while (0)
#define ATT_TOKEN(k_) ((k_) * NGW + ((gw + 256 * (k_)) % NGW))
    unsigned long long lstn = 0ull; bf16x8 qfn[4]; bf16x8 cf[16];
    if (ATT_TOKEN(0) < M) { const int t0_ = ATT_TOKEN(0); lstn = *(const unsigned long long*)(IDX + (size_t)t0_ * 256 + 4 * lane); const bf16_t* qp = QC + (size_t)t0_ * NATT + head * 128 + 8 * g;
#pragma unroll
        for (int ks = 0; ks < 4; ++ks) qfn[ks] = *(const bf16x8*)(qp + 32 * ks);
        asm volatile("" ::: "memory");
        *(LAS unsigned long long*)(listB + 4 * lane) = lstn;
        asm volatile("" ::: "memory");
        const char* cnb0 = (const char*)(CN + (size_t)__builtin_amdgcn_readfirstlane(t0_ >> 11) * SEQ * 128);
        ATT_LOAD(cf, 0, listB, cnb0); }
    for (int kr = 0; kr * NGW < M; ++kr) {
        const int token = ATT_TOKEN(kr); if (token >= M) break;
        const int b = token >> 11, pos = token & (SEQ - 1), cnt = pos + 1 < TOPK ? pos + 1 : TOPK, nstep = (cnt + 63) >> 6;
        LAS unsigned short* listL = listB + (kr & 1) * 256;
        bf16x8 qf[4];
#pragma unroll
        for (int ks = 0; ks < 4; ++ks) qf[ks] = qfn[ks];
        const char* cnb = (const char*)(CN + (size_t)__builtin_amdgcn_readfirstlane(b) * SEQ * 128);
        const int nt_ = ((kr + 1) * NGW < M) ? ATT_TOKEN(kr + 1) : M;
        if (nt_ < M) { lstn = *(const unsigned long long*)(IDX + (size_t)nt_ * 256 + 4 * lane); const bf16_t* qp = QC + (size_t)nt_ * NATT + head * 128 + 8 * g;
#pragma unroll
            for (int ks = 0; ks < 4; ++ks) qfn[ks] = *(const bf16x8*)(qp + 32 * ks); }
        AttState st; st.mrun = -INFINITY; st.lrun = 0.f;
#pragma unroll
        for (int dt = 0; dt < 8; ++dt) st.O[dt] = (f32x4){0.f, 0.f, 0.f, 0.f};
        for (int s = 0; s < nstep; ++s) {
            f32x4 S[4];
            att_stage(cf, V, lane);
            if (s + 1 < nstep) ATT_LOAD(cf, s + 1, listL, cnb);
            else if (nt_ < M) {
                LAS unsigned short* ln = listB + ((kr + 1) & 1) * 256;
                asm volatile("" ::: "memory");
                *(LAS unsigned long long*)(ln + 4 * lane) = lstn;
                asm volatile("" ::: "memory");
                const char* cnbn = (const char*)(CN + (size_t)__builtin_amdgcn_readfirstlane(nt_ >> 11) * SEQ * 128);
                ATT_LOAD(cf, 0, ln, cnbn); }
            att_qk(qf, S, V, lane, g);
            if (64 * (s + 1) > cnt) att_sm_pv<true>(S, s, cnt, st, listL, biasL, trbase, head, g); else att_sm_pv<false>(S, s, cnt, st, listL, biasL, trbase, head, g);
        }
        const float inv = 1.0f / st.lrun;
        bf16_t* op = QC + (size_t)token * NATT + head * 128 + 4 * g;
        if (dry) { asm volatile("" :: "v"(st.O[0]), "v"(st.O[7]), "v"(inv)); bf16_t* qp = QC + (size_t)token * NATT + head * 128 + 8 * g;
#pragma unroll
            for (int ks = 0; ks < 4; ++ks) *(bf16x8*)(qp + 32 * ks) = qf[ks]; continue; }
#pragma unroll
        for (int dt = 0; dt < 8; ++dt) { u32x2 wv; wv.x = cvt_pk_bf16(st.O[dt][0] * inv, st.O[dt][1] * inv); wv.y = cvt_pk_bf16(st.O[dt][2] * inv, st.O[dt][3] * inv); *(u32x2*)(op + 16 * dt) = wv; }
    }
#undef ATT_LOAD
#undef ATT_TOKEN
}


#ifndef NAIVE_IDX
#define NAIVE_IDX 0
#endif
#ifndef NAIVE_ATT
#define NAIVE_ATT 0
#endif
__device__ __forceinline__ void naive_index_phase(const Frame& F, const Ptrs& P, int j) {
    LAS float* sc = (LAS float*)F.lds;
    LAS float* qiL = sc + 2048;
    LAS float* wL = qiL + 512;
    LAS int* cntL = (LAS int*)(wL + 8);
    LAS unsigned char* bkL = (LAS unsigned char*)(cntL + 520);
    const bf16_t* QC = (const bf16_t*)(P.ws + WS_QC); bf16_t* CN = (bf16_t*)(P.ws + WS_CN); unsigned short* IDX = (unsigned short*)(P.ws + WS_IDX);
    const int tid = F.tid;
    if (tid < 128) { const int n = tid; int bk = n; if (n >= 16) { bk = 16 + (int)(logf((float)n / 16.0f) / 2.0794415416798357f * 16.0f); bk = bk > 31 ? 31 : bk; } bkL[n] = (unsigned char)bk; }
    __syncthreads();
    for (int tok = F.vcu; tok < M; tok += F.G) {
        const int b = tok >> 11, pos = tok & (SEQ - 1), n = pos + 1;
        if (tid < 64) {
            const unsigned cw = *(const unsigned*)(QC + (size_t)tok * NATT + QC_C + 2 * tid); const float c0 = bflo(cw), c1 = bfhi(cw);
            const float ss = wave_sum(c0 * c0 + c1 * c1); const float rs = rsqrtf(ss * (1.0f / 128.0f) + EPS); const float* g = P.in[14] + (size_t)j * 128 + 2 * tid;
            *(unsigned*)(CN + (size_t)tok * 128 + 2 * tid) = cvt_pk_bf16(c0 * rs * g[0], c1 * rs * g[1]);
        }
        qiL[tid] = bf2f(QC[(size_t)tok * NATT + QC_QI + tid]);
        if (tid < 8) wL[tid] = bf2f(QC[(size_t)tok * NATT + QC_WI + tid]);
        __syncthreads();
        for (int key = tid; key < SEQ; key += NTHREADS) {
            float s = -INFINITY;
            if (key <= pos) { const bf16_t* kp = QC + ((size_t)b * SEQ + key) * NATT + QC_KI; s = 0.f;
                for (int h = 0; h < 8; ++h) { float d = 0.f; for (int e = 0; e < 64; ++e) d = fmaf(qiL[h * 64 + e], bf2f(kp[e]), d); s = fmaf(wL[h], fmaxf(d, 0.f), s); }
                s = s + 0.0f; }
            sc[key] = s;
        }
        __syncthreads();
        unsigned short* out = IDX + (size_t)tok * 256;
        if (n <= TOPK) { if (tid < 256) { const int dist = pos - tid; const unsigned bk = (dist >= 0) ? (dist >= 128 ? 31u : (unsigned)bkL[dist]) : 0u; out[tid] = (tid < n) ? (unsigned short)(tid | (bk << 11)) : (unsigned short)0; } }
        else {
            bool sel[4]; int mycnt = 0;
            for (int e = 0; e < 4; ++e) { const int i = tid * 4 + e; sel[e] = false;
                if (i <= pos) { const float si = sc[i]; int rank = 0; for (int jx = 0; jx <= pos; ++jx) { const float sj = sc[jx]; rank += (sj > si || (sj == si && jx < i)) ? 1 : 0; } sel[e] = rank < TOPK; }
                mycnt += sel[e] ? 1 : 0; }
            cntL[tid] = mycnt;
            __syncthreads();
            int basep = 0; for (int t2 = 0; t2 < tid; ++t2) basep += cntL[t2];
            for (int e = 0; e < 4; ++e) if (sel[e]) { const int i = tid * 4 + e; const int dist = pos - i; const unsigned bk = dist >= 128 ? 31u : (unsigned)bkL[dist]; out[basep++] = (unsigned short)(i | (bk << 11)); }
        }
        __syncthreads();
    }
}
__device__ __forceinline__ void naive_attn_phase(const Frame& F, const Ptrs& P) {
    bf16_t* QC = (bf16_t*)(P.ws + WS_QC); const bf16_t* CN = (const bf16_t*)(P.ws + WS_CN); const unsigned short* IDX = (const unsigned short*)(P.ws + WS_IDX);
    LAS float* pL = (LAS float*)(F.lds + F.wave * 4096);
    LAS int* kL = (LAS int*)(pL + 256);
    LAS float* oL = (LAS float*)(kL + 256);
    const int lane = F.lane, gw = F.vcu * NWAVES + F.wave, NGW = F.G * NWAVES;
    for (int token = gw; token < M; token += NGW) {
        const int b = token >> 11, pos = token & (SEQ - 1), cnt = pos + 1 < TOPK ? pos + 1 : TOPK;
        float qv[16][2];
#pragma unroll
        for (int h = 0; h < 16; ++h) { qv[h][0] = bf2f(QC[(size_t)token * NATT + h * 128 + lane]); qv[h][1] = bf2f(QC[(size_t)token * NATT + h * 128 + 64 + lane]); }
        for (int s = lane; s < 256; s += 64) kL[s] = IDX[(size_t)token * 256 + s];
        LDS_WAIT(); asm volatile("" ::: "memory");
#pragma unroll
        for (int h = 0; h < 16; ++h) {
            float mx = -INFINITY;
            for (int s = 0; s < cnt; ++s) { const int pk = kL[s]; const bf16_t* cp = CN + ((size_t)b * SEQ + (pk & 2047)) * 128;
                float d = qv[h][0] * bf2f(cp[lane]) + qv[h][1] * bf2f(cp[64 + lane]); d = wave_sum(d);
                d += P.in[18][(pk >> 11) * 16 + h]; if (lane == 0) pL[s] = d; mx = fmaxf(mx, d); }
            LDS_WAIT(); asm volatile("" ::: "memory");
            float sum = 0.f; for (int s = 0; s < cnt; ++s) sum += __expf(pL[s] - mx);
            float o0 = 0.f, o1 = 0.f;
            for (int s = 0; s < cnt; ++s) { const int pk = kL[s]; const bf16_t* cp = CN + ((size_t)b * SEQ + (pk & 2047)) * 128; const float p = __expf(pL[s] - mx) / sum;
                o0 = fmaf(p, bf2f(cp[lane]), o0); o1 = fmaf(p, bf2f(cp[64 + lane]), o1); }
            QC[(size_t)token * NATT + h * 128 + lane] = (bf16_t)(cvt_pk_bf16(o0, 0.f) & 0xffffu); QC[(size_t)token * NATT + h * 128 + 64 + lane] = (bf16_t)(cvt_pk_bf16(o1, 0.f) & 0xffffu);
            asm volatile("" ::: "memory");
        }
    }
}


#ifndef MK_DEBUG_CHECKS
#define MK_DEBUG_CHECKS 0
#endif
#if MK_DEBUG_CHECKS
constexpr size_t WS_DIAG = 224 * MiB, WS_SAVE = 225 * MiB, WS_SAVEG = 226 * MiB, WS_TMPO = 227 * MiB;
constexpr int NS = 256;
__device__ __forceinline__ int srow(int s) { return ((s & 63) << 8) | ((s * 37 + 11) & 255); }
__device__ __forceinline__ float diag_err(float mine, float ref) { float e = fabsf(mine - ref) / (fabsf(ref) + 0.25f); if (!(e == e)) e = 1e9f; return e; }
__device__ __forceinline__ void diag_max(unsigned char* ws, int id, float e) {
    for (int o = 1; o < 64; o <<= 1) e = fmaxf(e, __shfl_xor(e, o));
    if ((threadIdx.x & 63) == 0) atomicMax((unsigned*)(ws + WS_DIAG) + id, __float_as_uint(e));
}
__device__ __forceinline__ void diag_put(unsigned char* ws, int id, float mine, float ref) { diag_max(ws, id, diag_err(mine, ref)); }
__device__ __forceinline__ float d_rs(const unsigned char* ws, int row) { const float* p = (const float*)(ws + WS_SSQ) + (size_t)row * 16; float s = 0.f; for (int i = 0; i < 16; ++i) s += p[i]; return rsqrtf(s / 1024.f + EPS); }
__device__ __forceinline__ float d_bf(const unsigned char* ws, size_t off, size_t idx) { return bf2f(((const bf16_t*)(ws + off))[idx]); }
__global__ void chk_zero(unsigned char* ws) { if (threadIdx.x < 64) ((unsigned*)(ws + WS_DIAG))[threadIdx.x] = 0u; }
__global__ void chk_save_rows(unsigned char* ws, const float* src) { const int s = blockIdx.x; float* d = (float*)(ws + WS_SAVE) + s * 1024; for (int c = threadIdx.x; c < 1024; c += blockDim.x) d[c] = src[(size_t)srow(s) * D + c]; }
__global__ void chk_proj(unsigned char* ws, int id, size_t off_a, int lda, const float* W, int ldw, const float* gam, int K, int N, size_t off_o, int ldo, int mode) {
    const int s = blockIdx.y, row = srow(s), col = blockIdx.x * blockDim.x + threadIdx.x;
    float acc = 0.f; for (int k = 0; k < K; ++k) acc = fmaf(d_bf(ws, off_a, (size_t)row * lda + k) * (gam ? gam[k] : 1.f), W[(size_t)k * ldw + col], acc);
    acc *= d_rs(ws, row);
    if (mode == 1 && col < 1024) acc = 0.5f * acc * (1.f + tanhf(0.7978845608f * (acc + 0.044715f * acc * acc * acc)));
    if (mode == 2) { acc = fmaxf(acc, 0.f); acc *= acc; }
    diag_put(ws, id, d_bf(ws, off_o, (size_t)row * ldo + col), acc);
}
__global__ void chk_res(unsigned char* ws, int id, size_t off_a, int lda, const float* W, int K, const float* outp, const float* xold_full) {
    const int s = blockIdx.y, row = srow(s), col = blockIdx.x * blockDim.x + threadIdx.x;
    float acc = 0.f; for (int k = 0; k < K; ++k) acc = fmaf(d_bf(ws, off_a, (size_t)row * lda + k), W[(size_t)k * D + col], acc);
    const float xo = xold_full ? xold_full[(size_t)row * D + col] : ((const float*)(ws + WS_SAVE))[s * 1024 + col];
    diag_put(ws, id, outp[(size_t)row * D + col], xo + acc);
    diag_put(ws, id, d_bf(ws, WS_XB, (size_t)row * D + col), xo + acc);
}
__global__ void chk_ssq(unsigned char* ws, int id, const float* outp) {
    const int s = blockIdx.x * blockDim.x + threadIdx.x; const int row = srow(s); float q = 0.f; for (int c = 0; c < D; ++c) { const float v = outp[(size_t)row * D + c]; q += v * v; }
    const float* p = (const float*)(ws + WS_SSQ) + (size_t)row * 16; float t = 0.f; for (int i = 0; i < 16; ++i) t += p[i]; diag_put(ws, id, t, q);
}
__global__ void chk_conv(unsigned char* ws, int id, const float* cw, const float* cb) {
    const int s = blockIdx.y, row = srow(s) & ~3 | (s & 3) * 0, ch = blockIdx.x * blockDim.x + threadIdx.x;
    const int rr = (s < 16) ? ((s >> 1) * SEQ + (s & 1) * 256 * 3 + (s & 3)) : srow(s); const int pos = rr & (SEQ - 1);
    float acc = cb[ch]; for (int k = 0; k < 4; ++k) { const int p = pos - 3 + k; if (p >= 0) acc += cw[k * D + ch] * d_bf(ws, WS_GX, (size_t)(rr - 3 + k) * 2048 + 1024 + ch); }
    diag_put(ws, id, d_bf(ws, WS_XC, (size_t)rr * D + ch), acc);
}
__global__ void chk_gates(unsigned char* ws, int id, const float* wa, const float* ba, const float* wx, const float* bx) {
    const int s = blockIdx.y, row = srow(s), ch = blockIdx.x * blockDim.x + threadIdx.x, blk = ch >> 8, i = ch & 255;
    float a = ba[ch], x = bx[ch]; for (int jx = 0; jx < 256; ++jx) { const float v = d_bf(ws, WS_XC, (size_t)row * D + blk * 256 + jx); a = fmaf(v, wa[(size_t)blk * 65536 + jx * 256 + i], a); x = fmaf(v, wx[(size_t)blk * 65536 + jx * 256 + i], x); }
    diag_put(ws, id, d_bf(ws, WS_RB, (size_t)row * D + ch), 1.f / (1.f + expf(-a))); diag_put(ws, id, d_bf(ws, WS_IB, (size_t)row * D + ch), 1.f / (1.f + expf(-x)));
}
__global__ void chk_save_gate(unsigned char* ws) {
    const int p = blockIdx.x, b = p & 7, ch = (p * 61 + 5) & 1023; bf16_t* d = (bf16_t*)(ws + WS_SAVEG) + p * 2048;
    for (int t = threadIdx.x; t < SEQ; t += blockDim.x) d[t] = ((const bf16_t*)(ws + WS_GX))[((size_t)b * SEQ + t) * 2048 + ch];
}
__global__ void chk_scan(unsigned char* ws, int id, const float* lam) {
    const int p = blockIdx.x * blockDim.x + threadIdx.x; const int b = p & 7, ch = (p * 61 + 5) & 1023;
    const float sp = -8.f * log1pf(expf(-lam[ch])); float h = 0.f, em = 0.f;
    for (int t = 0; t < SEQ; ++t) { const size_t r = (size_t)b * SEQ + t; const float rr = d_bf(ws, WS_RB, r * D + ch), ii = d_bf(ws, WS_IB, r * D + ch), xc = d_bf(ws, WS_XC, r * D + ch);
        const float la = sp * rr, a = expf(la), u = sqrtf(-expm1f(2.f * la)) * (ii * xc); h = a * h + u;
        const float g = bf2f(((const bf16_t*)(ws + WS_SAVEG))[p * 2048 + t]); em = fmaxf(em, diag_err(d_bf(ws, WS_GX, r * 2048 + ch), h * g)); }
    diag_max(ws, id, em);
}
__global__ void chk_att_in(unsigned char* ws, int id, const float* Win, const float* wuk, const float* gam) {
    const int s = blockIdx.y, row = srow(s), col = blockIdx.x * blockDim.x + threadIdx.x;
    const float rs = d_rs(ws, row); float ref = 0.f;
    if (col < 2048) { const int h = col >> 7, c = col & 127;
        for (int d = 0; d < 64; ++d) { float q = 0.f; for (int k = 0; k < D; ++k) q = fmaf(d_bf(ws, WS_XB, (size_t)row * D + k) * gam[k], Win[(size_t)k * ATT_IN + h * 64 + d], q); ref = fmaf(q, wuk[((size_t)h * 64 + d) * 128 + c], ref); }
        ref *= rs * 0.125f; }
    else if (col < 2760) { const int wc = 1024 + (col - 2048); for (int k = 0; k < D; ++k) ref = fmaf(d_bf(ws, WS_XB, (size_t)row * D + k) * gam[k], Win[(size_t)k * ATT_IN + wc], ref); ref *= rs * (col >= 2752 ? 0.044194173824159216f : 1.f); }
    diag_put(ws, id, d_bf(ws, WS_QC, (size_t)row * NATT + col), ref);
}
__global__ void chk_cn(unsigned char* ws, int id, const float* g) {
    const int s = blockIdx.x, row = srow(s), c = threadIdx.x; float ss = 0.f; for (int e = 0; e < 128; ++e) { const float v = d_bf(ws, WS_QC, (size_t)row * NATT + QC_C + e); ss += v * v; }
    diag_put(ws, id, d_bf(ws, WS_CN, (size_t)row * 128 + c), d_bf(ws, WS_QC, (size_t)row * NATT + QC_C + c) * rsqrtf(ss / 128.f + EPS) * g[c]);
}
__global__ void chk_att_o(unsigned char* ws, const float* wuv) {
    const int s = blockIdx.y, row = srow(s), n = blockIdx.x * blockDim.x + threadIdx.x, h = n >> 6, v = n & 63; float a = 0.f;
    for (int c = 0; c < 128; ++c) a = fmaf(d_bf(ws, WS_QC, (size_t)row * NATT + h * 128 + c), wuv[((size_t)h * 128 + c) * 64 + v], a);
    ((float*)(ws + WS_TMPO))[s * 1024 + n] = a;
}
__global__ void chk_att_out(unsigned char* ws, int id, const float* wo, const float* outp) {
    const int s = blockIdx.y, row = srow(s), col = blockIdx.x * blockDim.x + threadIdx.x; float a = 0.f;
    for (int k = 0; k < 1024; ++k) a = fmaf(((const float*)(ws + WS_TMPO))[s * 1024 + k], wo[(size_t)k * D + col], a);
    diag_put(ws, id, outp[(size_t)row * D + col], ((const float*)(ws + WS_SAVE))[s * 1024 + col] + a);
}
__global__ void chk_report(unsigned char* ws, float* outp) {
    if (threadIdx.x == 0) { const unsigned* dg = (const unsigned*)(ws + WS_DIAG); for (int id = 1; id < 40; ++id) { const float e = __uint_as_float(dg[id]); if (e > 0.1f) { outp[0] = 100.f * id + 10.f; break; } } }
}
#endif


#ifndef MK_DETCHECK
#define MK_DETCHECK 0
#endif
#if MK_DETCHECK
constexpr size_t WS_CKS = 230 * MiB;
__global__ void cks_zero(unsigned* d) { d[threadIdx.x] = 0u; }
__global__ void lds_poison(unsigned pat) { extern __shared__ unsigned lp[]; for (int i = threadIdx.x; i < LDS_BYTES / 4; i += blockDim.x) lp[i] = pat; __syncthreads(); if (lp[threadIdx.x] != pat) asm volatile("s_nop 0"); }
__global__ void cks_kernel(const unsigned* p, size_t nwords, unsigned* dst) {
    unsigned a = 0u; for (size_t i = (size_t)blockIdx.x * blockDim.x + threadIdx.x; i < nwords; i += (size_t)gridDim.x * blockDim.x) a += p[i] * 2654435761u + (unsigned)i;
    for (int o = 1; o < 64; o <<= 1) a += __shfl_xor(a, o);
    if ((threadIdx.x & 63) == 0) atomicAdd(dst, a);
}
__global__ void cks_report(const unsigned* d, float* outp) { if (threadIdx.x == 0) for (int ph = 0; ph < 64; ++ph) if (d[ph] != d[64 + ph]) { outp[0] = 100.f * (ph + 1) + 10.f; break; } }
#endif

constexpr int N_PHASES = 28;
#ifndef MK_PER_PHASE
#define MK_PER_PHASE 0
#endif

__global__ void __launch_bounds__(NTHREADS, 2) trunk_fwd(Args args) {
    extern __shared__ __attribute__((aligned(16))) unsigned char lds_raw[];
    Frame F0;
    F0.lds = (LAS unsigned char*)lds_raw;
    F0.tid = threadIdx.x; F0.lane = F0.tid & 63; F0.wave = __builtin_amdgcn_readfirstlane(F0.tid >> 6);
    F0.G = gridDim.x; F0.bid = blockIdx.x; { const int bx = blockIdx.x; F0.vcu = (F0.G % 8 == 0) ? (bx % 8) * (F0.G / 8) + bx / 8 : bx; }
    volatile LAS unsigned* MISC = (volatile LAS unsigned*)(F0.lds + MISC_OFF);
    for (int u = F0.tid; u < (LDS_BYTES - LDSCTL_OFF) / 4; u += NTHREADS) ((LAS unsigned*)(F0.lds + LDSCTL_OFF))[u] = 0u;
    __syncthreads();
    unsigned* barw = (unsigned*)(args.ws + WS_CTL) + CW_BAR;
    XcdBarrier bar; bar.bar = barw; bar.x = 0; bar.st = nullptr;
    if (!MK_PER_PHASE) bar = xcd_barrier_post(barw, MISC + 8);
    const int lo = args.ph_lo, hi = args.ph_hi;
#ifndef PHMASK
#define PHMASK 0xFFFFu
#endif
#define PM(b) ((PHMASK >> (b)) & 1u)

#define IN(k) (lo <= (k) && (k) < hi)
#define SEAM(k) do { if (IN(k) && IN((k) + 1)) xcd_barrier(bar); } while (0)
    const bool gated = (F0.G == 256) && !MK_PER_PHASE;
#define HANDW(sidx) (CW_HAND + (sidx) * 64 * 16)
#define HAND(sidx) ((unsigned*)(P.ws + WS_CTL) + HANDW(sidx))
#define SEAM_H(k) do { if (!gated) SEAM(k); } while (0)
#define HAND_PREP(S_, sidx, per_unit) do { if (gated) (S_).c |= ((sidx) + 1) << 16; } while (0)
#define HAND_PUBLISH() do { } while (0)

#define PHASE_PTRS const Frame F = launder(F0); const Ptrs P = load_ptrs(); bf16_t* XB = (bf16_t*)(P.ws + WS_XB); float* SSQ = (float*)(P.ws + WS_SSQ); float* SSQM = (float*)(P.ws + WS_SSQM); \
    bf16_t* WM = (bf16_t*)(P.ws + WS_WMIX); bf16_t* WA = (bf16_t*)(P.ws + WS_WATT); bf16_t* WUP = (bf16_t*)(P.ws + WS_WUP); bf16_t* WDN = (bf16_t*)(P.ws + WS_WDOWN); \
    (void)XB; (void)SSQ; (void)SSQM; (void)WM; (void)WA; (void)WUP; (void)WDN

    if (PM(0) && IN(0)) { PHASE_PTRS; if (DB(0)) { cvt_att_mix(F, P, 0, 1); cvt_rec_mix(F, P, 0, 0); cvt_up(F, P, 0); cvt_down(F, P, 0); p0_rows(F, P); __syncthreads(); } cvt_att_mix(F, P, 0, 1, 0); cvt_att_mix(F, P, 1, 3, 1024); cvt_rec_mix(F, P, 0, 0); cvt_up(F, P, 0); cvt_down(F, P, 0); p0_rows(F, P); }
    SEAM(0);

    for (int L = 0; L < DEPTH; ++L) {
        const int pb = 1 + 7 * ((L + 1) >> 1) + 6 * (L >> 1), j = L >> 1, mo = (L & 1) ? 0 : 1;
        if ((L & 1) == 0) {
            if (PM(1) && IN(pb)) { PHASE_PTRS;
                { const Frame& F1 = F; (void)F1;
                pg8::Gemm g{XB, WM, D, D, D, -1}; pg8::StaticOrderT<true, false> S; S.init(M, 2048, F.G, F.bid);
                if (gated && L > 0) { S.ready = HAND(8 + L - 1); }
                pg8::EpiScale<1> E{(bf16_t*)(P.ws + WS_GX), 2048, SSQ};
                if (DB(1)) pg8::gemm_phase(F.lds, F.tid, g, S, E);
                pg8::gemm_phase(F.lds, F.tid, g, S, E); } }
            SEAM(pb);
            if (PM(2) && IN(pb + 1)) { PHASE_PTRS;
                for (int rep = 0; rep < (DB(2) ? 2 : 1); ++rep) for (int p = F.vcu; p < 256; p += F.G) conv_tile(F, P, j, p >> 2, p & 3);
                if (L > 0) cvt_down(F, P, L);
                asm volatile("s_waitcnt vmcnt(0)" ::: "memory"); __syncthreads();
                pg8::Gemm g{(const bf16_t*)(P.ws + WS_XC), WM + WM_REC_GATE, D, D, 256, 3}; pg8::GateOrder S{F.G, F.vcu};
                pg8::EpiGate E{(bf16_t*)(P.ws + WS_RB), (bf16_t*)(P.ws + WS_IB), P.in[8] + (size_t)j * D, P.in[10] + (size_t)j * D};
                pg8::gemm_phase(F.lds, F.tid, g, S, E); }
            SEAM(pb + 2);
            if (PM(3) && IN(pb + 3)) { PHASE_PTRS; if (DB(3)) { scan_phase(F, P, j, true); __syncthreads(); } if (L > 0) { cvt_up(F, P, L); __syncthreads(); } scan_phase(F, P, j); }
            SEAM(pb + 3);
            if (PM(4) && IN(pb + 4)) { PHASE_PTRS;
                pg8::Gemm g{(const bf16_t*)(P.ws + WS_GX), WM + WM_REC_OUT, 2048, D, D, -1}; pg8::StaticOrderT<false, true> S; S.init(M, D, F.G, F.bid);
                                pg8::EpiRes<false> E{XB, SSQM, nullptr}; HAND_PREP(S, L, 4);
                pg8::gemm_phase(F.lds, F.tid, g, S, E); HAND_PUBLISH(); }
            SEAM_H(pb + 4);
        } else {
            if (PM(5) && IN(pb)) { PHASE_PTRS;
                { const Frame& F1 = F; (void)F1;
                pg8::Gemm g{XB, WA + (size_t)j * 5 * MiB, D, D, D, -1}; pg8::StaticOrderT<true, false> S; S.init(M, NATT, F.G, F.bid);
                if (gated && L > 0) { S.ready = HAND(8 + L - 1); }
                pg8::EpiScale<0> E{(bf16_t*)(P.ws + WS_QC), NATT, SSQ};
                pg8::gemm_phase(F.lds, F.tid, g, S, E); } }
            SEAM(pb);
            if (PM(6) && IN(pb + 1)) { PHASE_PTRS; cvt_down(F, P, L); if (L + 1 < DEPTH) cvt_rec_mix(F, P, (L + 1) >> 1, L + 1); __syncthreads(); if (DB(6)) { index_phase(F, P, j); __syncthreads(); } if (NAIVE_IDX) naive_index_phase(F, P, j); else index_phase(F, P, j); }
            SEAM(pb + 1);
            if (PM(7) && IN(pb + 2)) { PHASE_PTRS; cvt_up(F, P, L); __syncthreads(); if (DB(7)) { attn_phase(F, P, true); __syncthreads(); } if (NAIVE_ATT) naive_attn_phase(F, P); else attn_phase(F, P); }
            SEAM(pb + 2);
            if (PM(8) && IN(pb + 3)) { PHASE_PTRS;
                pg8::Gemm g{(const bf16_t*)(P.ws + WS_QC), WA + (size_t)j * 5 * MiB + WM_ATT_COMB, NATT, 2048, 2048, -1}; pg8::StaticOrderT<false, true> S; S.init(M, D, F.G, F.bid);
                                pg8::EpiRes<false> E{XB, SSQM, nullptr}; HAND_PREP(S, L, 4);
                pg8::gemm_phase(F.lds, F.tid, g, S, E); HAND_PUBLISH(); }
            SEAM_H(pb + 3);
        }
        if (PM(9) && IN(pb + 4 + mo)) { PHASE_PTRS;
            { const Frame& F1 = F; (void)F1;
            pg8::Gemm g{XB, WUP, D, D, D, -1}; pg8::StaticOrderT<true, true> S; S.init(M, FF, F.G, F.bid);
            if (gated) { S.ready = HAND(L); }
            pg8::EpiScale<2> E{(bf16_t*)(P.ws + WS_H), FF, nullptr};
            HAND_PREP(S, 4 + L, 1);
            pg8::gemm_phase(F.lds, F.tid, g, S, E); HAND_PUBLISH(); } }
        SEAM_H(pb + 4 + mo);
        if (PM(10) && IN(pb + 5 + mo)) { PHASE_PTRS;
            { const Frame& F1 = F; (void)F1;
            pg8::Gemm g{(const bf16_t*)(P.ws + WS_H), WDN, FF, FF, FF, -1}; pg8::StaticOrderT<true, true> S; S.init(M, D, F.G, F.bid);
            if (gated) { S.ready = HAND(4 + L); }
            pg8::EpiRes<true> E{XB, SSQ, SSQM};
            if (L + 1 < DEPTH) HAND_PREP(S, 8 + L, 4);
            pg8::gemm_phase(F.lds, F.tid, g, S, E); } }
        if (L + 1 < DEPTH) SEAM_H(pb + 5 + mo); else SEAM(pb + 5 + mo);
    }
    if (PM(11) && IN(27)) { PHASE_PTRS; if (DB(11)) final_norm(F, P, true); final_norm(F, P); }
#undef IN
#undef SEAM
}

extern "C" void kernel_launch(void* const* d_in, const int* in_sizes, int n_in, void* d_out, int out_size, void* d_ws, size_t ws_size, hipStream_t stream) {
    static int grid = 0;
    if (grid == 0) {
        if (n_in != 21 || in_sizes[0] != M * D || out_size != M * D || ws_size < WS_END) { fprintf(stderr, "kernel_launch: unexpected shapes (n_in %d, in0 %d, out %d, ws %zu)\n", n_in, n_in > 0 ? in_sizes[0] : -1, out_size, ws_size); grid = -1; return; }
        int dev = 0, cus = 0, per_cu = 0;
        if (hipGetDevice(&dev) != hipSuccess || hipDeviceGetAttribute(&cus, hipDeviceAttributeMultiprocessorCount, dev) != hipSuccess) { grid = -1; return; }
        if (hipFuncSetAttribute((const void*)trunk_fwd, hipFuncAttributeMaxDynamicSharedMemorySize, LDS_BYTES) != hipSuccess) { fprintf(stderr, "kernel_launch: hipFuncSetAttribute failed\n"); grid = -1; return; }
        if (hipOccupancyMaxActiveBlocksPerMultiprocessor(&per_cu, (const void*)trunk_fwd, NTHREADS, LDS_BYTES) != hipSuccess || per_cu < 1) fprintf(stderr, "kernel_launch: occupancy query reports %d\n", per_cu);
        (void)hipGetLastError();
        grid = cus;
    }
    if (grid < 0) return;
    (void)hipMemsetAsync((char*)d_ws + WS_CTL, 0, CTL_ZERO_BYTES, stream);
    Args a{};
    for (int i = 0; i < 21; ++i) a.in[i] = (const float*)d_in[i];
    a.out = (float*)d_out; a.ws = (unsigned char*)d_ws;
#if MK_PER_PHASE
#if MK_DETCHECK
    unsigned char* wsb = (unsigned char*)d_ws; unsigned* ck = (unsigned*)(wsb + WS_CKS);
    cks_zero<<<1, 128, 0, stream>>>(ck);
    (void)hipFuncSetAttribute((const void*)lds_poison, hipFuncAttributeMaxDynamicSharedMemorySize, LDS_BYTES);
    for (int pass = 0; pass < 2; ++pass)
    for (int ph = 0; ph < N_PHASES; ++ph) {
        if (ph == 0) { (void)hipMemsetAsync(wsb + 65536, pass ? 0x55 : 0xAA, 224 * MiB - 65536, stream); (void)hipMemsetAsync(d_out, pass ? 0x55 : 0xAA, (size_t)M * D * 4, stream);
            hipLaunchKernelGGL(lds_poison, dim3(grid), dim3(NTHREADS), LDS_BYTES, stream, pass ? 0x55555555u : 0xAAAAAAAAu); }
        a.ph_lo = ph; a.ph_hi = ph + 1; hipLaunchKernelGGL(trunk_fwd, dim3(grid), dim3(NTHREADS), LDS_BYTES, stream, a);
        int L = -1, k = -1; { const int pbs[5] = {1, 8, 14, 21, 27}; for (int l = 0; l < 4; ++l) if (ph >= pbs[l] && ph < pbs[l + 1]) { L = l; k = ph - pbs[l]; } }
        const bool rec = (L & 1) == 0; unsigned* dst = ck + pass * 64 + ph;
        auto CK = [&](size_t off, size_t bytes) { cks_kernel<<<1024, 256, 0, stream>>>((const unsigned*)(wsb + off), bytes / 4, dst); };
        auto CKO = [&]() { cks_kernel<<<1024, 256, 0, stream>>>((const unsigned*)d_out, (size_t)M * D, dst); CK(WS_XB, 32 * MiB); CK(WS_SSQ, 1 * MiB); };
        if (ph == 0) { CK(WS_WMIX, 10 * MiB); CK(WS_WUP, 8 * MiB); CK(WS_WDOWN, 8 * MiB); CK(WS_XB, 32 * MiB); CK(WS_SSQ, 1 * MiB); }
        else if (ph == 27) { cks_kernel<<<1024, 256, 0, stream>>>((const unsigned*)d_out, (size_t)M * D, dst); }
        else if (rec) {
            if (k == 0) { CK(WS_GX, 64 * MiB); CK(WS_WDOWN, 8 * MiB); }
            if (k == 1) CK(WS_XC, 32 * MiB);
            if (k == 2) { CK(WS_RB, 32 * MiB); CK(WS_IB, 32 * MiB); }
            if (k == 3) CK(WS_GX, 64 * MiB);
            if (k == 4) CKO();
            if (k == 5) { CK(WS_H, 128 * MiB); CK(WS_WMIX, 10 * MiB); }
            if (k == 6) { CKO(); CK(WS_WUP, 8 * MiB); }
        } else {
            if (k == 0) { CK(WS_QC, 88 * MiB); CK(WS_WDOWN, 8 * MiB); }
            if (k == 1) { CK(WS_CN, 4 * MiB); CK(WS_IDX, 8 * MiB); }
            if (k == 2) CK(WS_QC, 88 * MiB);
            if (k == 3) CKO();
            if (k == 4) { CK(WS_H, 128 * MiB); CK(WS_WMIX, 10 * MiB); }
            if (k == 5) { CKO(); CK(WS_WUP, 8 * MiB); }
        }
    }
    cks_report<<<1, 64, 0, stream>>>(ck, (float*)d_out);
#else
#if MK_DEBUG_CHECKS
    unsigned char* ws = (unsigned char*)d_ws; const float** in = (const float**)a.in; float* outp = (float*)d_out;
    chk_zero<<<1, 64, 0, stream>>>(ws);
#endif
    for (int ph = 0; ph < N_PHASES; ++ph) {
#if MK_DEBUG_CHECKS
        int L = -1, k = -1; { const int pbs[5] = {1, 8, 14, 21, 27}; for (int l = 0; l < 4; ++l) if (ph >= pbs[l] && ph < pbs[l + 1]) { L = l; k = ph - pbs[l]; } }
        const int j = L >> 1, id0 = 10 * L; const bool rec = (L & 1) == 0;
        if (L >= 0) {
            if ((rec && k == 4 && L > 0) || (!rec && k == 3) || (rec && k == 6) || (!rec && k == 5)) chk_save_rows<<<NS, 256, 0, stream>>>(ws, outp);
            if (rec && k == 3) chk_save_gate<<<128, 256, 0, stream>>>(ws);
        }
#endif
        a.ph_lo = ph; a.ph_hi = ph + 1; hipLaunchKernelGGL(trunk_fwd, dim3(grid), dim3(NTHREADS), LDS_BYTES, stream, a);
#if MK_DEBUG_CHECKS
        if (L >= 0) {
          if (rec) {
            if (k == 0) chk_proj<<<dim3(8, NS), 256, 0, stream>>>(ws, id0 + 1, WS_XB, D, in[4] + (size_t)j * D * 2048, 2048, in[1] + L * D, D, 2048, WS_GX, 2048, 1);
            if (k == 1) chk_conv<<<dim3(4, NS), 256, 0, stream>>>(ws, id0 + 2, in[5] + (size_t)j * 4 * D, in[6] + (size_t)j * D);
            if (k == 2) chk_gates<<<dim3(4, NS), 256, 0, stream>>>(ws, id0 + 3, in[7] + (size_t)j * 4 * 65536, in[8] + (size_t)j * D, in[9] + (size_t)j * 4 * 65536, in[10] + (size_t)j * D);
            if (k == 3) chk_scan<<<2, 64, 0, stream>>>(ws, id0 + 4, in[11] + (size_t)j * D);
            if (k == 4) { chk_res<<<dim3(4, NS), 256, 0, stream>>>(ws, id0 + 5, WS_GX, 2048, in[12] + (size_t)j * D * D, D, outp, L == 0 ? in[0] : nullptr); chk_ssq<<<NS / 64, 64, 0, stream>>>(ws, id0 + 5, outp); }
            if (k == 5) chk_proj<<<dim3(16, NS), 256, 0, stream>>>(ws, id0 + 6, WS_XB, D, in[19] + (size_t)L * D * FF, FF, in[2] + L * D, D, FF, WS_H, FF, 2);
            if (k == 6) { chk_res<<<dim3(4, NS), 256, 0, stream>>>(ws, id0 + 7, WS_H, FF, in[20] + (size_t)L * FF * D, FF, outp, nullptr); chk_ssq<<<NS / 64, 64, 0, stream>>>(ws, id0 + 7, outp); }
          } else {
            if (k == 0) chk_att_in<<<dim3(11, NS), 256, 0, stream>>>(ws, id0 + 1, in[13] + (size_t)j * D * ATT_IN, in[15] + (size_t)j * 16 * 64 * 128, in[1] + L * D);
            if (k == 1) chk_cn<<<NS, 128, 0, stream>>>(ws, id0 + 2, in[14] + (size_t)j * 128);
            if (k == 3) { chk_att_o<<<dim3(4, NS), 256, 0, stream>>>(ws, in[16] + (size_t)j * 16 * 128 * 64); chk_att_out<<<dim3(4, NS), 256, 0, stream>>>(ws, id0 + 5, in[17] + (size_t)j * D * D, outp); chk_ssq<<<NS / 64, 64, 0, stream>>>(ws, id0 + 5, outp); }
            if (k == 4) chk_proj<<<dim3(16, NS), 256, 0, stream>>>(ws, id0 + 6, WS_XB, D, in[19] + (size_t)L * D * FF, FF, in[2] + L * D, D, FF, WS_H, FF, 2);
            if (k == 5) { chk_res<<<dim3(4, NS), 256, 0, stream>>>(ws, id0 + 7, WS_H, FF, in[20] + (size_t)L * FF * D, FF, outp, nullptr); chk_ssq<<<NS / 64, 64, 0, stream>>>(ws, id0 + 7, outp); }
          }
        }
#endif
    }
#if MK_DEBUG_CHECKS
    chk_report<<<1, 64, 0, stream>>>(ws, outp);
#endif
#endif
#else
    a.ph_lo = 0; a.ph_hi = N_PHASES;
    hipLaunchKernelGGL(trunk_fwd, dim3(grid), dim3(NTHREADS), LDS_BYTES, stream, a);
#endif
}
```
